# Optimizing an MI355X kernel written in HIP

```python
import jax, jax.numpy as jnp
from jax import lax
import numpy as np


D_MODEL = 2048
BATCH = 4
SEQ = 4096
DEPTH = 4

BRANCH_WIDTH = D_MODEL // 2
N_BRANCH = 3
HEAD_A = 64
N_HEADS_A = BRANCH_WIDTH // HEAD_A
LORA_DECAY = 64
LORA_AAA = 64
LORA_GATE = 160
DECAY_SCALE = 0.606531
GN_EPS = 64e-5
HEAD_FB = 128
HEAD_IB = 128
N_HEADS_B = BRANCH_WIDTH // HEAD_IB
CHUNK = 64
F_TINY = 1e-30
QK_NOPE = 128
QK_ROPE = 64
V_HEAD = 128
N_HEADS_C = BRANCH_WIDTH // V_HEAD
Q_LORA = 3 * D_MODEL // 8
KV_LORA = D_MODEL // 4
Q_BLOCK = 128
ROPE_THETA = 10000.0
D_FF = 4 * D_MODEL
PLE_DIM = 256
NORM_EPS = 1e-6

RWKV_W = 3 * BRANCH_WIDTH + 2 * LORA_DECAY + 2 * LORA_AAA + LORA_GATE
HGRN_W = 5 * BRANCH_WIDTH
MLA_W = Q_LORA + KV_LORA + QK_ROPE
GATE_W = N_BRANCH * D_MODEL
IN_W = RWKV_W + HGRN_W + MLA_W + GATE_W

kernel_name = 'hybrid_rwkv7_hgrn2_mla_encoder'


def _split(t, sizes):
    out, start = [], 0
    for s in sizes:
        out.append(t[..., start:start + s])
        start += s
    return out


def rms_norm(t, g):
    tf = t.astype(jnp.float32)
    tf = tf * lax.rsqrt(jnp.mean(tf * tf, axis=-1, keepdims=True) + NORM_EPS)
    return (tf * g.astype(jnp.float32)).astype(t.dtype)


def centred_shift(u, mu):
    prev = jnp.pad(u, ((0, 0), (1, 0), (0, 0)))[:, :-1]
    nxt = jnp.pad(u, ((0, 0), (0, 1), (0, 0)))[:, 1:]
    return u + mu[0] * (prev - u) + mu[1] * (nxt - u)


def rwkv7_scan(r, w, k, v, kk, a, reverse):
    Bn, S, H, N = r.shape

    def step(state, inp):
        r_t, w_t, k_t, v_t, kk_t, a_t = inp
        sa = jnp.einsum('bhvk,bhk->bhv', state, -kk_t)
        state = (state * w_t[:, :, None, :]
                 + sa[..., None] * (kk_t * a_t)[:, :, None, :]
                 + v_t[..., None] * k_t[:, :, None, :])
        return state, jnp.einsum('bhvk,bhk->bhv', state, r_t)

    xs = tuple(jnp.moveaxis(t, 1, 0) for t in (r, w, k, v, kk, a))
    init = jnp.zeros((Bn, H, N, N), jnp.float32)
    _, ys = lax.scan(step, init, xs, reverse=reverse)
    return jnp.moveaxis(ys, 0, 1)


def rwkv7_mixer(u, mu, w0, w2, a0, a2, g2, k_k, k_a, r_k, gn_w, gn_b):
    dt = u.dtype
    Bn, S, _ = u.shape
    f32 = jnp.float32
    u = centred_shift(u.astype(f32), mu.astype(f32))
    r, k, v, wd, ad, gd = _split(u, [BRANCH_WIDTH] * 3 + [2 * LORA_DECAY, 2 * LORA_AAA, LORA_GATE])
    wd = wd.reshape(Bn, S, 2, LORA_DECAY)
    ad = ad.reshape(Bn, S, 2, LORA_AAA)
    w_raw = w0 + jnp.einsum('bsnl,nlc->bsnc', jnp.tanh(wd), w2)
    decay = jnp.exp(-DECAY_SCALE * jax.nn.sigmoid(w_raw))
    a = jax.nn.sigmoid(a0 + jnp.einsum('bsnl,nlc->bsnc', ad, a2))
    g = jax.nn.sigmoid(gd) @ g2
    heads = lambda t: t.reshape(Bn, S, N_HEADS_A, HEAD_A)
    kk = heads(k * k_k)
    kk = kk / jnp.maximum(jnp.sqrt(jnp.sum(kk * kk, axis=-1, keepdims=True)), 1e-12)
    kd = k[:, :, None, :] * (1.0 + (a - 1.0) * k_a)
    rh, vh = heads(r), heads(v)
    y = (rwkv7_scan(rh, heads(decay[:, :, 0]), heads(kd[:, :, 0]), vh, kk, heads(a[:, :, 0]), False)
         + rwkv7_scan(rh, heads(decay[:, :, 1]), heads(kd[:, :, 1]), vh, kk, heads(a[:, :, 1]), True))
    mean = jnp.mean(y, axis=-1, keepdims=True)
    var = jnp.mean(jnp.square(y - mean), axis=-1, keepdims=True)
    y = ((y - mean) * lax.rsqrt(var + GN_EPS)).reshape(Bn, S, BRANCH_WIDTH) * gn_w + gn_b
    bonus = jnp.sum(rh * heads(kd[:, :, 0] + kd[:, :, 1]) * r_k, axis=-1, keepdims=True) * vh
    y = y + bonus.reshape(Bn, S, BRANCH_WIDTH)
    return (y * g).astype(dt)


def gla_chunk_scan(q, k, v, logf):
    Bn, H, S, DK = q.shape
    DV = v.shape[-1]
    nc = S // CHUNK
    chunks = lambda t: jnp.moveaxis(t.reshape(Bn, H, nc, CHUNK, t.shape[-1]), 2, 0)
    lower = jnp.tril(jnp.ones((CHUNK, CHUNK), dtype=bool))[:, :, None]

    def step(state, inp):
        qc, kc, vc, gc = inp
        b = jnp.cumsum(gc, axis=2)
        b_last = b[:, :, -1:, :]
        inter = jnp.einsum('bhtk,bhkv->bhtv', qc * jnp.exp(b), state)
        diff = b[:, :, :, None, :] - b[:, :, None, :, :]
        rel = jnp.where(lower, jnp.exp(jnp.where(lower, diff, 0.0)), 0.0)
        scores = jnp.einsum('bhtk,bhsk,bhtsk->bhts', qc, kc, rel)
        intra = jnp.einsum('bhts,bhsv->bhtv', scores, vc)
        state = (state * jnp.exp(b_last)[:, :, 0, :, None]
                 + jnp.einsum('bhsk,bhsv->bhkv', kc * jnp.exp(b_last - b), vc))
        return state, inter + intra

    init = jnp.zeros((Bn, H, DK, DV), jnp.float32)
    _, out = lax.scan(step, init, (chunks(q), chunks(k), chunks(v), chunks(logf)))
    return jnp.moveaxis(out, 0, 2).reshape(Bn, H, S, DV)


def hgrn2_mixer(u, lb, norm_g):
    dt = u.dtype
    Bn, S, _ = u.shape
    q, z_f, z_b, i, g = jnp.split(u.astype(jnp.float32), 5, axis=-1)
    q = jax.nn.silu(q)
    lb = lb.astype(jnp.float32)

    def gate(zz):
        f = lb + (1.0 - lb) * jax.nn.sigmoid(zz)
        return (1.0 - lb) * jax.nn.sigmoid(-zz), jnp.log(jnp.maximum(f, F_TINY))

    k_f, logf_f = gate(z_f)
    k_b, logf_b = gate(z_b)
    heads = lambda t: t.reshape(Bn, S, N_HEADS_B, -1).transpose(0, 2, 1, 3)
    flip = lambda t: jnp.flip(t, axis=2)
    qh, ih = heads(q), heads(i)
    o = (gla_chunk_scan(qh, heads(k_f), ih, heads(logf_f))
         + flip(gla_chunk_scan(flip(qh), flip(heads(k_b)), flip(ih), flip(heads(logf_b)))))
    o = o.transpose(0, 2, 1, 3)
    o = rms_norm(o, norm_g) * jax.nn.silu(g.reshape(Bn, S, N_HEADS_B, HEAD_IB))
    return o.reshape(Bn, S, BRANCH_WIDTH).astype(dt)


def apply_rope(t, cos, sin):
    t1, t2 = jnp.split(t.astype(jnp.float32), 2, axis=-1)
    return jnp.concatenate([t1 * cos - t2 * sin, t2 * cos + t1 * sin], axis=-1).astype(t.dtype)


def mla_mixer(u, positions, q_norm_g, kv_norm_g, w_uq, w_ukv):
    Bn, S, _ = u.shape
    H = N_HEADS_C
    cq, ckv, k_rope = _split(u, [Q_LORA, KV_LORA, QK_ROPE])
    q = (rms_norm(cq, q_norm_g) @ w_uq).reshape(Bn, S, H, QK_NOPE + QK_ROPE)
    kv = (rms_norm(ckv, kv_norm_g) @ w_ukv).reshape(Bn, S, H, QK_NOPE + V_HEAD)
    q_nope, q_rope = q[..., :QK_NOPE], q[..., QK_NOPE:]
    k_nope, v = kv[..., :QK_NOPE], kv[..., QK_NOPE:]
    inv_freq = 1.0 / (ROPE_THETA ** (jnp.arange(0, QK_ROPE, 2, dtype=jnp.float32) / QK_ROPE))
    ang = positions.astype(jnp.float32)[..., None] * inv_freq
    cos, sin = jnp.cos(ang), jnp.sin(ang)
    q_rope = apply_rope(q_rope, cos[:, :, None], sin[:, :, None])
    k_rope = apply_rope(k_rope, cos, sin)
    scale = (QK_NOPE + QK_ROPE) ** -0.5
    nb = S // Q_BLOCK
    blocks = lambda t: jnp.moveaxis(t.reshape(Bn, nb, Q_BLOCK, H, t.shape[-1]), 1, 0)

    def attend(qb):
        qn, qr = qb
        s = (jnp.einsum('bqhd,bkhd->bhqk', qn, k_nope)
             + jnp.einsum('bqhd,bkd->bhqk', qr, k_rope))
        w = jax.nn.softmax(s.astype(jnp.float32) * scale, axis=-1).astype(v.dtype)
        return jnp.einsum('bhqk,bkhd->bqhd', w, v)

    o = lax.map(attend, (blocks(q_nope), blocks(q_rope)))
    return jnp.moveaxis(o, 0, 1).reshape(Bn, S, H * V_HEAD)


def setup_inputs(seed: int = 0) -> dict:
    key = jax.random.key(seed)
    ks = jax.random.split(key, 32)
    L = DEPTH
    nrm = lambda k, shape, s: jax.random.normal(k, shape, jnp.float32) * s
    gain = lambda k, shape: 1.0 + 0.02 * jax.random.normal(k, shape, jnp.float32)
    return {
        'x': nrm(ks[0], (BATCH, SEQ, D_MODEL), 1.0),
        'p': nrm(ks[1], (DEPTH, BATCH, SEQ, PLE_DIM), 1.0),
        'positions': (jnp.arange(SEQ, dtype=jnp.int32)[None, :]
                      + jax.random.randint(ks[2], (BATCH, 1), 0, SEQ, dtype=jnp.int32)),
        'ln1_g': gain(ks[3], (L, D_MODEL)),
        'w_in': nrm(ks[4], (L, D_MODEL, IN_W), D_MODEL ** -0.5),
        'rwkv_mu': jax.random.uniform(ks[5], (L, 2, RWKV_W), jnp.float32, 0.0, 0.5),
        'rwkv_w0': nrm(ks[6], (L, 2, BRANCH_WIDTH), 1.0),
        'rwkv_w2': nrm(ks[7], (L, 2, LORA_DECAY, BRANCH_WIDTH), 0.5 * LORA_DECAY ** -0.5),
        'rwkv_a0': nrm(ks[8], (L, 2, BRANCH_WIDTH), 0.5),
        'rwkv_a2': nrm(ks[9], (L, 2, LORA_AAA, BRANCH_WIDTH), 0.5 * LORA_AAA ** -0.5),
        'rwkv_g2': nrm(ks[10], (L, LORA_GATE, BRANCH_WIDTH), LORA_GATE ** -0.5),
        'rwkv_kk': 1.0 + nrm(ks[11], (L, BRANCH_WIDTH), 0.1),
        'rwkv_ka': 1.0 + nrm(ks[12], (L, BRANCH_WIDTH), 0.1),
        'rwkv_rk': nrm(ks[13], (L, N_HEADS_A, HEAD_A), 0.1),
        'rwkv_gn_w': gain(ks[14], (L, BRANCH_WIDTH)),
        'rwkv_gn_b': nrm(ks[15], (L, BRANCH_WIDTH), 0.02),
        'hgrn_lb': nrm(ks[16], (L, BRANCH_WIDTH), 0.1),
        'hgrn_norm_g': gain(ks[17], (L, HEAD_IB)),
        'mla_q_norm_g': gain(ks[18], (L, Q_LORA)),
        'mla_kv_norm_g': gain(ks[19], (L, KV_LORA)),
        'mla_w_uq': nrm(ks[20], (L, Q_LORA, N_HEADS_C * (QK_NOPE + QK_ROPE)), Q_LORA ** -0.5),
        'mla_w_ukv': nrm(ks[21], (L, KV_LORA, N_HEADS_C * (QK_NOPE + V_HEAD)), KV_LORA ** -0.5),
        'w_branch': nrm(ks[22], (L, N_BRANCH, BRANCH_WIDTH, D_MODEL), BRANCH_WIDTH ** -0.5),
        'w_o': nrm(ks[23], (L, D_MODEL, D_MODEL), D_MODEL ** -0.5),
        'ln2_g': gain(ks[24], (L, D_MODEL)),
        'w_mlp1': nrm(ks[25], (L, D_MODEL, D_FF), D_MODEL ** -0.5),
        'w_mlp2': nrm(ks[26], (L, D_FF, D_MODEL), D_FF ** -0.5),
        'w_pe': nrm(ks[27], (L, PLE_DIM, D_MODEL), PLE_DIM ** -0.5),
        'w_pg': nrm(ks[28], (L, D_MODEL, D_MODEL), D_MODEL ** -0.5),
        'final_g': gain(ks[29], (D_MODEL,)),
    }


def reference(x, p, positions, ln1_g, w_in, rwkv_mu, rwkv_w0, rwkv_w2, rwkv_a0, rwkv_a2,
              rwkv_g2, rwkv_kk, rwkv_ka, rwkv_rk, rwkv_gn_w, rwkv_gn_b, hgrn_lb, hgrn_norm_g,
              mla_q_norm_g, mla_kv_norm_g, mla_w_uq, mla_w_ukv, w_branch, w_o, ln2_g,
              w_mlp1, w_mlp2, w_pe, w_pg, final_g):
    Bn, S, D = x.shape
    lb_w = jax.nn.softmax(hgrn_lb.astype(jnp.float32), axis=0)
    lower_bounds = jnp.cumsum(lb_w, axis=0) - lb_w[0]
    h = x
    for l in range(DEPTH):
        hn = rms_norm(h, ln1_g[l])
        z = hn @ w_in[l]
        u_a, u_b, u_c, u_g = _split(z, [RWKV_W, HGRN_W, MLA_W, GATE_W])
        y_a = rwkv7_mixer(u_a, rwkv_mu[l], rwkv_w0[l], rwkv_w2[l], rwkv_a0[l], rwkv_a2[l],
                          rwkv_g2[l], rwkv_kk[l], rwkv_ka[l], rwkv_rk[l], rwkv_gn_w[l], rwkv_gn_b[l])
        y_b = hgrn2_mixer(u_b, lower_bounds[l], hgrn_norm_g[l])
        y_c = mla_mixer(u_c, positions, mla_q_norm_g[l], mla_kv_norm_g[l], mla_w_uq[l], mla_w_ukv[l])
        gates = jax.nn.sigmoid(u_g).reshape(Bn, S, N_BRANCH, D)
        mixed = (gates[:, :, 0] * (y_a @ w_branch[l, 0])
                 + gates[:, :, 1] * (y_b @ w_branch[l, 1])
                 + gates[:, :, 2] * (y_c @ w_branch[l, 2]))
        h = h + mixed @ w_o[l]
        hn = rms_norm(h, ln2_g[l])
        h = h + jnp.square(jax.nn.relu(hn @ w_mlp1[l])) @ w_mlp2[l]
        h = h + jax.nn.sigmoid(h @ w_pg[l]) * (p[l] @ w_pe[l])
    return rms_norm(h, final_g)
```

```cpp
#include <hip/hip_runtime.h>
#include <cstdio>
#include <cstdint>
__device__ __forceinline__ int tid_opaque() { int t = threadIdx.x; asm volatile("" : "+v"(t)); return t; }

#ifndef MK_N_LAUNCHES
#define MK_N_LAUNCHES 1
#endif

constexpr int DM = 2048, NBATCH = 4, SEQ = 4096, DEPTH = 4, M = NBATCH * SEQ, BW = 1024;
constexpr int RWKV_W = 3488, IN_W = 16096, DFF = 8192, PLE = 256;
constexpr int ZW = 16384;
constexpr int ZO_A = 0, ZO_H = 3584, ZO_C = 8704, ZO_G = 10240;
constexpr int NPH_LAYER = 12, NPHASES = 2 + DEPTH * NPH_LAYER;

constexpr size_t MiB = 1u << 20;
constexpr size_t WS_CTL = 0, CTL_ZERO_BYTES = 1 * MiB;
constexpr size_t WS_COS = 1 * MiB, WS_SIN = 3 * MiB, WS_LB = 5 * MiB;
constexpr size_t WS_SS = 1402 * MiB, WS_RSTD = 1422 * MiB;
constexpr size_t WS_PB = 6 * MiB;
constexpr size_t WS_WIN = 14 * MiB, WS_LORA = 78 * MiB, WS_UQ = 83 * MiB, WS_UKV = 86 * MiB, WS_BR = 88 * MiB, WS_WO = 100 * MiB,
                 WS_W1 = 108 * MiB, WS_W2 = 140 * MiB, WS_WPE = 172 * MiB, WS_WPG = 173 * MiB;
constexpr size_t WS_XN = 182 * MiB;
constexpr size_t WS_ALORA = WS_XN, WS_CQN = WS_XN + 16 * MiB, WS_CKVN = WS_XN + 40 * MiB;
constexpr size_t WS_Z = 246 * MiB;
constexpr size_t WS_HID = WS_Z, WS_HB = WS_Z + 256 * MiB, WS_PE = WS_Z + 320 * MiB;
constexpr size_t WS_SCAN = 758 * MiB;
constexpr size_t WS_R = WS_SCAN, WS_KAP = WS_SCAN + 64 * MiB, WS_W = WS_SCAN + 128 * MiB, WS_A = WS_SCAN + 256 * MiB;
constexpr size_t WS_MIX = WS_SCAN, WS_MIXED = WS_SCAN + 128 * MiB;
constexpr size_t WS_QH = 1270 * MiB, WS_KH = 1334 * MiB, WS_GM = 1398 * MiB, WS_GL = 1400 * MiB;
constexpr size_t WS_KS = 1462 * MiB, WS_G = 1526 * MiB;
constexpr size_t WS_V = 1832 * MiB;
constexpr size_t WS_Q = 1558 * MiB, WS_KV = 1606 * MiB, WS_KR = 1670 * MiB;
constexpr size_t WS_YA = WS_Q, WS_YB = WS_Q + 32 * MiB;
constexpr size_t WS_YC = 1672 * MiB;
constexpr size_t WS_YS = 1704 * MiB, WS_OS = 1768 * MiB;
constexpr size_t WS_END = 1896 * MiB;
constexpr int CW_BAR = 4096, CW_ATTQ = 8192, CW_CVQ = 12288;

namespace pg8 {
#define PG8_LAS __attribute__((address_space(3)))
typedef unsigned short bf16_t;
typedef short bf16x8 __attribute__((ext_vector_type(8)));
typedef float f32x4 __attribute__((ext_vector_type(4)));
typedef unsigned u32x4 __attribute__((ext_vector_type(4)));
constexpr int BM = 256, BK = 64, HALF = 128, HTB = HALF * BK * 2  , STAGE_BYTES = 8 * HTB, NXCD = 8, WGM = 4;

__host__ __device__ __forceinline__ int lds_byte(int r, int c) { const int st = (r >> 4) * 2 + (c >> 5), rr = r & 15, cc = c & 31, ob = rr * 64 + cc * 2; return st * 1024 + (ob ^ (((ob >> 9) & 1) << 5)); }
__host__ __device__ __forceinline__ void stage_rc(int b, int& R, int& C) { const int st = b / 1024, sb = b % 1024, swz = sb ^ (((sb >> 9) & 1) << 5); R = (st >> 1) * 16 + swz / 64; C = (st & 1) * 32 + (swz % 64) / 2; }
__host__ __device__ __forceinline__ int perm32(int rho) { const int n = rho >> 4, i = rho & 15; return 8 * (i >> 2) + 4 * n + (i & 3); }

struct Unit { int pm, pn; };
struct Gemm { const bf16_t* A; const bf16_t* Bt; int M, N, K; };

struct StaticOrder {
    int nM, nN, nwg, G, c, wgm;
    __host__ __device__ void init(int M, int N, int G_, int c_, int wgm_ = WGM) { nM = M / BM; nN = N / BM; nwg = nM * nN; G = G_; c = c_; wgm = wgm_; }
    __host__ __device__ bool next(int i, Unit& u) const {
        const long L = (long)i * G + c; if (L >= nwg) return false;
        int wgid = (int)L; { const int q = nwg / NXCD, r = nwg % NXCD, xcd = wgid % NXCD, off = wgid / NXCD; wgid = (xcd < r ? xcd * (q + 1) : r * (q + 1) + (xcd - r) * q) + off; }
        const int nig = wgm * nN, gid = wgid / nig, fm = gid * wgm, gsz = (nM - fm) < wgm ? (nM - fm) : wgm;
        u.pm = fm + ((wgid % nig) % gsz); u.pn = (wgid % nig) / gsz; return true;
    }
    __device__ __forceinline__ void a_ready(const Unit&) const {}
    __device__ __forceinline__ void done(const Unit&) const {}
};

typedef float cvt_f32x2 __attribute__((ext_vector_type(2))); typedef __bf16 cvt_bf16x2 __attribute__((ext_vector_type(2))); typedef _Float16 cvt_h16x2 __attribute__((ext_vector_type(2)));
__device__ __forceinline__ unsigned cvt_pk_bf16(float lo, float hi) { const cvt_f32x2 v = {lo, hi}; return __builtin_bit_cast(unsigned, __builtin_convertvector(v, cvt_bf16x2)); }
typedef float f32x2 __attribute__((ext_vector_type(2)));
typedef unsigned u32x2 __attribute__((ext_vector_type(2)));
__device__ __forceinline__ float sigm(float x) { return __builtin_amdgcn_rcpf(1.0f + __expf(-x)); }
__device__ __forceinline__ f32x4 sigm4(f32x4 v) { f32x4 o; o[0] = sigm(v[0]); o[1] = sigm(v[1]); o[2] = sigm(v[2]); o[3] = sigm(v[3]); return o; }
__device__ __forceinline__ f32x4 bf4_to_f32(u32x2 w) { f32x4 o; o[0] = __uint_as_float(w.x << 16); o[1] = __uint_as_float(w.x & 0xffff0000u); o[2] = __uint_as_float(w.y << 16); o[3] = __uint_as_float(w.y & 0xffff0000u); return o; }
__device__ __forceinline__ u32x2 f32_to_bf4(f32x4 v) { u32x2 w; w.x = cvt_pk_bf16(v[0], v[1]); w.y = cvt_pk_bf16(v[2], v[3]); return w; }
#define EPI_ROWS(ai, m) _Pragma("unroll") for (int ai = 0; ai < 2; ++ai) _Pragma("unroll") for (int m = 0; m < 4; ++m)
#define EPI_COLS(bj, n) _Pragma("unroll") for (int bj = 0; bj < 2; ++bj) _Pragma("unroll") for (int n = 0; n < 2; ++n)

template <int MODE> struct EpiB16 {
    static constexpr bool PERM = true, AFTER_DRAIN = false;
    bf16_t* O; int ldc; const float* COS; const float* SIN;
    __device__ __forceinline__ void operator()(const f32x4 (&acc)[2][2][4][2], const Unit& u, int wr, int wc, int fr, int fq) const {
        const int row0 = u.pm * BM + wr * 64 + fr, col0 = u.pn * BM + wc * 32 + 8 * fq;
        float rs[2][4];
        if (MODE == 1 || MODE == 2) { EPI_ROWS(ai, m) rs[ai][m] = COS[row0 + ai * HALF + m * 16]; }
        EPI_ROWS(ai, m) { const int row = row0 + ai * HALF + m * 16; bf16_t* rowp = O + (size_t)row * ldc + col0;
            float rstd = 1.f; if (MODE == 1 || MODE == 2) rstd = rs[ai][m];
#pragma unroll
            for (int bj = 0; bj < 2; ++bj) { f32x4 v0 = acc[ai][bj][m][0], v1 = acc[ai][bj][m][1];
                if (MODE == 1) { v0 = v0 * rstd; v1 = v1 * rstd; if (u.pn >= 40) { v0 = sigm4(v0); v1 = sigm4(v1); } }
                if (MODE == 2) {
#pragma unroll
                    for (int j = 0; j < 4; ++j) { const float a = fmaxf(v0[j], 0.f) * rstd, b = fmaxf(v1[j], 0.f) * rstd; v0[j] = a * a; v1[j] = b * b; } }
                if (MODE == 3) { const int j192 = (col0 + bj * HALF) % 192;
                    if (j192 >= 128) { const int i0 = (j192 - 128) >> 1; const f32x4 c = *(const f32x4*)(COS + (size_t)row * 32 + i0), s = *(const f32x4*)(SIN + (size_t)row * 32 + i0);
                        f32x4 a, b; a[0] = v0[0] * c[0] - v0[1] * s[0]; a[1] = v0[1] * c[0] + v0[0] * s[0]; a[2] = v0[2] * c[1] - v0[3] * s[1]; a[3] = v0[3] * c[1] + v0[2] * s[1];
                        b[0] = v1[0] * c[2] - v1[1] * s[2]; b[1] = v1[1] * c[2] + v1[0] * s[2]; b[2] = v1[2] * c[3] - v1[3] * s[3]; b[3] = v1[3] * c[3] + v1[2] * s[3]; v0 = a; v1 = b; } }
                u32x4 w; w.x = cvt_pk_bf16(v0[0], v0[1]); w.y = cvt_pk_bf16(v0[2], v0[3]); w.z = cvt_pk_bf16(v1[0], v1[1]); w.w = cvt_pk_bf16(v1[2], v1[3]);
                if (MODE == 1) __builtin_nontemporal_store(w, (u32x4*)(rowp + bj * HALF)); else *(u32x4*)(rowp + bj * HALF) = w; } }
    }
};
struct EpiLora {
    static constexpr bool PERM = false, AFTER_DRAIN = false;
    const float* w0; const float* a0;
    unsigned short* W; bf16_t* A; bf16_t* G; int pn_off;
    __device__ __forceinline__ void operator()(const f32x4 (&acc)[2][2][4][2], const Unit& u, int wr, int wc, int fr, int fq) const {
        const int pn = u.pn + pn_off; const int row0 = u.pm * BM + wr * 64 + fr, cc0 = (pn & 3) * BM + wc * 32 + 4 * fq;
        if (pn < 8) { const int dir = pn >> 2; f32x4 wv[2][2];
            EPI_COLS(bj, n) wv[bj][n] = *(const f32x4*)(w0 + dir * 1024 + cc0 + bj * HALF + n * 16);
            EPI_ROWS(ai, m) { unsigned short* rowp = W + ((size_t)dir * M + row0 + ai * HALF + m * 16) * 1024 + cc0;
                EPI_COLS(bj, n) { const f32x4 s = sigm4(wv[bj][n] + acc[ai][bj][m][n]); f32x4 o;
#pragma unroll
                    for (int j = 0; j < 4; ++j) o[j] = __expf(-0.606531f * s[j]);
                    const cvt_f32x2 oa = {o[0], o[1]}, ob = {o[2], o[3]}; u32x2 wv_; wv_.x = __builtin_bit_cast(unsigned, __builtin_convertvector(oa, cvt_h16x2)); wv_.y = __builtin_bit_cast(unsigned, __builtin_convertvector(ob, cvt_h16x2));
                    *(u32x2*)(rowp + bj * HALF + n * 16) = wv_; } }
        } else if (pn < 16) { const int dir = (pn - 8) >> 2; f32x4 av[2][2];
            EPI_COLS(bj, n) av[bj][n] = *(const f32x4*)(a0 + dir * 1024 + cc0 + bj * HALF + n * 16);
            EPI_ROWS(ai, m) { bf16_t* rowp = A + ((size_t)dir * M + row0 + ai * HALF + m * 16) * 1024 + cc0;
                EPI_COLS(bj, n) *(u32x2*)(rowp + bj * HALF + n * 16) = f32_to_bf4(sigm4(av[bj][n] + acc[ai][bj][m][n])); }
        } else {
            EPI_ROWS(ai, m) { bf16_t* rowp = G + (size_t)(row0 + ai * HALF + m * 16) * 1024 + cc0;
                EPI_COLS(bj, n) *(u32x2*)(rowp + bj * HALF + n * 16) = f32_to_bf4(acc[ai][bj][m][n]); }
        }
    }
};
template <int NB> struct EpiBranch {
    static constexpr bool PERM = false, AFTER_DRAIN = false;
    const bf16_t* Z; float* MIX; bf16_t* MIXED;
    __device__ __forceinline__ void operator()(const f32x4 (&acc)[2][2][4][2], const Unit& u, int wr, int wc, int fr, int fq) const {
        const int row0 = u.pm * BM + wr * 64 + fr, col0 = u.pn * BM + wc * 32 + 4 * fq;
#pragma unroll
        for (int ai = 0; ai < 2; ++ai)
#pragma unroll
            for (int mh = 0; mh < 2; ++mh) { u32x2 gq[2][2][2]; f32x4 mq[2][2][2];
#pragma unroll
                for (int e = 0; e < 2; ++e) { const size_t row = (size_t)(row0 + ai * HALF + (2 * mh + e) * 16); const bf16_t* gp = Z + row * 16384 + 10240 + NB * 2048 + col0; const float* mp = MIX + row * 2048 + col0;
                    EPI_COLS(bj, n) { const int co = bj * HALF + n * 16; gq[e][bj][n] = *(const u32x2*)(gp + co); if (NB >= 1) mq[e][bj][n] = *(const f32x4*)(mp + co); } }
#pragma unroll
                for (int e = 0; e < 2; ++e) { const int m = 2 * mh + e; const size_t row = (size_t)(row0 + ai * HALF + m * 16); float* mp = MIX + row * 2048 + col0;
                    EPI_COLS(bj, n) { const int co = bj * HALF + n * 16; f32x4 v = bf4_to_f32(gq[e][bj][n]) * acc[ai][bj][m][n];
                        if (NB >= 1) v += mq[e][bj][n];
                        if (NB < 2) *(f32x4*)(mp + co) = v; else *(u32x2*)(MIXED + row * 2048 + col0 + co) = f32_to_bf4(v); } } }
    }
};
__device__ __forceinline__ void norm_feed(const f32x4 (&h)[2][2], const float* g, bf16_t* xn, float* ss, int fq) {
    float q = 0.f;
    EPI_COLS(bj, n) { const f32x4 v = h[bj][n]; q += (v[0] * v[0] + v[1] * v[1]) + (v[2] * v[2] + v[3] * v[3]);
        *(u32x2*)(xn + bj * HALF + n * 16) = f32_to_bf4(v * *(const f32x4*)(g + bj * HALF + n * 16)); }
    q += __shfl_xor(q, 16); q += __shfl_xor(q, 32);
    if (fq == 0) *ss = q;
}
template <int MODE> struct EpiResid {
    static constexpr bool PERM = false, AFTER_DRAIN = false;
    float* H; bf16_t* HB; const float* G; float* SS;
    __device__ __forceinline__ void operator()(const f32x4 (&acc)[2][2][4][2], const Unit& u, int wr, int wc, int fr, int fq) const {
        const int row0 = u.pm * BM + wr * 64 + fr, col0 = u.pn * BM + wc * 32 + 4 * fq;
#pragma unroll
        for (int ai = 0; ai < 2; ++ai)
#pragma unroll
            for (int mp = 0; mp < 2; ++mp) { f32x4 hv[2][2][2];
#pragma unroll
                for (int e = 0; e < 2; ++e) { const size_t ro = (size_t)(row0 + ai * HALF + (2 * mp + e) * 16) * 2048 + col0; EPI_COLS(bj, n) hv[e][bj][n] = *(const f32x4*)(H + ro + bj * HALF + n * 16); }
#pragma unroll
                for (int e = 0; e < 2; ++e) { const int m = 2 * mp + e, row = row0 + ai * HALF + m * 16; const size_t ro = (size_t)row * 2048 + col0;
                    EPI_COLS(bj, n) { const int co = bj * HALF + n * 16; const f32x4 v = hv[e][bj][n] + acc[ai][bj][m][n]; *(f32x4*)(H + ro + co) = v; hv[e][bj][n] = v;
                        if (MODE == 1) *(u32x2*)(HB + ro + co) = f32_to_bf4(v); }
                    if (MODE == 2) norm_feed(hv[e], G + col0, HB + ro, SS + (size_t)row * 32 + u.pn * 4 + wc, fq); } }
    }
};
struct EpiPG {
    static constexpr bool PERM = false, AFTER_DRAIN = false;
    float* H; const bf16_t* PE; bf16_t* XN; const float* G; float* SS;
    __device__ __forceinline__ void operator()(const f32x4 (&acc)[2][2][4][2], const Unit& u, int wr, int wc, int fr, int fq) const {
        const int row0 = u.pm * BM + wr * 64 + fr, col0 = u.pn * BM + wc * 32 + 4 * fq;
#pragma unroll
        for (int ai = 0; ai < 2; ++ai)
#pragma unroll
            for (int mp = 0; mp < 2; ++mp) { f32x4 hv[2][2][2]; u32x2 pq_[2][2][2];
#pragma unroll
                for (int e = 0; e < 2; ++e) { const size_t ro = (size_t)(row0 + ai * HALF + (2 * mp + e) * 16) * 2048 + col0; EPI_COLS(bj, n) { const int co = bj * HALF + n * 16; pq_[e][bj][n] = *(const u32x2*)(PE + ro + co); hv[e][bj][n] = *(const f32x4*)(H + ro + co); } }
#pragma unroll
                for (int e = 0; e < 2; ++e) { const int m = 2 * mp + e, row = row0 + ai * HALF + m * 16; const size_t ro = (size_t)row * 2048 + col0;
                    EPI_COLS(bj, n) { const int co = bj * HALF + n * 16; const f32x4 v = hv[e][bj][n] + sigm4(acc[ai][bj][m][n]) * bf4_to_f32(pq_[e][bj][n]); *(f32x4*)(H + ro + co) = v; hv[e][bj][n] = v; }
                    norm_feed(hv[e], G + col0, XN + ro, SS + (size_t)row * 32 + u.pn * 4 + wc, fq); } }
    }
};

template <class Epi, class Sched, bool ALIGN_EPI = false, bool SP2 = false>
__device__ __forceinline__ void gemm_phase(PG8_LAS unsigned char* lds, const Gemm g, const Sched& S, const Epi& E) {
    const int tid = tid_opaque(), wid = __builtin_amdgcn_readfirstlane(tid >> 6), lane = tid & 63, wr = wid >> 2, wc = wid & 3, fr = lane & 15, fq = lane >> 4;
    int K_ = g.K; asm volatile("" : "+s"(K_)); const int K = K_, nt = K / BK;
    unsigned voffA[2], voffB[2];
#pragma unroll
    for (int i = 0; i < 2; ++i) { int R, C; stage_rc(tid * 16 + i * 8192, R, C); const int Rb = Epi::PERM ? ((R & ~31) + perm32(R & 31)) : R;
        voffA[i] = (unsigned)(R * K + C) * 2u; voffB[i] = (unsigned)(Rb * K + C) * 2u; }
    const size_t kstep = (size_t)(BK * 2);
    const size_t hstep = (size_t)HALF * K * 2;
    const size_t tstep = 2 * hstep;
    const unsigned ldsw = (unsigned)wid * 1024u;
    const int aoff = lds_byte(wr * 64 + fr, fq * 8), boff = lds_byte(wc * 32 + fr, fq * 8);
#define PG8_SA(b, h) (((b) * 2 + (h)) * HTB)
#define PG8_SB(b, h) ((4 + (b) * 2 + (h)) * HTB)
#define PG8_STAGE(bufoff, gbase, voff) do { _Pragma("unroll") for (int _i = 0; _i < 2; ++_i) \
        __builtin_amdgcn_global_load_lds((const unsigned*)((const char*)(gbase) + (voff)[_i]), (PG8_LAS unsigned*)(lds + (bufoff) + ldsw + _i * 8192), 16, 0, 0); } while (0)
#define PG8_LDA(dst, b, h) do { _Pragma("unroll") for (int m = 0; m < 4; ++m) _Pragma("unroll") for (int k = 0; k < 2; ++k) dst[m][k] = *(const PG8_LAS bf16x8*)(lds + PG8_SA(b, h) + aoff + m * 2048 + k * 1024); } while (0)
#define PG8_LDB(dst, b, h) do { _Pragma("unroll") for (int n = 0; n < 2; ++n) _Pragma("unroll") for (int k = 0; k < 2; ++k) dst[n][k] = *(const PG8_LAS bf16x8*)(lds + PG8_SB(b, h) + boff + n * 2048 + k * 1024); } while (0)
#define PG8_MMA(ai, bj, At, Bt) do { __builtin_amdgcn_s_setprio(1); _Pragma("unroll") for (int m = 0; m < 4; ++m) _Pragma("unroll") for (int n = 0; n < 2; ++n) _Pragma("unroll") for (int k = 0; k < 2; ++k) \
        acc[ai][bj][m][n] = __builtin_amdgcn_mfma_f32_16x16x32_bf16(Bt[n][k], At[m][k], acc[ai][bj][m][n], 0, 0, 0); __builtin_amdgcn_s_setprio(0); } while (0)
#define PG8_WAIT_V(n) asm volatile("s_waitcnt vmcnt(" #n ")" ::: "memory")
#define PG8_WAIT_L(n) asm volatile("s_waitcnt lgkmcnt(" #n ")" ::: "memory")
#define PG8_BAR __builtin_amdgcn_s_barrier()
#define PG8_SCHED __builtin_amdgcn_sched_barrier(0)
    Unit cur, nxt; int ui = 0;
    if (!S.next(0, cur)) return;
    f32x4 acc[2][2][4][2];
#pragma unroll
    for (int a = 0; a < 2; ++a)
#pragma unroll
        for (int b = 0; b < 2; ++b)
#pragma unroll
            for (int m = 0; m < 4; ++m)
#pragma unroll
                for (int n = 0; n < 2; ++n) acc[a][b][m][n] = (f32x4){0.f, 0.f, 0.f, 0.f};
    bf16x8 At[4][2], B0[2][2], B1[2][2];
    const char* cA = (const char*)g.A + (size_t)cur.pm * tstep; const char* cB = (const char*)g.Bt + (size_t)cur.pn * tstep;
    S.a_ready(cur);
    if constexpr (SP2) {
        PG8_STAGE(PG8_SB(0, 0), cB, voffB); PG8_STAGE(PG8_SB(0, 1), cB + hstep, voffB); PG8_STAGE(PG8_SA(0, 0), cA, voffA); PG8_STAGE(PG8_SA(0, 1), cA + hstep, voffA);
        if (wr == 1) PG8_BAR;
        PG8_WAIT_V(2); PG8_BAR;
        PG8_STAGE(PG8_SB(1, 0), cB + kstep, voffB); PG8_STAGE(PG8_SA(1, 0), cA + kstep, voffA); PG8_STAGE(PG8_SB(1, 1), cB + hstep + kstep, voffB);
        PG8_WAIT_V(6); PG8_BAR;
    } else {
        PG8_STAGE(PG8_SB(0, 0), cB, voffB); PG8_STAGE(PG8_SA(0, 0), cA, voffA); PG8_STAGE(PG8_SB(0, 1), cB + hstep, voffB); PG8_STAGE(PG8_SA(0, 1), cA + hstep, voffA);
        if (wr == 1) PG8_BAR;
        PG8_WAIT_V(4); PG8_BAR;
        PG8_STAGE(PG8_SB(1, 0), cB + kstep, voffB); PG8_STAGE(PG8_SA(1, 0), cA + kstep, voffA); PG8_STAGE(PG8_SB(1, 1), cB + hstep + kstep, voffB);
        PG8_WAIT_V(6); PG8_BAR;
    }
    for (;;) {
        const bool has_next = S.next(ui + 1, nxt);
        const char* nA = has_next ? (const char*)g.A + (size_t)nxt.pm * tstep : cA; const char* nB = has_next ? (const char*)g.Bt + (size_t)nxt.pn * tstep : cB;
        for (int t = 0; t < nt; t += 2) {
            const bool last = (t == nt - 2);
            const char* a1 = cA + (size_t)(t + 1) * kstep;
            const char* a2 = last ? nA : cA + (size_t)(t + 2) * kstep; const char* b2 = last ? nB : cB + (size_t)(t + 2) * kstep;
            const char* a3 = a2 + kstep; const char* b3 = b2 + kstep;
            if (last && has_next) S.a_ready(nxt);
            if constexpr (SP2) {
            PG8_LDB(B0, 0, 0); PG8_LDB(B1, 0, 1); PG8_SCHED; PG8_LDA(At, 0, 0); PG8_STAGE(PG8_SA(1, 1), a1 + hstep, voffA);
            PG8_WAIT_V(8); PG8_WAIT_L(0); PG8_BAR; PG8_MMA(0, 0, At, B0); PG8_MMA(0, 1, At, B1); PG8_BAR; PG8_SCHED;
            PG8_LDA(At, 0, 1); PG8_STAGE(PG8_SB(0, 0), b2, voffB); PG8_STAGE(PG8_SB(0, 1), b2 + hstep, voffB); PG8_STAGE(PG8_SA(0, 0), a2, voffA);
            PG8_WAIT_V(8); PG8_WAIT_L(0); PG8_BAR; PG8_MMA(1, 0, At, B0); PG8_MMA(1, 1, At, B1); PG8_BAR; PG8_SCHED;
            PG8_LDB(B0, 1, 0); PG8_LDB(B1, 1, 1); PG8_SCHED; PG8_LDA(At, 1, 0); PG8_STAGE(PG8_SA(0, 1), a2 + hstep, voffA);
            PG8_WAIT_V(8); PG8_WAIT_L(0); PG8_BAR; PG8_MMA(0, 0, At, B0); PG8_MMA(0, 1, At, B1); PG8_BAR; PG8_SCHED;
            PG8_LDA(At, 1, 1); PG8_STAGE(PG8_SB(1, 0), b3, voffB); PG8_STAGE(PG8_SB(1, 1), b3 + hstep, voffB); PG8_STAGE(PG8_SA(1, 0), a3, voffA);
            PG8_WAIT_V(8); PG8_WAIT_L(0); PG8_BAR; PG8_MMA(1, 0, At, B0); PG8_MMA(1, 1, At, B1); PG8_BAR; PG8_SCHED;
            } else {
            PG8_LDB(B0, 0, 0); PG8_SCHED; PG8_LDA(At, 0, 0); PG8_STAGE(PG8_SA(1, 1), a1 + hstep, voffA);
            PG8_WAIT_L(8); PG8_BAR; PG8_WAIT_L(0); PG8_MMA(0, 0, At, B0); PG8_BAR; PG8_SCHED;
            PG8_LDB(B1, 0, 1); PG8_STAGE(PG8_SB(0, 0), b2, voffB);
            PG8_BAR; PG8_WAIT_L(0); PG8_MMA(0, 1, At, B1); PG8_BAR;
            PG8_LDA(At, 0, 1); PG8_STAGE(PG8_SA(0, 0), a2, voffA);
            PG8_BAR; PG8_WAIT_L(0); PG8_MMA(1, 0, At, B0); PG8_BAR; PG8_SCHED;
            PG8_STAGE(PG8_SB(0, 1), b2 + hstep, voffB);
            PG8_WAIT_V(6); PG8_BAR; PG8_MMA(1, 1, At, B1); PG8_BAR;
            PG8_LDB(B0, 1, 0); PG8_SCHED; PG8_LDA(At, 1, 0); PG8_STAGE(PG8_SA(0, 1), a2 + hstep, voffA);
            PG8_WAIT_L(8); PG8_BAR; PG8_WAIT_L(0); PG8_MMA(0, 0, At, B0); PG8_BAR; PG8_SCHED;
            PG8_LDB(B1, 1, 1); PG8_STAGE(PG8_SB(1, 0), b3, voffB);
            PG8_BAR; PG8_WAIT_L(0); PG8_MMA(0, 1, At, B1); PG8_BAR;
            PG8_LDA(At, 1, 1); PG8_STAGE(PG8_SA(1, 0), a3, voffA);
            PG8_BAR; PG8_WAIT_L(0); PG8_MMA(1, 0, At, B0); PG8_BAR; PG8_SCHED;
            PG8_STAGE(PG8_SB(1, 1), b3 + hstep, voffB);
            PG8_WAIT_V(6); PG8_BAR; PG8_MMA(1, 1, At, B1); PG8_BAR;
            }
        }
        if constexpr (ALIGN_EPI) { if (wr == 0) PG8_BAR; }
        if constexpr (!Epi::AFTER_DRAIN) { E(acc, cur, wr, wc, fr, fq); S.done(cur); }
        if (!has_next) break;
#pragma unroll
        for (int a = 0; a < 2; ++a)
#pragma unroll
            for (int b = 0; b < 2; ++b)
#pragma unroll
                for (int m = 0; m < 4; ++m)
#pragma unroll
                    for (int n = 0; n < 2; ++n) acc[a][b][m][n] = (f32x4){0.f, 0.f, 0.f, 0.f};
        cur = nxt; cA = nA; cB = nB; ++ui;
        if constexpr (ALIGN_EPI) { if (wr == 1) PG8_BAR; }
    }
    PG8_WAIT_V(0);
    if constexpr (!ALIGN_EPI) { if (wr == 0) PG8_BAR; }
    PG8_BAR;
    if constexpr (Epi::AFTER_DRAIN) { E.fused(acc, cur, wr, wc, fr, fq, lds, wid, lane); S.done(cur); }
#undef PG8_SA
#undef PG8_SB
#undef PG8_STAGE
#undef PG8_LDA
#undef PG8_LDB
#undef PG8_MMA
#undef PG8_WAIT_V
#undef PG8_WAIT_L
#undef PG8_BAR
#undef PG8_SCHED
}
}
namespace att {
using bf16x8 = __attribute__((ext_vector_type(8))) short;
using s16x4  = __attribute__((ext_vector_type(4))) short;
using f32x16 = __attribute__((ext_vector_type(16))) float;
using u32x4  = __attribute__((ext_vector_type(4))) unsigned;
constexpr int NW = 8, QBLK = 32, KVBLK = 64;
constexpr float SCALE = 0.07216878364870322f;
constexpr float THR = 8.f;
constexpr int LDQ = 1536, LDK = 2048, LDR = 64, LDO = 1024;
constexpr size_t SHM_V = KVBLK * 128 * 2, SHM_K = KVBLK * 128 * 2, SHM_R = KVBLK * 64 * 2, SHM_QR = NW * 4096, SHM_ATTN = 2 * SHM_V + 2 * SHM_K + 2 * SHM_R + NW * 64 * 4 + SHM_QR;
#define KSWZ(row, colB) ((row) * 256 + ((colB) ^ (((row) & 7) << 4)))
#define RSWZ(row, colB) ((row) * 128 + ((colB) ^ (((row) & 7) << 4)))
#define SBAR() __builtin_amdgcn_sched_barrier(0)
__device__ __forceinline__ int crow(int r, int hi) { return (r & 3) + 8 * (r >> 2) + 4 * hi; }
__device__ __forceinline__ unsigned cvtpk(float lo, float hi) { return pg8::cvt_pk_bf16(lo, hi); }
__device__ __forceinline__ bf16x8 ld8(const unsigned short* p) { return *reinterpret_cast<const bf16x8*>(p); }
__device__ __forceinline__ unsigned bfr(float f) { return pg8::cvt_pk_bf16(f, 0.f) & 0xffffu; }
__device__ __forceinline__ unsigned bfpk(float lo, float hi) { return pg8::cvt_pk_bf16(lo, hi); }

__device__ __forceinline__ void partialSM(f32x16& p0, f32x16& p1, float& m_reg, float& mn, float& alpha) {
  constexpr float C = SCALE * 1.4426950408889634f;
  float pmax = p0[0];
#pragma unroll
  for (int r = 1; r < 16; ++r) pmax = fmaxf(pmax, p0[r]);
#pragma unroll
  for (int r = 0; r < 16; ++r) pmax = fmaxf(pmax, p1[r]);
  { auto rr = __builtin_amdgcn_permlane32_swap(__float_as_uint(pmax), __float_as_uint(pmax), false, false);
    pmax = fmaxf(__uint_as_float(rr[0]), __uint_as_float(rr[1])); }
  if (__builtin_expect(__all(pmax - m_reg <= THR / SCALE), 1)) { mn = m_reg; alpha = 1.f; }
  else { mn = fmaxf(m_reg, pmax); alpha = __builtin_amdgcn_exp2f((m_reg - mn) * C); m_reg = mn; }
  float mnC = -mn * C;
#pragma unroll
  for (int r = 0; r < 16; ++r) p0[r] = fmaf(p0[r], C, mnC);
#pragma unroll
  for (int r = 0; r < 16; ++r) p1[r] = fmaf(p1[r], C, mnC);
#pragma unroll
  for (int r = 0; r < 16; ++r) p0[r] = __builtin_amdgcn_exp2f(p0[r]);
}
__device__ __forceinline__ void finishSM(f32x16& p0, f32x16& p1, float alpha, float& l_reg, bf16x8& pa0, bf16x8& pa1, bf16x8& pa2, bf16x8& pa3) {
#pragma unroll
  for (int r = 0; r < 16; ++r) p1[r] = __builtin_amdgcn_exp2f(p1[r]);
  float ps = 0;
#pragma unroll
  for (int r = 0; r < 16; ++r) ps += p0[r];
#pragma unroll
  for (int r = 0; r < 16; ++r) ps += p1[r];
  { auto rr = __builtin_amdgcn_permlane32_swap(__float_as_uint(ps), __float_as_uint(ps), false, false);
    ps = __uint_as_float(rr[0]) + __uint_as_float(rr[1]); }
  l_reg = l_reg * alpha + ps;
#define PK4(P, BASE, OUT) do { unsigned a0 = cvtpk(P[BASE + 0], P[BASE + 1]), a1 = cvtpk(P[BASE + 2], P[BASE + 3]);   \
    unsigned b0 = cvtpk(P[BASE + 4], P[BASE + 5]), b1 = cvtpk(P[BASE + 6], P[BASE + 7]);                              \
    auto r0 = __builtin_amdgcn_permlane32_swap(a0, b0, false, false); auto r1 = __builtin_amdgcn_permlane32_swap(a1, b1, false, false); \
    u32x4 w = {r0[0], r1[0], r0[1], r1[1]}; OUT = *reinterpret_cast<bf16x8*>(&w); } while (0)
  PK4(p0, 0, pa0); PK4(p0, 8, pa1); PK4(p1, 0, pa2); PK4(p1, 8, pa3);
#undef PK4
}
__device__ __forceinline__ void qkt(f32x16& p0, f32x16& p1, const char* Ks, const char* Rs, const bf16x8* qr, const char* qrl, int r32, int hi) {
  p0 = f32x16{}; p1 = f32x16{};
#pragma unroll
  for (int d0 = 0; d0 < 8; ++d0) { int cb = (d0 * 16 + hi * 8) * 2;
    bf16x8 b0 = *reinterpret_cast<const bf16x8*>(Ks + KSWZ(r32, cb));
    bf16x8 b1 = *reinterpret_cast<const bf16x8*>(Ks + KSWZ(32 + r32, cb));
    p0 = __builtin_amdgcn_mfma_f32_32x32x16_bf16(b0, qr[d0], p0, 0, 0, 0);
    p1 = __builtin_amdgcn_mfma_f32_32x32x16_bf16(b1, qr[d0], p1, 0, 0, 0); }
#pragma unroll
  for (int d0 = 0; d0 < 4; ++d0) { int cb = (d0 * 16 + hi * 8) * 2;
    bf16x8 b0 = *reinterpret_cast<const bf16x8*>(Rs + RSWZ(r32, cb));
    bf16x8 b1 = *reinterpret_cast<const bf16x8*>(Rs + RSWZ(32 + r32, cb));
    const bf16x8 qv = *reinterpret_cast<const bf16x8*>(qrl + d0 * 1024);
    p0 = __builtin_amdgcn_mfma_f32_32x32x16_bf16(b0, qv, p0, 0, 0, 0);
    p1 = __builtin_amdgcn_mfma_f32_32x32x16_bf16(b1, qv, p1, 0, 0, 0); }
}
__device__ __forceinline__ int v_st(int k, int c) { const int kk = (k & ~0xC) | ((k & 4) << 1) | ((k & 8) >> 1); return ((kk >> 3) * 4 + (c >> 5)) * 512 + ((kk & 7) * 32 + (c & 31)) * 2; }
__device__ __forceinline__ int v_rd_base(int lane) { return ((lane & 3) << 3) | (((lane >> 2) & 3) << 6) | (((lane >> 4) & 1) << 5) | (((lane >> 5) & 1) << 8); }
constexpr int v_rd_off(int d0, int ks, int half) { return d0 * 512 + ks * 4096 + half * 2048; }
template <int OFF> __device__ __forceinline__ s16x4 tr_read(int vb) {
  s16x4 r; asm volatile("ds_read_b64_tr_b16 %0, %1 offset:%2" : "=&v"(r) : "v"(vb), "i"(OFF) : "memory"); return r;
}
template <int D0> __device__ __forceinline__ void pv_one(f32x16& od, int vb, bf16x8 pa0, bf16x8 pa1, bf16x8 pa2, bf16x8 pa3) {
  const s16x4 l0 = tr_read<v_rd_off(D0, 0, 0)>(vb), h0 = tr_read<v_rd_off(D0, 0, 1)>(vb), l1 = tr_read<v_rd_off(D0, 1, 0)>(vb), h1 = tr_read<v_rd_off(D0, 1, 1)>(vb);
  const s16x4 l2 = tr_read<v_rd_off(D0, 2, 0)>(vb), h2 = tr_read<v_rd_off(D0, 2, 1)>(vb), l3 = tr_read<v_rd_off(D0, 3, 0)>(vb), h3 = tr_read<v_rd_off(D0, 3, 1)>(vb);
  asm volatile("s_waitcnt lgkmcnt(0)" ::: "memory"); SBAR();
#define PK(L, H) (bf16x8){L[0], L[1], L[2], L[3], H[0], H[1], H[2], H[3]}
  od = __builtin_amdgcn_mfma_f32_32x32x16_bf16(pa0, PK(l0, h0), od, 0, 0, 0);
  od = __builtin_amdgcn_mfma_f32_32x32x16_bf16(pa1, PK(l1, h1), od, 0, 0, 0);
  od = __builtin_amdgcn_mfma_f32_32x32x16_bf16(pa2, PK(l2, h2), od, 0, 0, 0);
  od = __builtin_amdgcn_mfma_f32_32x32x16_bf16(pa3, PK(l3, h3), od, 0, 0, 0);
#undef PK
}
__device__ __forceinline__ void pv_d0(f32x16* o, int vb, bf16x8 pa0, bf16x8 pa1, bf16x8 pa2, bf16x8 pa3) {
  pv_one<0>(o[0], vb, pa0, pa1, pa2, pa3); pv_one<1>(o[1], vb, pa0, pa1, pa2, pa3); pv_one<2>(o[2], vb, pa0, pa1, pa2, pa3); pv_one<3>(o[3], vb, pa0, pa1, pa2, pa3);
}
__device__ __forceinline__ void attn_dense_body(const unsigned short* __restrict__ Qb, const unsigned short* __restrict__ Kh, const unsigned short* __restrict__ Vh,
                                                const unsigned short* __restrict__ Rh, unsigned short* __restrict__ Ob, int seq, char* lds) {
  const int tid = tid_opaque(), wid = tid >> 6, lane = tid & 63, r32 = lane & 31, hi = lane >> 5;
  char* V_lds = lds; char* K_lds = lds + 2 * SHM_V; char* R_lds = lds + 2 * SHM_V + 2 * SHM_K;
  float* ws = (float*)(lds + 2 * SHM_V + 2 * SHM_K + 2 * SHM_R) + wid * 64; float* li_l = ws; float* al_l = ws + 32;
  float m_reg = -1e30f, l_reg = 0; f32x16 o[4] = {}; bf16x8 qr[8]; char* qrl = lds + 2 * SHM_V + 2 * SHM_K + 2 * SHM_R + NW * 64 * 4 + wid * 4096 + lane * 16;
  const unsigned short* Qw = Qb + (long)(wid * QBLK + r32) * LDQ + hi * 8;
#pragma unroll
  for (int d0 = 0; d0 < 8; ++d0) qr[d0] = ld8(Qw + d0 * 16);
#pragma unroll
  for (int d0 = 0; d0 < 4; ++d0) *(bf16x8*)(qrl + d0 * 1024) = ld8(Qw + (8 + d0) * 16);
  const int sr = tid >> 4, sc = (tid & 15) * 8, vst0 = v_st(sr, sc), vst1 = v_st(32 + sr, sc);
  const int rr_ = tid >> 3, rc = (tid & 7) * 8;
  const int vb0 = (int)(uintptr_t)V_lds + v_rd_base(lane);
  struct { bf16x8 vs0, vs1, ks0, ks1, rs; } sr_[1];
#define SLOAD(i, k0) do { sr_[i].vs0 = ld8(&Vh[(long)((k0) + sr) * LDK + sc]); sr_[i].vs1 = ld8(&Vh[(long)((k0) + 32 + sr) * LDK + sc]); \
    sr_[i].ks0 = ld8(&Kh[(long)((k0) + sr) * LDK + sc]); sr_[i].ks1 = ld8(&Kh[(long)((k0) + 32 + sr) * LDK + sc]); sr_[i].rs = ld8(&Rh[(long)((k0) + rr_) * LDR + rc]); } while (0)
#define SWRITE(b, i) do { *(bf16x8*)(V_lds + (b) * SHM_V + vst0) = sr_[i].vs0;          \
    *(bf16x8*)(V_lds + (b) * SHM_V + vst1) = sr_[i].vs1; int kc = sc * 2;               \
    *(bf16x8*)(K_lds + (b) * SHM_K + KSWZ(sr, kc)) = sr_[i].ks0;                       \
    *(bf16x8*)(K_lds + (b) * SHM_K + KSWZ(32 + sr, kc)) = sr_[i].ks1;                  \
    *(bf16x8*)(R_lds + (b) * SHM_R + RSWZ(rr_, rc * 2)) = sr_[i].rs; } while (0)
#define SWAIT() asm volatile("s_waitcnt vmcnt(0)" ::: "memory")
#define RESC(a) do { if (__any((a) < 1.f)) { if (hi == 0) al_l[r32] = (a); asm volatile("s_waitcnt lgkmcnt(0)" ::: "memory"); \
    _Pragma("unroll") for (int d = 0; d < 4; ++d) _Pragma("unroll") for (int r = 0; r < 16; ++r) o[d][r] *= al_l[crow(r, hi)]; } } while (0)
  f32x16 pA0, pA1, pB0, pB1; float mnA, mnB, alA, alB; bf16x8 pa0, pa1, pa2, pa3; const int NT = seq / KVBLK;
  constexpr int SE = 0, SO = 0;
  SLOAD(SE, 0); asm volatile("s_waitcnt vmcnt(0)" ::: "memory"); SWRITE(0, SE); __syncthreads();
  qkt(pA0, pA1, K_lds, R_lds, qr, qrl, r32, hi); partialSM(pA0, pA1, m_reg, mnA, alA);
  SLOAD(SO, KVBLK);
  SWAIT(); SWRITE(1, SO); __syncthreads();
  for (int j = 1; j + 1 < NT; j += 2) {
    SBAR(); qkt(pB0, pB1, K_lds + SHM_K, R_lds + SHM_R, qr, qrl, r32, hi);
    finishSM(pA0, pA1, alA, l_reg, pa0, pa1, pa2, pa3); SBAR();
    SLOAD(SO, (j + 1) * KVBLK); SBAR();
    pv_d0(o, vb0, pa0, pa1, pa2, pa3); partialSM(pB0, pB1, m_reg, mnB, alB);
    __syncthreads(); SWAIT(); SWRITE(0, SE);
    RESC(alB); __syncthreads();
    SBAR(); qkt(pA0, pA1, K_lds, R_lds, qr, qrl, r32, hi);
    finishSM(pB0, pB1, alB, l_reg, pa0, pa1, pa2, pa3); SBAR();
    SLOAD(SE, (j + 2) * KVBLK); SBAR();
    pv_d0(o, vb0 + (int)SHM_V, pa0, pa1, pa2, pa3); partialSM(pA0, pA1, m_reg, mnA, alA);
    __syncthreads(); SWAIT(); SWRITE(1, SO);
    RESC(alA); __syncthreads();
  }
  SBAR(); qkt(pB0, pB1, K_lds + SHM_K, R_lds + SHM_R, qr, qrl, r32, hi);
  finishSM(pA0, pA1, alA, l_reg, pa0, pa1, pa2, pa3); SBAR();
  pv_d0(o, vb0, pa0, pa1, pa2, pa3); partialSM(pB0, pB1, m_reg, mnB, alB);
  __syncthreads(); RESC(alB);
  finishSM(pB0, pB1, alB, l_reg, pa0, pa1, pa2, pa3); SBAR();
  pv_d0(o, vb0 + (int)SHM_V, pa0, pa1, pa2, pa3);
  if (hi == 0) li_l[r32] = l_reg; asm volatile("s_waitcnt lgkmcnt(0)" ::: "memory");
  float rli[16];
#pragma unroll
  for (int r = 0; r < 16; ++r) rli[r] = __builtin_amdgcn_rcpf(li_l[crow(r, hi)]);
  unsigned short* Ow = Ob + (long)(wid * QBLK) * LDO;
#pragma unroll
  for (int r = 0; r < 16; ++r) { int orow = crow(r, hi);
#pragma unroll
    for (int d0 = 0; d0 < 4; ++d0) Ow[(long)orow * LDO + d0 * 32 + r32] = (unsigned short)(cvtpk(o[d0][r] * rli[r], 0.f) & 0xffffu); }
  __syncthreads();
#undef SLOAD
#undef SWRITE
#undef SWAIT
#undef RESC
}
__device__ __forceinline__ void hgrn_chunk_seq(const unsigned short* __restrict__ QH, const unsigned short* __restrict__ KH, const unsigned short* __restrict__ Zi, int ldz,
                                               const float* __restrict__ GM, const float* __restrict__ GL, unsigned short* __restrict__ OS, int dir, char* lds) {
  const int tid = tid_opaque(), wid = __builtin_amdgcn_readfirstlane(tid >> 6), lane = tid & 63, r32 = lane & 31, hi = lane >> 5, rb = wid & 1, vq = wid >> 1;
  char* Kimg = lds; char* KTimg = lds + 16384; char* Vimg = lds + 32768; char* Simg = lds + 49152; float* gtab = (float*)(lds + 81920);
  const int sr = tid >> 4, sc = (tid & 15) * 8;
  const int vbV = (int)(uintptr_t)Vimg + v_rd_base(lane) + vq * 512, vbS = (int)(uintptr_t)Simg + v_rd_base(lane) + vq * 512, vbK = (int)(uintptr_t)KTimg + v_rd_base(lane) + 2 * rb * 512;
  f32x16 St0 = {}, St1 = {};
#pragma unroll 1
  for (int c = 0; c < 64; ++c) {
    const int cn = dir ? 63 - c : c; const long n0 = (long)cn * 64;
    if (tid < 128) gtab[tid] = GM[cn * 1024 + tid]; else if (tid < 256) gtab[tid] = GL[cn * 1024 + tid - 128];
#pragma unroll
    for (int e = 0; e < 2; ++e) { const int t = sr + 32 * e; const long n = n0 + (dir ? 63 - t : t);
      const bf16x8 k8 = ld8(KH + n * 1024 + sc), v8 = ld8(Zi + n * ldz + sc);
      *(bf16x8*)(Kimg + KSWZ(t, sc * 2)) = k8; *(bf16x8*)(KTimg + v_st(t, sc)) = k8; *(bf16x8*)(Vimg + v_st(t, sc)) = v8; }
    bf16x8 qr[8];
    { const int t = 32 * rb + r32; const long n = n0 + (dir ? 63 - t : t);
#pragma unroll
      for (int d0 = 0; d0 < 8; ++d0) qr[d0] = ld8(QH + n * 1024 + d0 * 16 + hi * 8); }
    __syncthreads();
#pragma unroll
    for (int r = 0; r < 16; ++r) { const int k0 = 64 * rb + crow(r, hi), k1 = k0 + 32;
      St0[r] *= gtab[k0]; St1[r] *= gtab[k1];
      *(unsigned short*)(Simg + rb * 16384 + v_st(k0 & 63, 32 * vq + r32)) = (unsigned short)bfr(St0[r]);
      *(unsigned short*)(Simg + rb * 16384 + v_st(k1 & 63, 32 * vq + r32)) = (unsigned short)bfr(St1[r]); }
    __syncthreads();
    f32x16 p0 = {}, p1 = {};
#pragma unroll
    for (int d0 = 0; d0 < 8; ++d0) { const int cb = (d0 * 16 + hi * 8) * 2;
      const bf16x8 b0 = *reinterpret_cast<const bf16x8*>(Kimg + KSWZ(r32, cb));
      p0 = __builtin_amdgcn_mfma_f32_32x32x16_bf16(b0, qr[d0], p0, 0, 0, 0);
      if (rb) { const bf16x8 b1 = *reinterpret_cast<const bf16x8*>(Kimg + KSWZ(32 + r32, cb)); p1 = __builtin_amdgcn_mfma_f32_32x32x16_bf16(b1, qr[d0], p1, 0, 0, 0); } }
#pragma unroll
    for (int r = 0; r < 16; ++r) { const bool keep = crow(r, hi) <= r32; if (rb) p1[r] = keep ? p1[r] : 0.f; else p0[r] = keep ? p0[r] : 0.f; }
    bf16x8 pa0, pa1, pa2, pa3;
#define PK4(P, BASE, OUT) do { unsigned a0 = bfpk(P[BASE + 0], P[BASE + 1]), a1 = bfpk(P[BASE + 2], P[BASE + 3]);   \
    unsigned b0 = bfpk(P[BASE + 4], P[BASE + 5]), b1 = bfpk(P[BASE + 6], P[BASE + 7]);                              \
    auto r0 = __builtin_amdgcn_permlane32_swap(a0, b0, false, false); auto r1 = __builtin_amdgcn_permlane32_swap(a1, b1, false, false); \
    u32x4 w = {r0[0], r1[0], r0[1], r1[1]}; OUT = *reinterpret_cast<bf16x8*>(&w); } while (0)
    PK4(p0, 0, pa0); PK4(p0, 8, pa1); PK4(p1, 0, pa2); PK4(p1, 8, pa3);
#undef PK4
    f32x16 o = {};
    pv_one<0>(o, vbV, pa0, pa1, pa2, pa3);
    pv_one<0>(o, vbS, qr[0], qr[1], qr[2], qr[3]);
    pv_one<0>(o, vbS + 16384, qr[4], qr[5], qr[6], qr[7]);
#pragma unroll
    for (int r = 0; r < 16; ++r) { const int t = 32 * rb + crow(r, hi); const long n = n0 + (dir ? 63 - t : t);
      OS[n * 1024 + 32 * vq + r32] = (unsigned short)bfr(o[r]); }
#define PKF(L, H) (bf16x8){L[0], L[1], L[2], L[3], H[0], H[1], H[2], H[3]}
    { const s16x4 vl0 = tr_read<v_rd_off(0, 0, 0)>(vbV), vh0 = tr_read<v_rd_off(0, 0, 1)>(vbV), vl1 = tr_read<v_rd_off(0, 1, 0)>(vbV), vh1 = tr_read<v_rd_off(0, 1, 1)>(vbV);
      const s16x4 vl2 = tr_read<v_rd_off(0, 2, 0)>(vbV), vh2 = tr_read<v_rd_off(0, 2, 1)>(vbV), vl3 = tr_read<v_rd_off(0, 3, 0)>(vbV), vh3 = tr_read<v_rd_off(0, 3, 1)>(vbV);
      const s16x4 al0 = tr_read<v_rd_off(0, 0, 0)>(vbK), ah0 = tr_read<v_rd_off(0, 0, 1)>(vbK), al1 = tr_read<v_rd_off(0, 1, 0)>(vbK), ah1 = tr_read<v_rd_off(0, 1, 1)>(vbK);
      const s16x4 al2 = tr_read<v_rd_off(0, 2, 0)>(vbK), ah2 = tr_read<v_rd_off(0, 2, 1)>(vbK), al3 = tr_read<v_rd_off(0, 3, 0)>(vbK), ah3 = tr_read<v_rd_off(0, 3, 1)>(vbK);
      const s16x4 bl0 = tr_read<v_rd_off(1, 0, 0)>(vbK), bh0 = tr_read<v_rd_off(1, 0, 1)>(vbK), bl1 = tr_read<v_rd_off(1, 1, 0)>(vbK), bh1 = tr_read<v_rd_off(1, 1, 1)>(vbK);
      const s16x4 bl2 = tr_read<v_rd_off(1, 2, 0)>(vbK), bh2 = tr_read<v_rd_off(1, 2, 1)>(vbK), bl3 = tr_read<v_rd_off(1, 3, 0)>(vbK), bh3 = tr_read<v_rd_off(1, 3, 1)>(vbK);
      asm volatile("s_waitcnt lgkmcnt(0)" ::: "memory"); SBAR();
      St0 = __builtin_amdgcn_mfma_f32_32x32x16_bf16(PKF(al0, ah0), PKF(vl0, vh0), St0, 0, 0, 0); St0 = __builtin_amdgcn_mfma_f32_32x32x16_bf16(PKF(al1, ah1), PKF(vl1, vh1), St0, 0, 0, 0);
      St0 = __builtin_amdgcn_mfma_f32_32x32x16_bf16(PKF(al2, ah2), PKF(vl2, vh2), St0, 0, 0, 0); St0 = __builtin_amdgcn_mfma_f32_32x32x16_bf16(PKF(al3, ah3), PKF(vl3, vh3), St0, 0, 0, 0);
      St1 = __builtin_amdgcn_mfma_f32_32x32x16_bf16(PKF(bl0, bh0), PKF(vl0, vh0), St1, 0, 0, 0); St1 = __builtin_amdgcn_mfma_f32_32x32x16_bf16(PKF(bl1, bh1), PKF(vl1, vh1), St1, 0, 0, 0);
      St1 = __builtin_amdgcn_mfma_f32_32x32x16_bf16(PKF(bl2, bh2), PKF(vl2, vh2), St1, 0, 0, 0); St1 = __builtin_amdgcn_mfma_f32_32x32x16_bf16(PKF(bl3, bh3), PKF(vl3, vh3), St1, 0, 0, 0); }
#undef PKF
#pragma unroll
    for (int r = 0; r < 16; ++r) { const int k0 = 64 * rb + crow(r, hi); St0[r] *= gtab[128 + k0]; St1[r] *= gtab[128 + k0 + 32]; }
    __syncthreads();
  }
}
}

constexpr int NWAVES = 8;
#define GAS __attribute__((address_space(1)))
#define LAS __attribute__((address_space(3)))
#define CAS __attribute__((address_space(4)))
typedef unsigned short bf16;
typedef unsigned v4u __attribute__((ext_vector_type(4)));
typedef unsigned v2u __attribute__((ext_vector_type(2)));
typedef float f32x4 __attribute__((ext_vector_type(4)));
typedef float f32x2 __attribute__((ext_vector_type(2)));
typedef float f32x16 __attribute__((ext_vector_type(16)));
typedef GAS unsigned gu32;
#define RLX_AGENT __ATOMIC_RELAXED, __HIP_MEMORY_SCOPE_AGENT
#define LDS_WAIT() asm volatile("s_waitcnt lgkmcnt(0)" ::: "memory")
#define VM_WAIT() asm volatile("s_waitcnt vmcnt(0)" ::: "memory")
constexpr int RING_BYTES = 131072, MISC_OFF = RING_BYTES + 320, LDS_BYTES = 147456;

__device__ __forceinline__ float bf2f(unsigned short b) { return __uint_as_float(((unsigned)b) << 16); }
__device__ __forceinline__ unsigned f2bf(float f) { unsigned u = __float_as_uint(f); return (u + 0x7fffu + ((u >> 16) & 1u)) >> 16; }
__device__ __forceinline__ unsigned pk2(float lo, float hi) { return pg8::cvt_pk_bf16(lo, hi); }
__device__ __forceinline__ float sigmf(float x) { return __builtin_amdgcn_rcpf(1.0f + __expf(-x)); }
__device__ __forceinline__ float wave_sum(float v) {
#pragma unroll
    for (int o = 1; o < 64; o <<= 1) v += __shfl_xor(v, o);
    return v;
}
__device__ __forceinline__ void ld16bf(const bf16* p, float (&f)[16]) {
    const v4u a = *(const v4u*)p, b = *(const v4u*)(p + 8);
    const unsigned w[8] = {a.x, a.y, a.z, a.w, b.x, b.y, b.z, b.w};
#pragma unroll
    for (int i = 0; i < 8; ++i) { f[2 * i] = __uint_as_float(w[i] << 16); f[2 * i + 1] = __uint_as_float(w[i] & 0xffff0000u); }
}
__device__ __forceinline__ void ld8bf(const bf16* p, float (&f)[8]) {
    const v4u a = *(const v4u*)p; const unsigned w[4] = {a.x, a.y, a.z, a.w};
#pragma unroll
    for (int i = 0; i < 4; ++i) { f[2 * i] = __uint_as_float(w[i] << 16); f[2 * i + 1] = __uint_as_float(w[i] & 0xffff0000u); }
}
__device__ __forceinline__ void ld16f(const float* p, float (&f)[16]) {
#pragma unroll
    for (int i = 0; i < 4; ++i) { const f32x4 v = *(const f32x4*)(p + 4 * i); f[4 * i] = v[0]; f[4 * i + 1] = v[1]; f[4 * i + 2] = v[2]; f[4 * i + 3] = v[3]; }
}
__device__ __forceinline__ void st16f(float* p, const float (&f)[16]) {
#pragma unroll
    for (int i = 0; i < 4; ++i) *(f32x4*)(p + 4 * i) = (f32x4){f[4 * i], f[4 * i + 1], f[4 * i + 2], f[4 * i + 3]};
}
__device__ __forceinline__ void st16bf(bf16* p, const float (&f)[16]) {
    v4u a, b; a.x = pk2(f[0], f[1]); a.y = pk2(f[2], f[3]); a.z = pk2(f[4], f[5]); a.w = pk2(f[6], f[7]);
    b.x = pk2(f[8], f[9]); b.y = pk2(f[10], f[11]); b.z = pk2(f[12], f[13]); b.w = pk2(f[14], f[15]);
    *(v4u*)p = a; *(v4u*)(p + 8) = b;
}
__device__ __forceinline__ void st8bf(bf16* p, const float (&f)[8]) {
    v4u a; a.x = pk2(f[0], f[1]); a.y = pk2(f[2], f[3]); a.z = pk2(f[4], f[5]); a.w = pk2(f[6], f[7]); *(v4u*)p = a;
}

#define XB_TMO      128
#define XB_XCNT(j)  (256  + 64 * (j))
#define XB_XSUB(j)  (1280 + 64 * (j))
#define XB_XGEN(j)  (2304 + 64 * (j))
#define XB_TOP      3328
#define XB_TOPGEN   3392
#define XCD_BAR_WORDS 3456
#define XB_SPIN_CAP (1u << 18)

__device__ __forceinline__ unsigned xb_ld(unsigned* p)              { return __hip_atomic_load(p, __ATOMIC_RELAXED, __HIP_MEMORY_SCOPE_AGENT); }
__device__ __forceinline__ unsigned xb_add(unsigned* p, unsigned v) { return __hip_atomic_fetch_add(p, v, __ATOMIC_RELAXED, __HIP_MEMORY_SCOPE_AGENT); }
__device__ __forceinline__ unsigned xb_xcc_id() { return (unsigned)__builtin_amdgcn_s_getreg((3 << 11) | 20) & 0xFu; }
#define XB_SPIN(cond, bar) do { unsigned _sp = 0; while (cond) { __builtin_amdgcn_s_sleep(1); \
    if ((++_sp & 255u) == 0u) { if (xb_ld(&(bar)[XB_TMO])) break; if (_sp > XB_SPIN_CAP) { atomicAdd(&(bar)[XB_TMO], 1u); break; } } } } while (0)

struct XcdBarrier {
    unsigned* bar; unsigned x;
    volatile LAS unsigned* st;
};

__device__ __forceinline__ XcdBarrier xcd_barrier_post(unsigned* bar, volatile LAS unsigned* st) {
    XcdBarrier b; b.bar = bar; b.x = xb_xcc_id(); b.st = st;
    if (threadIdx.x == 0) (void)xb_add(&bar[XB_XCNT(b.x)], 1u);
    return b;
}
__device__ __forceinline__ void xcd_barrier_complete(unsigned* bar, unsigned x, unsigned& nloc, unsigned& nx) {
    const unsigned G = gridDim.x * gridDim.y * gridDim.z;
    unsigned sum, cnt, mine, sp = 0u;
    for (;;) {
        sum = 0u; cnt = 0u; mine = 0u;
#pragma unroll
        for (unsigned j = 0; j < 16; ++j) { const unsigned c = xb_ld(&bar[XB_XCNT(j)]); sum += c; cnt += (c > 0u) ? 1u : 0u; mine = (j == x) ? c : mine; }
        if (sum == G) break;
        __builtin_amdgcn_s_sleep(1);
        if ((++sp & 255u) == 0u) { if (xb_ld(&bar[XB_TMO])) break; if (sp > XB_SPIN_CAP) { atomicAdd(&bar[XB_TMO], 1u); break; } }
    }
    nloc = mine > 0u ? mine : 1u; nx = cnt > 0u ? cnt : 1u;
}

__device__ __forceinline__ void xcd_barrier(const XcdBarrier& b) {
    asm volatile("s_waitcnt vmcnt(0)" ::: "memory");
    __syncthreads();
    if (threadIdx.x == 0) {
        unsigned* bar = b.bar;
        __builtin_amdgcn_s_waitcnt(0);
        unsigned nloc = b.st[0], nx = b.st[1];
        if (nloc == 0u) { xcd_barrier_complete(bar, b.x, nloc, nx); b.st[0] = nloc; b.st[1] = nx; }
        const unsigned old = xb_add(&bar[XB_XSUB(b.x)], 1u);
        const unsigned gen = old / nloc;
        if (old + 1u == (gen + 1u) * nloc) {
            __builtin_amdgcn_fence(__ATOMIC_RELEASE, "agent");
            asm volatile("s_waitcnt vmcnt(0)" ::: "memory");
            const unsigned og = xb_add(&bar[XB_TOP], 1u);
            const unsigned tg = og / nx;
            if (og + 1u == (tg + 1u) * nx) xb_add(&bar[XB_TOPGEN], 1u);
            else XB_SPIN(xb_ld(&bar[XB_TOPGEN]) == tg, bar);
            __builtin_amdgcn_fence(__ATOMIC_ACQUIRE, "agent");
            xb_add(&bar[XB_XGEN(b.x)], 1u);
            asm volatile("s_waitcnt vmcnt(0)" ::: "memory");
        } else {
            XB_SPIN(xb_ld(&bar[XB_XGEN(b.x)]) == gen, bar);
            __builtin_amdgcn_fence(__ATOMIC_ACQUIRE, "agent");
            asm volatile("s_waitcnt vmcnt(0)" ::: "memory");
        }
    }
    __syncthreads();
}

__device__ __forceinline__ int uq_perm(int n) { const int h = n / 192, j = n % 192; if (j < 128) return n; const int jj = j - 128; return h * 192 + 128 + 2 * (jj & 31) + (jj >> 5); }
struct TrItem { const float* W; bf16* WT; int ldn, k0, kvalid, n0, ldk, kd0, drow0, perm; };
__device__ __forceinline__ void tr_load(const TrItem& T, float (&v)[32], int lane) {
#pragma unroll
    for (int i = 0; i < 32; ++i) { const int kk = 2 * i + (lane >> 5); v[i] = kk < T.kvalid ? __builtin_nontemporal_load(&T.W[(size_t)(T.k0 + kk) * T.ldn + T.n0 + (lane & 31)]) : 0.f; }
}
__device__ __forceinline__ void tr_store(const TrItem& T, const float (&v)[32], LAS float* scr, int lane) {
#pragma unroll
    for (int i = 0; i < 32; ++i) scr[(2 * i + (lane >> 5)) * 33 + (lane & 31)] = v[i];
    LDS_WAIT(); asm volatile("" ::: "memory");
    const int c = lane & 7;
#pragma unroll
    for (int j = 0; j < 4; ++j) { const int n = (lane >> 3) + 8 * j; const LAS float* s = scr + (8 * c) * 33 + n;
        v4u o; o.x = pk2(s[0 * 33], s[1 * 33]); o.y = pk2(s[2 * 33], s[3 * 33]); o.z = pk2(s[4 * 33], s[5 * 33]); o.w = pk2(s[6 * 33], s[7 * 33]);
        const int drow = T.perm ? uq_perm(T.n0 + n) : T.drow0 + n;
        *(GAS v4u*)(T.WT + (size_t)drow * T.ldk + T.kd0 + 8 * c) = o; }
    LDS_WAIT(); asm volatile("" ::: "memory");
}
struct LayerW { const float *w_in, *w2, *a2, *g2, *uq, *ukv, *br, *wo, *w1, *w2m, *wpe, *wpg; };
__device__ __forceinline__ TrItem tr_which(const LayerW& L, unsigned char* ws, int it) {
    bf16* WIN = (bf16*)(ws + WS_WIN); bf16* LORA = (bf16*)(ws + WS_LORA); bf16* UQ = (bf16*)(ws + WS_UQ); bf16* UKV = (bf16*)(ws + WS_UKV); bf16* BR = (bf16*)(ws + WS_BR);
    bf16* WO = (bf16*)(ws + WS_WO); bf16* W1 = (bf16*)(ws + WS_W1); bf16* W2 = (bf16*)(ws + WS_W2); bf16* WPE = (bf16*)(ws + WS_WPE); bf16* WPG = (bf16*)(ws + WS_WPG);
    constexpr int I_IN = 32 * 503, I_LW = 64, I_LA = 64, I_LG = 96, I_UQ = 12 * 48, I_UKV = 8 * 64, I_BR = 3 * 16 * 64, I_WO = 32 * 64, I_W1 = 32 * 256, I_W2 = 128 * 64, I_PE = 4 * 64;
    int r = it;
    if (r < I_IN) { const int kb = r / 503, n0 = (r % 503) * 32; const int drow = n0 < 3488 ? n0 : (n0 < 9952 ? n0 + 96 : n0 + 288); return TrItem{L.w_in, WIN, IN_W, kb * 64, 64, n0, 2048, kb * 64, drow, 0}; } r -= I_IN;
    if (r < I_LW) { const int d = r >> 5, n0 = (r & 31) * 32; return TrItem{L.w2 + d * 65536, LORA, 1024, 0, 64, n0, 256, 64 * d, d * 1024 + n0, 0}; } r -= I_LW;
    if (r < I_LA) { const int d = r >> 5, n0 = (r & 31) * 32; return TrItem{L.a2 + d * 65536, LORA, 1024, 0, 64, n0, 256, 128 + 64 * d, 2048 + d * 1024 + n0, 0}; } r -= I_LA;
    if (r < I_LG) { const int kb = r >> 5, n0 = (r & 31) * 32; return TrItem{L.g2, LORA + (size_t)4096 * 256, 1024, kb * 64, 160 - kb * 64, n0, 256, 64 * kb, n0, 0}; } r -= I_LG;
    if (r < I_UQ) { const int kb = r / 48, n0 = (r % 48) * 32; return TrItem{L.uq, UQ, 1536, kb * 64, 64, n0, 768, kb * 64, 0, 1}; } r -= I_UQ;
    if (r < I_UKV) { const int kb = r >> 6, n0 = (r & 63) * 32; return TrItem{L.ukv, UKV, 2048, kb * 64, 64, n0, 512, kb * 64, n0, 0}; } r -= I_UKV;
    if (r < I_BR) { const int nb3 = r >> 10, q = r & 1023, kb = q >> 6, n0 = (q & 63) * 32; return TrItem{L.br + (size_t)nb3 * 1024 * 2048, BR + (size_t)nb3 * 2048 * 1024, 2048, kb * 64, 64, n0, 1024, kb * 64, n0, 0}; } r -= I_BR;
    if (r < I_WO) { const int kb = r >> 6, n0 = (r & 63) * 32; return TrItem{L.wo, WO, 2048, kb * 64, 64, n0, 2048, kb * 64, n0, 0}; } r -= I_WO;
    if (r < I_W1) { const int kb = r >> 8, n0 = (r & 255) * 32; return TrItem{L.w1, W1, 8192, kb * 64, 64, n0, 2048, kb * 64, n0, 0}; } r -= I_W1;
    if (r < I_W2) { const int kb = r >> 6, n0 = (r & 63) * 32; return TrItem{L.w2m, W2, 2048, kb * 64, 64, n0, 8192, kb * 64, n0, 0}; } r -= I_W2;
    if (r < I_PE) { const int kb = r >> 6, n0 = (r & 63) * 32; return TrItem{L.wpe, WPE, 2048, kb * 64, 64, n0, 256, kb * 64, n0, 0}; } r -= I_PE;
    { const int kb = r >> 6, n0 = (r & 63) * 32; return TrItem{L.wpg, WPG, 2048, kb * 64, 64, n0, 2048, kb * 64, n0, 0}; }
}
constexpr int TR_EARLY = 32 * 503 + 64 + 64 + 96 + 12 * 48 + 8 * 64;
static_assert(TR_EARLY % 8 == 0, "the phase-4 filler hands out chunks of 8 items");
__device__ __forceinline__ void convert_weights(const LayerW& L, unsigned char* ws, LAS float* scr, int gw, int NGW, int lane, int first) {
    constexpr int NITEMS = 32 * 503 + 64 + 64 + 96 + 12 * 48 + 8 * 64 + 3 * 16 * 64 + 32 * 64 + 32 * 256 + 128 * 64 + 4 * 64 + 32 * 64;
    if (first + gw >= NITEMS) return;
    TrItem cur = tr_which(L, ws, first + gw); float v[32]; tr_load(cur, v, lane);
#pragma unroll 1
    for (int it = first + gw; it < NITEMS; it += NGW) {
        const int nx = it + NGW; TrItem nxt = cur; float w[32];
        if (nx < NITEMS) { nxt = tr_which(L, ws, nx); tr_load(nxt, w, lane); }
        tr_store(cur, v, scr, lane);
        if (nx < NITEMS) {
#pragma unroll
            for (int i = 0; i < 32; ++i) v[i] = w[i]; }
        cur = nxt;
    }
}
template <bool OUT32> __device__ __forceinline__ void rms_row(const float* xrow, const float* g, void* orow, int lane) {
    const f32x4* xr = (const f32x4*)xrow + lane; f32x4 v[8]; float s = 0.f;
#pragma unroll
    for (int j = 0; j < 8; ++j) { v[j] = xr[64 * j]; s += (v[j][0] * v[j][0] + v[j][1] * v[j][1]) + (v[j][2] * v[j][2] + v[j][3] * v[j][3]); }
    const float rstd = __builtin_amdgcn_rsqf(wave_sum(s) * (1.0f / 2048.0f) + 1e-6f);
#pragma unroll
    for (int j = 0; j < 8; ++j) { const f32x4 gv = ((const f32x4*)g)[64 * j + lane]; const f32x4 o = v[j] * rstd * gv;
        if (OUT32) ((f32x4*)orow)[64 * j + lane] = o; else { v2u w; w.x = pk2(o[0], o[1]); w.y = pk2(o[2], o[3]); ((v2u*)orow)[64 * j + lane] = w; } }
}
template <int NCH> __device__ __forceinline__ void shiftN(const bf16* Z, size_t m, bool hp, bool hn, int c, const float* mu, float (&u)[NCH]) {
    float z[NCH], zp[NCH], zn[NCH];
    if constexpr (NCH == 16) { ld16bf(Z + m * ZW + c, z); if (hp) ld16bf(Z + (m - 1) * ZW + c, zp); if (hn) ld16bf(Z + (m + 1) * ZW + c, zn); }
    else { ld8bf(Z + m * ZW + c, z); if (hp) ld8bf(Z + (m - 1) * ZW + c, zp); if (hn) ld8bf(Z + (m + 1) * ZW + c, zn); }
#pragma unroll
    for (int i = 0; i < NCH; i += 4) { const f32x4 m0 = *(const f32x4*)(mu + c + i), m1 = *(const f32x4*)(mu + RWKV_W + c + i);
#pragma unroll
        for (int j = 0; j < 4; ++j) { const float zz = z[i + j], p = hp ? zp[i + j] : 0.f, n = hn ? zn[i + j] : 0.f; u[i + j] = zz + m0[j] * (p - zz) + m1[j] * (n - zz); } }
}
struct PreP { const float *mu, *kk, *lb, *qg, *kvg, *COS, *SIN; };
__device__ __forceinline__ void unpk8(const v4u a, float (&f)[8]) { const unsigned w[4] = {a.x, a.y, a.z, a.w};
#pragma unroll
    for (int i = 0; i < 4; ++i) { f[2 * i] = __uint_as_float(w[i] << 16); f[2 * i + 1] = __uint_as_float(w[i] & 0xffff0000u); } }
__device__ __forceinline__ void pre_run_rwkv(size_t m0, const PreP& P, unsigned char* ws, int lane) {
    const bf16* Z = (const bf16*)(ws + WS_Z);
    const int s0 = (int)(m0 & (SEQ - 1)); const bool hp = s0 > 0, hn = s0 + 4 < SEQ;
    unsigned z_ = 0u; asm volatile("" : "+v"(z_)); const v4u zero4 = {z_, z_, z_, z_};
    v4u ra[6], rb[6];
#pragma unroll
    for (int i = 0; i < 6; ++i) { const bool ok = i == 0 ? hp : (i == 5 ? hn : true); const bf16* p = Z + (m0 + i - 1) * ZW + 16 * lane; ra[i] = ok ? *(const v4u*)p : zero4; rb[i] = ok ? *(const v4u*)(p + 8) : zero4; }
#pragma unroll
    for (int sec = 0; sec < 3; ++sec) {
        const int c = sec * 1024 + 16 * lane;
        v4u na[6], nb[6];
#pragma unroll
        for (int i = 0; i < 6; ++i) { const bool ok = i == 0 ? hp : (i == 5 ? hn : true);
            if (sec < 2) { const bf16* p = Z + (m0 + i - 1) * ZW + c + 1024; na[i] = ok ? *(const v4u*)p : zero4; nb[i] = ok ? *(const v4u*)(p + 8) : zero4; }
            else { na[i] = (ok && lane < 52) ? *(const v4u*)(Z + (m0 + i - 1) * ZW + 3072 + 8 * lane) : zero4; nb[i] = zero4; } }
        float m0v[16], m1v[16]; ld16f(P.mu + c, m0v); ld16f(P.mu + RWKV_W + c, m1v);
        float kkv[16]; if (sec == 1) ld16f(P.kk + 16 * lane, kkv);
#pragma unroll
        for (int t = 0; t < 4; ++t) { float zp[16], zz[16], zn[16], u[16];
            { float h0[8], h1[8]; unpk8(ra[t], h0); unpk8(rb[t], h1);
#pragma unroll
              for (int i = 0; i < 8; ++i) { zp[i] = h0[i]; zp[8 + i] = h1[i]; } }
            { float h0[8], h1[8]; unpk8(ra[t + 1], h0); unpk8(rb[t + 1], h1);
#pragma unroll
              for (int i = 0; i < 8; ++i) { zz[i] = h0[i]; zz[8 + i] = h1[i]; } }
            { float h0[8], h1[8]; unpk8(ra[t + 2], h0); unpk8(rb[t + 2], h1);
#pragma unroll
              for (int i = 0; i < 8; ++i) { zn[i] = h0[i]; zn[8 + i] = h1[i]; } }
#pragma unroll
            for (int i = 0; i < 16; ++i) u[i] = zz[i] + m0v[i] * (zp[i] - zz[i]) + m1v[i] * (zn[i] - zz[i]);
            const size_t o = (m0 + t) * 1024 + 16 * lane;
            if (sec == 0) st16bf((bf16*)(ws + WS_R) + o, u);
            else if (sec == 2) st16bf((bf16*)(ws + WS_V) + o, u);
            else { st16bf((bf16*)(ws + WS_KS) + o, u); float ss = 0.f;
#pragma unroll
                for (int i = 0; i < 16; ++i) { u[i] *= kkv[i]; ss += u[i] * u[i]; }
                ss += __shfl_xor(ss, 1); ss += __shfl_xor(ss, 2);
                const float inv = __builtin_amdgcn_rsqf(fmaxf(ss, 1e-24f));
                if ((lane & 3) == 0) ((float*)(ws + WS_KAP))[(m0 + t) * 16 + (lane >> 2)] = inv; } }
#pragma unroll
        for (int i = 0; i < 6; ++i) { ra[i] = na[i]; rb[i] = nb[i]; }
    }
    {
        const int c = 3072 + 8 * lane;
        if (lane < 52) {
            float m0v[8], m1v[8];
#pragma unroll
            for (int i = 0; i < 8; i += 4) { const f32x4 a = *(const f32x4*)(P.mu + c + i), b = *(const f32x4*)(P.mu + RWKV_W + c + i);
#pragma unroll
                for (int j = 0; j < 4; ++j) { m0v[i + j] = a[j]; m1v[i + j] = b[j]; } }
#pragma unroll
            for (int t = 0; t < 4; ++t) { float zp[8], zz[8], zn[8], u[8]; unpk8(ra[t], zp); unpk8(ra[t + 1], zz); unpk8(ra[t + 2], zn);
#pragma unroll
                for (int i = 0; i < 8; ++i) { u[i] = zz[i] + m0v[i] * (zp[i] - zz[i]) + m1v[i] * (zn[i] - zz[i]); if (lane < 16) { const float e_ = __builtin_amdgcn_exp2f(-2.8853900817779268f * __builtin_fabsf(u[i])), th_ = (1.0f - e_) * __builtin_amdgcn_rcpf(1.0f + e_); u[i] = u[i] < 0.f ? -th_ : th_; }     else if (lane >= 32) u[i] = sigmf(u[i]); }
                st8bf((bf16*)(ws + WS_ALORA) + (lane < 32 ? (size_t)0 : (size_t)M * 256) + (m0 + t) * 256 + 8 * (lane & 31), u); }
        } else {
#pragma unroll
            for (int t = 0; t < 4; ++t) *(v4u*)((bf16*)(ws + WS_ALORA) + (size_t)M * 256 + (m0 + t) * 256 + 8 * (lane & 31)) = zero4;
        }
    }
}
__device__ __forceinline__ void pre_token(size_t m, const PreP& P, unsigned char* ws, int lane) {
    const bf16* Z = (const bf16*)(ws + WS_Z);
    float a[8], b[8], kvv[8]; ld8bf(Z + m * ZW + ZO_C + 8 * lane, a); if (lane < 32) ld8bf(Z + m * ZW + ZO_C + 512 + 8 * lane, b); ld8bf(Z + m * ZW + ZO_C + 768 + 8 * lane, kvv);
    const float tr = bf2f(Z[m * ZW + ZO_C + 1280 + lane]); const float cc_ = P.COS[m * 32 + (lane & 31)], sn_ = P.SIN[m * 32 + (lane & 31)];
    { float ss = 0.f;
#pragma unroll
      for (int i = 0; i < 8; ++i) { ss += a[i] * a[i]; if (lane < 32) ss += b[i] * b[i]; }
      const float rstd = __builtin_amdgcn_rsqf(wave_sum(ss) * (1.0f / 768.0f) + 1e-6f);
      bf16* O = (bf16*)(ws + WS_CQN) + m * 768;
#pragma unroll
      for (int i = 0; i < 8; ++i) a[i] = a[i] * rstd * P.qg[8 * lane + i];
      st8bf(O + 8 * lane, a);
      if (lane < 32) {
#pragma unroll
          for (int i = 0; i < 8; ++i) b[i] = b[i] * rstd * P.qg[512 + 8 * lane + i];
          st8bf(O + 512 + 8 * lane, b); } }
    { float ss = 0.f;
#pragma unroll
      for (int i = 0; i < 8; ++i) ss += kvv[i] * kvv[i];
      const float rstd = __builtin_amdgcn_rsqf(wave_sum(ss) * (1.0f / 512.0f) + 1e-6f);
#pragma unroll
      for (int i = 0; i < 8; ++i) kvv[i] = kvv[i] * rstd * P.kvg[8 * lane + i];
      st8bf((bf16*)(ws + WS_CKVN) + m * 512 + 8 * lane, kvv); }
    { const float o = __shfl_xor(tr, 32); const int i = lane & 31;
      const float r = lane < 32 ? tr * cc_ - o * sn_ : tr * cc_ + o * sn_;
      ((bf16*)(ws + WS_KR))[m * 64 + 2 * i + (lane >> 5)] = (bf16)f2bf(r); }
}
__device__ __forceinline__ void hgrn_gate(float z, float lb, float ol, float& key, float& lf2) {
    const float e = __builtin_amdgcn_exp2f(-1.4426950408889634f * __builtin_fabsf(z)), s = __builtin_amdgcn_rcpf(1.0f + e), es = e * s;
    const float sp = z >= 0.f ? s : es, sn = z >= 0.f ? es : s;
    key = ol * sn; lf2 = __builtin_amdgcn_logf(fmaxf(lb + ol * sp, 1e-30f));
}
__device__ __forceinline__ void hgrn_prep(int u, const float* lbl, unsigned char* ws, int lane) {
    const bf16* Z = (const bf16*)(ws + WS_Z); const int cg = u >> 3, h = u & 7, c0 = 128 * h + 2 * lane; const size_t n0 = (size_t)cg * 64;
    const float lb0 = lbl[c0], lb1 = lbl[c0 + 1], ol0 = 1.0f - lb0, ol1 = 1.0f - lb1;
    const bf16* zq = Z + ZO_H + c0; const bf16* zf = zq + 1024; const bf16* zb = zq + 2048;
    bf16* QH = (bf16*)(ws + WS_QH) + c0; bf16* KH = (bf16*)(ws + WS_KH) + c0; constexpr size_t DS = (size_t)M * 1024; constexpr float CL = 115.41560327111707f;
    float* GM = (float*)(ws + WS_GM); float* GL = (float*)(ws + WS_GL); const size_t go = (size_t)cg * 1024 + c0, gd = (size_t)256 * 1024;
    float x00 = 0.f, x01 = 0.f, x10 = 0.f, x11 = 0.f;
#pragma unroll 1
    for (int bt = 0; bt < 4; ++bt) {
        const bool up = bt < 2; const int tb = up ? 32 + 16 * bt : 31 - 16 * (bt - 2), ts = up ? 1 : -1;
        if (bt == 2) { *(f32x2*)(GL + go) = (f32x2){__builtin_amdgcn_exp2f(x00), __builtin_amdgcn_exp2f(x01)}; *(f32x2*)(GM + gd + go) = (f32x2){__builtin_amdgcn_exp2f(x10), __builtin_amdgcn_exp2f(x11)};
                       x00 = 0.f; x01 = 0.f; x10 = 0.f; x11 = 0.f; }
        unsigned wf[16], wb[16], wq[16];
#pragma unroll
        for (int i = 0; i < 16; ++i) { const size_t n = n0 + (size_t)(tb + ts * i); wf[i] = *(const unsigned*)(zf + n * ZW); wb[i] = *(const unsigned*)(zb + n * ZW); wq[i] = *(const unsigned*)(zq + n * ZW); }
#pragma unroll
        for (int i = 0; i < 16; ++i) { const size_t n = n0 + (size_t)(tb + ts * i);
            const float q0 = __uint_as_float(wq[i] << 16), q1 = __uint_as_float(wq[i] & 0xffff0000u);
            const float s0 = q0 * __builtin_amdgcn_rcpf(1.0f + __builtin_amdgcn_exp2f(-1.4426950408889634f * q0)), s1 = q1 * __builtin_amdgcn_rcpf(1.0f + __builtin_amdgcn_exp2f(-1.4426950408889634f * q1));
            float k00, k01, k10, k11, l00, l01, l10, l11;
            hgrn_gate(__uint_as_float(wf[i] << 16), lb0, ol0, k00, l00); hgrn_gate(__uint_as_float(wf[i] & 0xffff0000u), lb1, ol1, k01, l01);
            hgrn_gate(__uint_as_float(wb[i] << 16), lb0, ol0, k10, l10); hgrn_gate(__uint_as_float(wb[i] & 0xffff0000u), lb1, ol1, k11, l11);
            const float y00 = x00 + l00, y01 = x01 + l01, y10 = x10 + l10, y11 = x11 + l11;
            const float e00 = up ? y00 : -x00, e01 = up ? y01 : -x01, e10 = up ? -x10 : y10, e11 = up ? -x11 : y11;
            x00 = y00; x01 = y01; x10 = y10; x11 = y11;
            *(unsigned*)(QH + n * 1024) = pk2(s0 * __builtin_amdgcn_exp2f(fminf(e00, CL)), s1 * __builtin_amdgcn_exp2f(fminf(e01, CL)));
            *(unsigned*)(KH + n * 1024) = pk2(k00 * __builtin_amdgcn_exp2f(fminf(-e00, CL)), k01 * __builtin_amdgcn_exp2f(fminf(-e01, CL)));
            *(unsigned*)(QH + DS + n * 1024) = pk2(s0 * __builtin_amdgcn_exp2f(fminf(e10, CL)), s1 * __builtin_amdgcn_exp2f(fminf(e11, CL)));
            *(unsigned*)(KH + DS + n * 1024) = pk2(k10 * __builtin_amdgcn_exp2f(fminf(-e10, CL)), k11 * __builtin_amdgcn_exp2f(fminf(-e11, CL))); }
    }
    *(f32x2*)(GM + go) = (f32x2){__builtin_amdgcn_exp2f(x00), __builtin_amdgcn_exp2f(x01)}; *(f32x2*)(GL + gd + go) = (f32x2){__builtin_amdgcn_exp2f(x10), __builtin_amdgcn_exp2f(x11)};
}
struct PostP { const float *gnw, *gnb, *rk, *hng, *ka; };
__device__ __forceinline__ void post_token(size_t m, const PostP& P, unsigned char* ws, int lane) {
    const int c16 = 16 * lane; const size_t o = m * 1024 + c16;
    float of[16], ob[16], gz[16];
    ld16bf((const bf16*)(ws + WS_OS) + o, of); ld16bf((const bf16*)(ws + WS_OS) + (size_t)M * 1024 + o, ob); ld16bf((const bf16*)(ws + WS_Z) + m * ZW + ZO_H + 4096 + c16, gz);
    { float yf[16], yb[16]; ld16bf((const bf16*)(ws + WS_YS) + o, yf); ld16bf((const bf16*)(ws + WS_YS) + (size_t)M * 1024 + o, yb);
      float s1 = 0.f;
#pragma unroll
      for (int i = 0; i < 16; ++i) { yf[i] += yb[i]; s1 += yf[i]; }
      s1 += __shfl_xor(s1, 1); s1 += __shfl_xor(s1, 2); const float mean = s1 * (1.0f / 64.0f); float s2 = 0.f;
#pragma unroll
      for (int i = 0; i < 16; ++i) { yf[i] -= mean; s2 += yf[i] * yf[i]; }
      s2 += __shfl_xor(s2, 1); s2 += __shfl_xor(s2, 2); const float rstd = __builtin_amdgcn_rsqf(s2 * (1.0f / 64.0f) + 64e-5f);
      float r[16], k0[16], k1[16], t[16]; ld16bf((const bf16*)(ws + WS_R) + o, r); ld16bf((const bf16*)(ws + WS_A) + o, k0); ld16bf((const bf16*)(ws + WS_A) + (size_t)M * 1024 + o, k1); ld16f(P.rk + c16, t);
      float bs = 0.f;
      { float ks[16], ka[16]; ld16bf((const bf16*)(ws + WS_KS) + o, ks); ld16f(P.ka + c16, ka);
#pragma unroll
        for (int i = 0; i < 16; ++i) bs += r[i] * ks[i] * (2.0f + (k0[i] + k1[i] - 2.0f) * ka[i]) * t[i]; }
      bs += __shfl_xor(bs, 1); bs += __shfl_xor(bs, 2);
      float gw_[16], gb_[16], v[16], g[16]; ld16f(P.gnw + c16, gw_); ld16f(P.gnb + c16, gb_); ld16bf((const bf16*)(ws + WS_V) + o, v); ld16bf((const bf16*)(ws + WS_G) + o, g);
#pragma unroll
      for (int i = 0; i < 16; ++i) yf[i] = (yf[i] * rstd * gw_[i] + gb_[i] + bs * v[i]) * g[i];
      st16bf((bf16*)(ws + WS_YA) + o, yf); }
    { float ss = 0.f;
#pragma unroll
      for (int i = 0; i < 16; ++i) { of[i] += ob[i]; ss += of[i] * of[i]; }
      ss += __shfl_xor(ss, 1); ss += __shfl_xor(ss, 2); ss += __shfl_xor(ss, 4);
      const float rstd = __builtin_amdgcn_rsqf(ss * (1.0f / 128.0f) + 1e-6f);
      float ng[16]; ld16f(P.hng + (c16 & 127), ng);
#pragma unroll
      for (int i = 0; i < 16; ++i) of[i] = of[i] * rstd * ng[i] * (gz[i] * sigmf(gz[i]));
      st16bf((bf16*)(ws + WS_YB) + o, of); }
}
#define SCAN_BAR() do { asm volatile("s_waitcnt lgkmcnt(0)" ::: "memory"); __builtin_amdgcn_s_barrier(); asm volatile("" ::: "memory"); } while (0)
__device__ __forceinline__ float quad_sum(float x) {
    x += __builtin_bit_cast(float, __builtin_amdgcn_update_dpp(0, __builtin_bit_cast(int, x), 0xB1, 0xF, 0xF, true));
    x += __builtin_bit_cast(float, __builtin_amdgcn_update_dpp(0, __builtin_bit_cast(int, x), 0x4E, 0xF, 0xF, true));
    return x;
}
__device__ __forceinline__ float oct_sum(float x) {
    x += __builtin_bit_cast(float, __builtin_amdgcn_update_dpp(0, __builtin_bit_cast(int, x), 0xB1, 0xF, 0xF, true));
    x += __builtin_bit_cast(float, __builtin_amdgcn_update_dpp(0, __builtin_bit_cast(int, x), 0x4E, 0xF, 0xF, true));
    x += __builtin_bit_cast(float, __builtin_amdgcn_update_dpp(0, __builtin_bit_cast(int, x), 0x141, 0xF, 0xF, true));
    return x;
}
__device__ __forceinline__ void rwkv_scan(int sid, const float* kal, const float* kkl, unsigned char* ws, LAS unsigned char* lds) {
    const int tid = tid_opaque(), wave = __builtin_amdgcn_readfirstlane(tid >> 6), lane = tid & 63;
    const int dir = sid & 1, bh = sid >> 1, h = bh & 15, b = bh >> 4;
    constexpr int NB = SEQ / 16;
    constexpr int O_XI = 0, O_B2T = 16384, O_VT = 32768, O_YI = 49152, O_MN = 61440, O_GS = 73728, O_SB = 81920, O_OUT = 90112, O_WRAW = 98304, O_LAM = 106496;
    LAS float* outb = (LAS float*)(lds + O_OUT); LAS float* lamb = (LAS float*)(lds + O_LAM);
#define SW128(row, k) ((row) * 128 + (((((k) >> 3) << 4)) ^ (((row) & 7) << 4)) + ((k) & 7) * 2)
#define SW64(row, kk) ((row) * 64 + (((((kk) >> 3) << 4)) ^ ((((row) >> 2) & 3) << 4)) + ((kk) & 7) * 2)
#define NK(t_) (((t_) & 3) + 8 * ((t_) >> 2))
    if (wave >= 4) {
        const int j = tid - 256, st = j & 15, q4 = j >> 4;
        const size_t dofs = (size_t)dir * M * 1024;
        const int co = h * 64 + q4 * 4;
        const float* b0 = (const float*)(ws + WS_KAP) + h;     const unsigned short* b1 = (const unsigned short*)(ws + WS_W) + dofs + co; const bf16* b2 = (const bf16*)(ws + WS_A) + dofs + co;
        const bf16* b3 = (const bf16*)(ws + WS_KS) + co; const bf16* b4 = (const bf16*)(ws + WS_R) + co; const bf16* b5 = (const bf16*)(ws + WS_V) + co;
        const f32x4 ka4 = *(const f32x4*)(kal + co), kk4 = *(const f32x4*)(kkl + co);
        bf16* YS = (bf16*)(ws + WS_YS) + dofs + co;
        const int nk = NK(st), nr = nk + 4;
        const int q4p = (q4 & 12) | ((q4 & 1) << 1) | ((q4 & 2) >> 1);
        struct Raw { v2u a, ks, r, v, w; float ki; };
        typedef _Float16 h16x4_ __attribute__((ext_vector_type(4)));
        Raw A, B, C;
#define RW_TOK(nb_) ((size_t)(b * SEQ + (dir ? SEQ - 1 - ((nb_) * 16 + st) : (nb_) * 16 + st)) * 1024)
#define RW_LOAD(X, nb_) do { const size_t o_ = RW_TOK(nb_); X.ki = b0[(o_ >> 10) * 16]; X.w = *(const v2u*)(b1 + o_); X.a = *(const v2u*)(b2 + o_); X.ks = *(const v2u*)(b3 + o_); X.r = *(const v2u*)(b4 + o_); X.v = *(const v2u*)(b5 + o_); } while (0)
#define BF4(w_) ((f32x4){__uint_as_float((w_).x << 16), __uint_as_float((w_).x & 0xffff0000u), __uint_as_float((w_).y << 16), __uint_as_float((w_).y & 0xffff0000u)})
#define PK4B(v_) ((v2u){pg8::cvt_pk_bf16((v_)[0], (v_)[1]), pg8::cvt_pk_bf16((v_)[2], (v_)[3])})
#define RW_SHR(x_, n_) __builtin_bit_cast(float, __builtin_amdgcn_update_dpp(0x3f800000, __builtin_bit_cast(int, x_), 0x110 + (n_), 0xF, 0xF, false))
#define RW_SCALE(X, nb_) do { f32x4 lt_ = __builtin_convertvector(__builtin_bit_cast(h16x4_, X.w), f32x4), lp_; \
        _Pragma("unroll") for (int e_ = 0; e_ < 4; ++e_) { float x_ = lt_[e_]; x_ *= RW_SHR(x_, 1); x_ *= RW_SHR(x_, 2); x_ *= RW_SHR(x_, 4); x_ *= RW_SHR(x_, 8); lt_[e_] = x_; lp_[e_] = RW_SHR(x_, 1); } \
        f32x4 il_; il_[0] = __builtin_amdgcn_rcpf(lt_[0]); il_[1] = __builtin_amdgcn_rcpf(lt_[1]); il_[2] = __builtin_amdgcn_rcpf(lt_[2]); il_[3] = __builtin_amdgcn_rcpf(lt_[3]); \
        const f32x4 af_ = BF4(X.a), sf_ = BF4(X.ks), kf_ = sf_ * kk4 * X.ki; const int p3_ = ((nb_) & 3) * 4096, p2_ = ((nb_) % 3) * 4096; \
        const f32x4 kh_ = kf_ * lp_, bh_ = (kf_ * af_) * il_, th_ = (sf_ * (1.0f + (af_ - 1.0f) * ka4)) * il_, rh_ = BF4(X.r) * lt_; \
        *(LAS v2u*)(lds + O_XI + p3_ + SW128(nk, 4 * q4p)) = PK4B(kh_); *(LAS v2u*)(lds + O_XI + p3_ + SW128(nr, 4 * q4p)) = PK4B(rh_); \
        *(LAS v2u*)(lds + O_YI + p2_ + SW128(st, 4 * q4p)) = PK4B(bh_); *(LAS v2u*)(lds + O_YI + p2_ + SW128(16 + st, 4 * q4p)) = PK4B(th_); \
        _Pragma("unroll") for (int e_ = 0; e_ < 4; ++e_) { const unsigned w2_ = pg8::cvt_pk_bf16(bh_[e_], th_[e_]); *(LAS unsigned short*)(lds + O_B2T + p3_ + SW64(4 * q4 + e_, st)) = (unsigned short)(w2_ & 0xffffu); *(LAS unsigned short*)(lds + O_B2T + p3_ + SW64(4 * q4 + e_, 16 + st)) = (unsigned short)(w2_ >> 16); } \
        { const unsigned vw_[4] = {X.v.x & 0xffffu, X.v.x >> 16, X.v.y & 0xffffu, X.v.y >> 16}; \
          _Pragma("unroll") for (int e_ = 0; e_ < 4; ++e_) *(LAS unsigned short*)(lds + O_VT + p3_ + SW64(4 * q4 + e_, 16 + st)) = (unsigned short)vw_[e_]; } \
        if (st == 15) *(LAS f32x4*)(lamb + ((nb_) & 3) * 64 + q4 * 4) = lt_; } while (0)
#define RW_FLUSH(nb_) do { const f32x4 y_ = *(const LAS f32x4*)(outb + (((nb_) & 1) * 16 + st) * 64 + ((q4 ^ st) << 2)); v2u w_; w_.x = pk2(y_[0], y_[1]); w_.y = pk2(y_[2], y_[3]); *(v2u*)(YS + RW_TOK(nb_)) = w_; } while (0)
#define RW_ITER(nb_, X1, X2) do { if ((nb_) + 3 < NB) RW_SCALE(X1, (nb_) + 3); if ((nb_) + 6 < NB) RW_LOAD(X1, (nb_) + 6); if ((nb_) > 0) RW_FLUSH((nb_) - 1); SCAN_BAR(); } while (0)
        RW_LOAD(A, 0); RW_LOAD(B, 1); RW_LOAD(C, 2);
        SCAN_BAR();
        RW_SCALE(A, 0); RW_LOAD(A, 3);
        SCAN_BAR();
        RW_SCALE(B, 1); RW_LOAD(B, 4);
        SCAN_BAR();
        RW_SCALE(C, 2); RW_LOAD(C, 5);
        SCAN_BAR();
        for (int nb = 0; nb + 2 < NB; nb += 3) { RW_ITER(nb, A, B); RW_ITER(nb + 1, B, C); RW_ITER(nb + 2, C, A); }
        RW_ITER(NB - 1, A, B);
        static_assert(NB % 3 == 1, "stager loop tail assumes NB = 1 (mod 3)");
        RW_FLUSH(NB - 1);
#undef RW_TOK
#undef RW_LOAD
#undef RW_SHR
#undef RW_SCALE
#undef RW_FLUSH
#undef RW_ITER
#undef BF4
#undef PK4B
    } else if (wave < 2) {
        typedef short bfx8 __attribute__((ext_vector_type(8))); typedef float f16v __attribute__((ext_vector_type(16))); typedef unsigned u4v __attribute__((ext_vector_type(4)));
        const int vl = lane & 31, hi = lane >> 5, vrow = 32 * wave + vl;
        f16v St0 = {}, St1 = {};
        bfx8 so0 = {}, so1 = {}, so2 = {}, so3 = {};
        SCAN_BAR(); SCAN_BAR(); SCAN_BAR(); SCAN_BAR();
#pragma unroll 1
        for (int nb = 0; nb < NB; ++nb) {
            const int p3 = (nb & 3) * 4096, p2 = (nb % 3) * 4096;
            const LAS unsigned char* xi = lds + O_XI + p3; const LAS unsigned char* b2t = lds + O_B2T + p3; LAS unsigned char* vt = lds + O_VT + p3; const LAS unsigned char* mn = lds + O_MN + p2;
            f16v pq = {};
#pragma unroll
            for (int q = 0; q < 4; ++q) { const bfx8 ax = *(const LAS bfx8*)(xi + SW128(vl, 16 * q + 8 * hi)); pq = __builtin_amdgcn_mfma_f32_32x32x16_bf16(ax, q == 0 ? so0 : (q == 1 ? so1 : (q == 2 ? so2 : so3)), pq, 0, 0, 0); }
            f32x4 lm0[4], lm1[4];
#pragma unroll
            for (int g4 = 0; g4 < 4; ++g4) { lm0[g4] = *(const LAS f32x4*)(lamb + (nb & 3) * 64 + 8 * g4 + 4 * hi); lm1[g4] = *(const LAS f32x4*)(lamb + (nb & 3) * 64 + 32 + 8 * g4 + 4 * hi); }
            bfx8 pa0, pa1;
#define PK4(P, BASE, OUT) do { const unsigned a0 = pg8::cvt_pk_bf16(P[BASE + 0], P[BASE + 1]), a1 = pg8::cvt_pk_bf16(P[BASE + 2], P[BASE + 3]), b0_ = pg8::cvt_pk_bf16(P[BASE + 4], P[BASE + 5]), b1_ = pg8::cvt_pk_bf16(P[BASE + 6], P[BASE + 7]); \
        const auto r0 = __builtin_amdgcn_permlane32_swap(a0, b0_, false, false); const auto r1 = __builtin_amdgcn_permlane32_swap(a1, b1_, false, false); \
        const u4v w_ = {r0[0], r1[0], r0[1], r1[1]}; OUT = __builtin_bit_cast(bfx8, w_); } while (0)
            PK4(pq, 0, pa0); PK4(pq, 8, pa1);
#undef PK4
            f16v d = {};
            const bfx8 pv = *(const LAS bfx8*)(vt + SW64(vrow, 16 + 8 * hi));
            const bfx8 bk00 = *(const LAS bfx8*)(b2t + SW64(vl, 8 * hi)), bk10 = *(const LAS bfx8*)(b2t + SW64(32 + vl, 8 * hi)), bk01 = *(const LAS bfx8*)(b2t + SW64(vl, 16 + 8 * hi)), bk11 = *(const LAS bfx8*)(b2t + SW64(32 + vl, 16 + 8 * hi));
            { const bfx8 m0 = *(const LAS bfx8*)(mn + SW128(vl, 8 * hi)), m1 = *(const LAS bfx8*)(mn + SW128(vl, 16 + 8 * hi)), m2 = *(const LAS bfx8*)(mn + SW128(vl, 32 + 8 * hi));
              d = __builtin_amdgcn_mfma_f32_32x32x16_bf16(m0, pa0, d, 0, 0, 0); d = __builtin_amdgcn_mfma_f32_32x32x16_bf16(m1, pa1, d, 0, 0, 0); d = __builtin_amdgcn_mfma_f32_32x32x16_bf16(m2, pv, d, 0, 0, 0); }
            bfx8 av0;
            { const unsigned w0x = pg8::cvt_pk_bf16(d[0], d[1]), w0y = pg8::cvt_pk_bf16(d[2], d[3]), w0z = pg8::cvt_pk_bf16(d[4], d[5]), w0w = pg8::cvt_pk_bf16(d[6], d[7]);
              const unsigned w1x = pg8::cvt_pk_bf16(d[8], d[9]), w1y = pg8::cvt_pk_bf16(d[10], d[11]), w1z = pg8::cvt_pk_bf16(d[12], d[13]), w1w = pg8::cvt_pk_bf16(d[14], d[15]);
              const auto e0 = __builtin_amdgcn_permlane32_swap(w0x, w1x, false, false); const auto e1 = __builtin_amdgcn_permlane32_swap(w0y, w1y, false, false);
              const auto e2 = __builtin_amdgcn_permlane32_swap(w0z, w1z, false, false); const auto e3 = __builtin_amdgcn_permlane32_swap(w0w, w1w, false, false);
              const u4v w_ = {e0[0], e1[0], e2[0], e3[0]}; av0 = __builtin_bit_cast(bfx8, w_); }
            if (hi == 1) { LAS float* po = outb + (nb & 1) * 16 * 64 + (vrow & 3);
#pragma unroll
                for (int t = 0; t < 16; ++t) po[t * 64 + (((vrow >> 2) ^ t) << 2)] = d[t]; }
            St0 = __builtin_amdgcn_mfma_f32_32x32x16_bf16(bk00, av0, St0, 0, 0, 0); St1 = __builtin_amdgcn_mfma_f32_32x32x16_bf16(bk10, av0, St1, 0, 0, 0);
            St0 = __builtin_amdgcn_mfma_f32_32x32x16_bf16(bk01, pv, St0, 0, 0, 0); St1 = __builtin_amdgcn_mfma_f32_32x32x16_bf16(bk11, pv, St1, 0, 0, 0);
            {
#pragma unroll
              for (int r = 0; r < 16; ++r) { St0[r] *= lm0[r >> 2][r & 3]; St1[r] *= lm1[r >> 2][r & 3]; }
              u4v w_;
              w_ = (u4v){pg8::cvt_pk_bf16(St0[0], St0[1]), pg8::cvt_pk_bf16(St0[2], St0[3]), pg8::cvt_pk_bf16(St0[4], St0[5]), pg8::cvt_pk_bf16(St0[6], St0[7])}; so0 = __builtin_bit_cast(bfx8, w_);
              w_ = (u4v){pg8::cvt_pk_bf16(St0[8], St0[9]), pg8::cvt_pk_bf16(St0[10], St0[11]), pg8::cvt_pk_bf16(St0[12], St0[13]), pg8::cvt_pk_bf16(St0[14], St0[15])}; so1 = __builtin_bit_cast(bfx8, w_);
              w_ = (u4v){pg8::cvt_pk_bf16(St1[0], St1[1]), pg8::cvt_pk_bf16(St1[2], St1[3]), pg8::cvt_pk_bf16(St1[4], St1[5]), pg8::cvt_pk_bf16(St1[6], St1[7])}; so2 = __builtin_bit_cast(bfx8, w_);
              w_ = (u4v){pg8::cvt_pk_bf16(St1[8], St1[9]), pg8::cvt_pk_bf16(St1[10], St1[11]), pg8::cvt_pk_bf16(St1[12], St1[13]), pg8::cvt_pk_bf16(St1[14], St1[15])}; so3 = __builtin_bit_cast(bfx8, w_); }
            SCAN_BAR();
        }
    } else {
        typedef short bfx8 __attribute__((ext_vector_type(8))); typedef float f16v __attribute__((ext_vector_type(16))); typedef unsigned u4v __attribute__((ext_vector_type(4)));
        const int vl = lane & 31, hi = lane >> 5, j = lane & 15, grp = lane >> 4;
        LAS float* gk = (LAS float*)(lds + O_GS + (wave - 2) * 4096); LAS float* gr = gk + 512;
        const int col = grp == 0 ? NK(j) : (grp == 1 ? 32 + j : (grp == 2 ? NK(j) + 4 : 48 + j));
#define MK_SPLIT 9
#define MK_BATCH(kb_) do { const LAS unsigned char* xi = lds + O_XI + ((kb_) & 3) * 4096; const LAS unsigned char* yi = lds + O_YI + ((kb_) % 3) * 4096; LAS unsigned char* mo = lds + O_MN + ((kb_) % 3) * 4096; \
        f16v g = {}; \
        _Pragma("unroll") for (int q = 0; q < 4; ++q) { const bfx8 ay = *(const LAS bfx8*)(yi + SW128(vl, 16 * q + 8 * hi)), bx = *(const LAS bfx8*)(xi + SW128(vl, 16 * q + 8 * hi)); g = __builtin_amdgcn_mfma_f32_32x32x16_bf16(ay, bx, g, 0, 0, 0); } \
        { const int tb_ = (vl >> 2) & 1, t_ = (vl & 3) + 4 * (vl >> 3); LAS float* gp_ = gk + tb_ * 512 + t_ * 32; \
          _Pragma("unroll") for (int r = 0; r < 16; ++r) gp_[(r & 3) + 8 * (r >> 2) + 4 * hi] = g[r]; } \
        asm volatile("s_waitcnt lgkmcnt(0)" ::: "memory"); \
        float x[16]; const float m0_ = grp == 0 ? -1.0f : 0.f, m1_ = grp == 1 ? -1.0f : 0.f; \
        f32x4 Lr[2][4]; float gq[2]; \
        _Pragma("unroll") for (int s4 = 0; s4 < 4; ++s4) Lr[0][s4] = *(const LAS f32x4*)(gk + 4 * s4); gq[0] = gk[16 + j]; \
        _Pragma("unroll") for (int t = 0; t < 16; ++t) {             \
            if (t == MK_SPLIT) SCAN_BAR();            \
            if (t + 1 < 16) { _Pragma("unroll") for (int s4 = 0; s4 < 4; ++s4) { if (4 * s4 < t + 1) Lr[(t + 1) & 1][s4] = *(const LAS f32x4*)(gk + (t + 1) * 32 + 4 * s4); } gq[(t + 1) & 1] = gk[(t + 1) * 32 + 16 + j]; } \
            float rhs = (t == j ? m0_ : 0.f) + (j < t ? m1_ * gq[t & 1] : 0.f); \
            _Pragma("unroll") for (int s = 0; s < 16; ++s) if (s < t) rhs = __builtin_fmaf(-Lr[t & 1][s >> 2][s & 3], x[s], rhs); \
            x[t] = rhs; asm volatile("" : "+v"(x[t]) :: "memory"); } \
          \
        f16v cm = {}; unsigned xp_s_[8]; \
        { const f32x4 b0_ = *(const LAS f32x4*)(gr + (vl & 15) * 32 + 8 * hi), b1_ = *(const LAS f32x4*)(gr + (vl & 15) * 32 + 8 * hi + 4); float bb_[8]; \
          _Pragma("unroll") for (int e = 0; e < 4; ++e) { bb_[e] = (vl < 16 && 8 * hi + e <= vl) ? b0_[e] : 0.f; bb_[4 + e] = (vl < 16 && 8 * hi + 4 + e <= vl) ? b1_[e] : 0.f; } \
          const u4v aw_ = {pg8::cvt_pk_bf16(bb_[0], bb_[1]), pg8::cvt_pk_bf16(bb_[2], bb_[3]), pg8::cvt_pk_bf16(bb_[4], bb_[5]), pg8::cvt_pk_bf16(bb_[6], bb_[7])}; \
          _Pragma("unroll") for (int q = 0; q < 8; ++q) xp_s_[q] = pg8::cvt_pk_bf16(x[2 * q], x[2 * q + 1]); \
          u4v bw_; _Pragma("unroll") for (int q = 0; q < 4; ++q) { const auto r_ = __builtin_amdgcn_permlane32_swap(xp_s_[q], xp_s_[4 + q], false, false); bw_[q] = r_[0]; }     \
          cm = __builtin_amdgcn_mfma_f32_32x32x16_bf16(__builtin_bit_cast(bfx8, aw_), __builtin_bit_cast(bfx8, bw_), cm, 0, 0, 0); } \
          \
        { const int cj_ = vl & 15; const bool c2_ = vl >= 16; float b2_[8]; \
          _Pragma("unroll") for (int r = 0; r < 8; ++r) { const int t = (r & 3) + 8 * (r >> 2) + 4 * hi; b2_[r] = gr[t * 32 + 16 + cj_]; } \
          const int colc_ = c2_ ? 32 + cj_ : NK(cj_); \
          if (hi == 0) { _Pragma("unroll") for (int q = 0; q < 8; ++q) { *(LAS unsigned short*)(mo + SW128(NK(2 * q), colc_)) = (unsigned short)(xp_s_[q] & 0xffffu); *(LAS unsigned short*)(mo + SW128(NK(2 * q + 1), colc_)) = (unsigned short)(xp_s_[q] >> 16); } } \
          _Pragma("unroll") for (int r = 0; r < 8; r += 2) { const int t0 = (r & 3) + 8 * (r >> 2) + 4 * hi; \
              const float c0_ = cm[r] + ((c2_ && cj_ <= t0) ? b2_[r] : 0.f), c1_ = cm[r + 1] + ((c2_ && cj_ <= t0 + 1) ? b2_[r + 1] : 0.f); const unsigned w2_ = pg8::cvt_pk_bf16(c0_, c1_); \
              *(LAS unsigned short*)(mo + SW128(NK(t0) + 4, colc_)) = (unsigned short)(w2_ & 0xffffu); *(LAS unsigned short*)(mo + SW128(NK(t0 + 1) + 4, colc_)) = (unsigned short)(w2_ >> 16); } } } while (0)
        if (wave == 2) {
            unsigned z_ = 0u; asm volatile("" : "+v"(z_));
#pragma unroll
            for (int i = 0; i < 12; ++i) *(LAS v4u*)(lds + O_MN + (i * 64 + lane) * 16) = (v4u){z_, z_, z_, z_};
            asm volatile("s_waitcnt lgkmcnt(0)" ::: "memory");
            if (lane < 48) { const int bi_ = lane >> 4, t = lane & 15; *(LAS unsigned short*)(lds + O_MN + bi_ * 4096 + SW128(NK(t) + 4, NK(t) + 4)) = (unsigned short)0x3f80u; } }
        if (wave == 2) { SCAN_BAR(); SCAN_BAR(); MK_BATCH(0); SCAN_BAR();
#pragma unroll 1
            for (int k = 2; k < NB; k += 2) { MK_BATCH(k); SCAN_BAR(); }
            SCAN_BAR(); SCAN_BAR(); }
        else { SCAN_BAR(); SCAN_BAR(); SCAN_BAR(); MK_BATCH(1); SCAN_BAR();
#pragma unroll 1
            for (int k = 3; k < NB; k += 2) { MK_BATCH(k); SCAN_BAR(); }
            SCAN_BAR(); }
#undef MK_BATCH
#undef MK_SPLIT
    }
#undef SW128
#undef SW64
#undef NK
}

constexpr int N_LAUNCHES = MK_N_LAUNCHES;
struct Args { const void* in[30]; float* out; unsigned char* ws; int ph_lo, ph_hi; };
enum { I_X = 0, I_P, I_POS, I_LN1, I_WIN, I_MU, I_W0, I_W2, I_A0, I_A2, I_G2, I_KK, I_KA, I_RK, I_GNW, I_GNB, I_HLB, I_HNG, I_QG, I_KVG, I_UQ, I_UKV, I_BR, I_WO, I_LN2, I_W1, I_W2M, I_WPE, I_WPG, I_FG };
#define INF(i) ((const float*)args.in[i])

__global__ void __launch_bounds__(NWAVES * 64, 2) fwd(Args args) {
    extern __shared__ __attribute__((aligned(16))) unsigned char lds_[];
    LAS unsigned char* lds = (LAS unsigned char*)lds_;
    volatile LAS unsigned* MISC = (volatile LAS unsigned*)(lds + MISC_OFF);
    const int tid = threadIdx.x, lane = tid & 63, wave = __builtin_amdgcn_readfirstlane(tid >> 6), G = gridDim.x, bx = blockIdx.x;
    const int gw = bx * NWAVES + wave, NGW = G * NWAVES;
    unsigned char* ws = args.ws; gu32* ctl = (gu32*)(ws + WS_CTL);
    float* H = args.out;
    for (int u = tid; u < (LDS_BYTES - RING_BYTES) / 4; u += NWAVES * 64) ((LAS unsigned*)(lds + RING_BYTES))[u] = 0u;
    __syncthreads();
    XcdBarrier bar; bar.bar = (unsigned*)(ctl + CW_BAR); bar.x = 0; bar.st = nullptr;
    if (N_LAUNCHES == 1) bar = xcd_barrier_post((unsigned*)(ctl + CW_BAR), MISC + 8);
    const int lo = args.ph_lo, hi = args.ph_hi;
#ifndef PHMASK
#define PHMASK 0xFFFFFF
#endif
#define IN(k) (lo <= (k) && (k) < hi)
#define ON(k) ((PHMASK >> (k)) & 1)
#ifndef CVFILL
#define CVFILL 1
#endif
#ifndef WGM_Z
#define WGM_Z 4
#define WGM_M1 4
#define WGM_M2 4
#define WGM_O 2
#endif
#ifndef DUP_MASK
#define DUP_MASK 0
#endif
#define DUPK(k) ((DUP_MASK >> (k)) & 1)
#ifndef PROBE_X2
#define PROBE_X2 0
#endif
#ifndef DUP_SUB
#define DUP_SUB 7
#endif
#define SEAM(k) do { if (N_LAUNCHES == 1) { if (IN(k) && IN((k) + 1)) xcd_barrier(bar); } } while (0)
    bf16* XN = (bf16*)(ws + WS_XN); bf16* Z = (bf16*)(ws + WS_Z); float* COS = (float*)(ws + WS_COS); float* SIN = (float*)(ws + WS_SIN); float* LB = (float*)(ws + WS_LB);
    bf16* PB = (bf16*)(ws + WS_PB);

    if (IN(0)) {
        const int tid = tid_opaque(); const size_t gt = (size_t)bx * 512 + tid, NGT = (size_t)G * 512;
        const int* pos = (const int*)args.in[I_POS];
        for (size_t i = gt; i < (size_t)M * 32; i += NGT) { const int m = (int)(i >> 5), j = (int)(i & 31);
            const float inv = __builtin_amdgcn_exp2f(-13.287712379549449f * (float)j * (1.0f / 32.0f)); const float ang = (float)pos[m] * inv;
            const float k = rintf(ang * 0.15915494309189535f); float r = fmaf(-k, 6.28125f, ang); r = fmaf(-k, 0.0019353071795864769f, r);
            COS[i] = __cosf(r); SIN[i] = __sinf(r); }
        { unsigned z_ = 0u; asm volatile("" : "+v"(z_)); const v4u z4_ = {z_, z_, z_, z_};
          v4u* p1_ = (v4u*)(ws + WS_WIN + (size_t)3488 * 4096); v4u* p2_ = (v4u*)(ws + WS_WIN + (size_t)10048 * 4096); v4u* p3_ = (v4u*)(ws + WS_LORA);
          for (size_t i = gt; i < (size_t)96 * 4096 / 16; i += NGT) p1_[i] = z4_;
          for (size_t i = gt; i < (size_t)192 * 4096 / 16; i += NGT) p2_[i] = z4_;
          for (size_t i = gt; i < (size_t)5120 * 512 * 2 / 16; i += NGT) p3_[i] = z4_; }
        if (gt < 1024) { const float* hl = INF(I_HLB); float e[4], mx = -1e30f, sum = 0.f;
#pragma unroll
            for (int l = 0; l < 4; ++l) { e[l] = hl[l * 1024 + gt]; mx = fmaxf(mx, e[l]); }
#pragma unroll
            for (int l = 0; l < 4; ++l) { e[l] = expf(e[l] - mx); sum += e[l]; }
            float cum = 0.f; const float w0 = e[0] / sum;
#pragma unroll
            for (int l = 0; l < 4; ++l) { cum += e[l] / sum; LB[l * 1024 + gt] = cum - w0; } }
        { const int lane = tid & 63; float* RS0 = (float*)(ws + WS_RSTD); const float* g0 = INF(I_LN1);
          for (int m = gw; m < M; m += NGW) { const f32x4* xr = (const f32x4*)(INF(I_X) + (size_t)m * 2048) + lane; f32x4* hr = (f32x4*)(H + (size_t)m * 2048) + lane; v2u* xo = (v2u*)(XN + (size_t)m * 2048) + lane; float q = 0.f;
#pragma unroll
              for (int j = 0; j < 8; ++j) { const f32x4 v = xr[64 * j]; hr[64 * j] = v; q += (v[0] * v[0] + v[1] * v[1]) + (v[2] * v[2] + v[3] * v[3]); const f32x4 o = v * ((const f32x4*)g0)[64 * j + lane]; v2u w; w.x = pk2(o[0], o[1]); w.y = pk2(o[2], o[3]); xo[64 * j] = w; }
              q = wave_sum(q); if (lane == 0) RS0[m] = __builtin_amdgcn_rsqf(q * (1.0f / 2048.0f) + 1e-6f); } }
        SEAM(0);
    }

    for (int l = 0; l < DEPTH; ++l) {
        const int pb = 1 + NPH_LAYER * l;
        if (hi <= pb || lo >= pb + NPH_LAYER) continue;
        if (ON(0) && IN(pb + 0)) for (int rep_ = 0; rep_ < 1 + DUPK(0); ++rep_) {
            const int tid = tid_opaque(), lane = tid & 63; const size_t gt = (size_t)bx * 512 + tid, NGT = (size_t)G * 512; (void)lane; (void)gt; (void)NGT;
            LayerW L; L.w_in = INF(I_WIN) + (size_t)l * 2048 * IN_W; L.w2 = INF(I_W2) + (size_t)l * 2 * 64 * 1024; L.a2 = INF(I_A2) + (size_t)l * 2 * 64 * 1024; L.g2 = INF(I_G2) + (size_t)l * 160 * 1024;
            L.uq = INF(I_UQ) + (size_t)l * 768 * 1536; L.ukv = INF(I_UKV) + (size_t)l * 512 * 2048; L.br = INF(I_BR) + (size_t)l * 3 * 1024 * 2048; L.wo = INF(I_WO) + (size_t)l * 2048 * 2048;
            L.w1 = INF(I_W1) + (size_t)l * 2048 * 8192; L.w2m = INF(I_W2M) + (size_t)l * 8192 * 2048; L.wpe = INF(I_WPE) + (size_t)l * 256 * 2048; L.wpg = INF(I_WPG) + (size_t)l * 2048 * 2048;
            convert_weights(L, ws, (LAS float*)(lds + wave * 16384), gw, NGW, lane, (l > 0 && CVFILL) ? TR_EARLY : 0);
            const float* pl = INF(I_P) + (size_t)l * M * 256;
            for (size_t i = gt; i < (size_t)M * 256 / 8; i += NGT) { const f32x4 a = *(const f32x4*)(pl + 8 * i), b = *(const f32x4*)(pl + 8 * i + 4);
                v4u o; o.x = pk2(a[0], a[1]); o.y = pk2(a[2], a[3]); o.z = pk2(b[0], b[1]); o.w = pk2(b[2], b[3]); *(v4u*)(PB + 8 * i) = o; }
            if (l > 0) { const float* SSP = (const float*)(ws + WS_SS); float* RSO = (float*)(ws + WS_RSTD); for (int m0 = gw * 2 + (lane >> 5); m0 < M; m0 += NGW * 8) { float q4_[4];
#pragma unroll
              for (int i = 0; i < 4; ++i) { const int m = m0 + i * NGW * 2; q4_[i] = m < M ? SSP[(size_t)m * 32 + (lane & 31)] : 0.f; }
#pragma unroll
              for (int i = 0; i < 4; ++i) { const int m = m0 + i * NGW * 2; float q = q4_[i]; q += __shfl_xor(q, 1); q += __shfl_xor(q, 2); q += __shfl_xor(q, 4); q += __shfl_xor(q, 8); q += __shfl_xor(q, 16); if ((lane & 31) == 0 && m < M) RSO[m] = __builtin_amdgcn_rsqf(q * (1.0f / 2048.0f) + 1e-6f); } } }
            if (PROBE_X2 == 5) { convert_weights(L, ws, (LAS float*)(lds + wave * 16384), gw, NGW, lane, 0); for (int m = gw; m < M; m += NGW) rms_row<false>(H + (size_t)m * 2048, INF(I_LN1) + l * 2048, XN + (size_t)m * 2048, lane); }
            if (rep_ < DUPK(0)) xcd_barrier(bar); else SEAM(pb + 0);
        }
        if (ON(1) && IN(pb + 1)) for (int rep_ = 0; rep_ < 1 + DUPK(1); ++rep_) {
            const int tid = tid_opaque(), lane = tid & 63; const size_t gt = (size_t)bx * 512 + tid, NGT = (size_t)G * 512; (void)lane; (void)gt; (void)NGT;
            pg8::Gemm g{XN, (const bf16*)(ws + WS_WIN), M, ZW, 2048}; pg8::StaticOrder S; S.init(M, ZW, G, bx, WGM_Z);
            pg8::EpiB16<1> E{Z, ZW, (const float*)(ws + WS_RSTD), nullptr};
            pg8::gemm_phase<pg8::EpiB16<1>, pg8::StaticOrder, true, true>(lds, g, S, E);
            if (PROBE_X2 == 3) { __syncthreads(); pg8::gemm_phase<pg8::EpiB16<1>, pg8::StaticOrder, true, true>(lds, g, S, E); }
            if (rep_ < DUPK(1)) xcd_barrier(bar); else SEAM(pb + 1);
        }
        if (ON(2) && IN(pb + 2)) for (int rep_ = 0; rep_ < 1 + DUPK(2); ++rep_) {
            const int tid = tid_opaque(), lane = tid & 63; const size_t gt = (size_t)bx * 512 + tid, NGT = (size_t)G * 512; (void)lane; (void)gt; (void)NGT;
            PreP P; P.mu = INF(I_MU) + (size_t)l * 2 * RWKV_W; P.kk = INF(I_KK) + l * 1024; P.lb = LB + l * 1024; P.qg = INF(I_QG) + l * 768; P.kvg = INF(I_KVG) + l * 512; P.COS = COS; P.SIN = SIN;
            for (int r = gw; r < M / 4; r += NGW) pre_run_rwkv((size_t)r * 4, P, ws, lane);
            for (int m = gw; m < M; m += NGW) pre_token((size_t)m, P, ws, lane);
            for (int u = gw; u < 2048; u += NGW) hgrn_prep(u, LB + l * 1024, ws, lane);
            if (rep_ < DUPK(2)) xcd_barrier(bar); else SEAM(pb + 2);
        }
        if (ON(3) && IN(pb + 3)) for (int rep_ = 0; rep_ < 1 + DUPK(3); ++rep_) {
            const int tid = tid_opaque(), lane = tid & 63; const size_t gt = (size_t)bx * 512 + tid, NGT = (size_t)G * 512; (void)lane; (void)gt; (void)NGT;
            if (ON(16)) { pg8::Gemm g{(const bf16*)(ws + WS_ALORA), (const bf16*)(ws + WS_LORA), M, 4096, 256}; pg8::StaticOrder S; S.init(M, 4096, G, bx, WGM_O);
              pg8::EpiLora E{INF(I_W0) + l * 2048, INF(I_A0) + l * 2048, (unsigned short*)(ws + WS_W), (bf16*)(ws + WS_A), (bf16*)(ws + WS_G), 0};
              pg8::gemm_phase<pg8::EpiLora, pg8::StaticOrder, true, true>(lds, g, S, E); }
            if (ON(16) && (G != 256 || bx >= 128)) { pg8::Gemm g{(const bf16*)(ws + WS_ALORA) + (size_t)M * 256, (const bf16*)(ws + WS_LORA) + (size_t)4096 * 256, M, 1024, 256}; pg8::StaticOrder S; if (G == 256) S.init(M, 1024, 128, bx - 128, WGM_O); else S.init(M, 1024, G, bx, WGM_O);
              pg8::EpiLora E{INF(I_W0) + l * 2048, INF(I_A0) + l * 2048, (unsigned short*)(ws + WS_W), (bf16*)(ws + WS_A), (bf16*)(ws + WS_G), 16};
              pg8::gemm_phase<pg8::EpiLora, pg8::StaticOrder, true, true>(lds, g, S, E); }
            if (ON(17)) { pg8::Gemm g{(const bf16*)(ws + WS_CQN), (const bf16*)(ws + WS_UQ), M, 1536, 768}; pg8::StaticOrder S; S.init(M, 1536, G, bx, WGM_O);
              pg8::EpiB16<3> E{(bf16*)(ws + WS_Q), 1536, COS, SIN};
              pg8::gemm_phase<pg8::EpiB16<3>, pg8::StaticOrder, true, true>(lds, g, S, E); }
            if (ON(18)) { pg8::Gemm g{(const bf16*)(ws + WS_CKVN), (const bf16*)(ws + WS_UKV), M, 2048, 512}; pg8::StaticOrder S; S.init(M, 2048, G, bx, WGM_O);
              pg8::EpiB16<0> E{(bf16*)(ws + WS_KV), 2048, nullptr, nullptr};
              pg8::gemm_phase<pg8::EpiB16<0>, pg8::StaticOrder, true, true>(lds, g, S, E); }
            if (rep_ < DUPK(3)) xcd_barrier(bar); else SEAM(pb + 3);
        }
        if (ON(4) && IN(pb + 4)) for (int rep_ = 0; rep_ < 1 + DUPK(4); ++rep_) {
            const int tid = tid_opaque(), lane = tid & 63; const size_t gt = (size_t)bx * 512 + tid, NGT = (size_t)G * 512; (void)lane; (void)gt; (void)NGT;
            if (bx < 128) { if (ON(19) && (rep_ == 0 || (DUP_SUB & 1))) rwkv_scan(bx, INF(I_KA) + l * 1024, INF(I_KK) + l * 1024, ws, lds);
                if (PROBE_X2 == 1) { __syncthreads(); rwkv_scan(bx, INF(I_KA) + l * 1024, INF(I_KK) + l * 1024, ws, lds); } }
            else if (bx < 192) { if (ON(20) && (rep_ == 0 || (DUP_SUB & 4))) { const int qid = bx - 128, dir = qid & 1, bh = qid >> 1, h = bh & 7, b = bh >> 3;
                att::hgrn_chunk_seq((const bf16*)(ws + WS_QH) + ((size_t)dir * M + (size_t)b * SEQ) * 1024 + 128 * h, (const bf16*)(ws + WS_KH) + ((size_t)dir * M + (size_t)b * SEQ) * 1024 + 128 * h,
                                    (const bf16*)(ws + WS_Z) + (size_t)b * SEQ * ZW + ZO_H + 3072 + 128 * h, ZW, (const float*)(ws + WS_GM) + ((size_t)dir * 256 + b * 64) * 1024 + 128 * h,
                                    (const float*)(ws + WS_GL) + ((size_t)dir * 256 + b * 64) * 1024 + 128 * h, (bf16*)(ws + WS_OS) + ((size_t)dir * M + (size_t)b * SEQ) * 1024 + 128 * h, dir, (char*)lds_);
                if (PROBE_X2 == 2) att::hgrn_chunk_seq((const bf16*)(ws + WS_QH) + ((size_t)dir * M + (size_t)b * SEQ) * 1024 + 128 * h, (const bf16*)(ws + WS_KH) + ((size_t)dir * M + (size_t)b * SEQ) * 1024 + 128 * h,
                                    (const bf16*)(ws + WS_Z) + (size_t)b * SEQ * ZW + ZO_H + 3072 + 128 * h, ZW, (const float*)(ws + WS_GM) + ((size_t)dir * 256 + b * 64) * 1024 + 128 * h,
                                    (const float*)(ws + WS_GL) + ((size_t)dir * 256 + b * 64) * 1024 + 128 * h, (bf16*)(ws + WS_OS) + ((size_t)dir * M + (size_t)b * SEQ) * 1024 + 128 * h, dir, (char*)lds_); } }
            __syncthreads();
            {
                gu32* qh = ctl + CW_ATTQ + 64 * (l + 4 * rep_);
                const bf16* Q = (const bf16*)(ws + WS_Q); const bf16* KV = (const bf16*)(ws + WS_KV); const bf16* KR = (const bf16*)(ws + WS_KR); bf16* YC = (bf16*)(ws + WS_YC);
                for (;ON(21) && (rep_ == 0 || (DUP_SUB & 2));) {
                    if (tid == 0) MISC[16] = __hip_atomic_fetch_add(qh, 1u, RLX_AGENT);
                    __syncthreads(); const unsigned u = MISC[16]; __syncthreads();
                    if (u >= 512u) break;
                    const int bh = (int)(u >> 4), qb = (int)(u & 15), b = bh >> 3, h = bh & 7; const size_t row0 = (size_t)b * SEQ + (size_t)qb * 256, kr0 = (size_t)b * SEQ;
                    att::attn_dense_body(Q + row0 * 1536 + h * 192, KV + kr0 * 2048 + h * 256, KV + kr0 * 2048 + h * 256 + 128, KR + kr0 * 64, YC + row0 * 1024 + h * 128, SEQ, (char*)lds_);
                }
            }
            if (CVFILL && l + 1 < DEPTH && rep_ == 0) {
                const int l1 = l + 1; LayerW L; L.w_in = INF(I_WIN) + (size_t)l1 * 2048 * IN_W; L.w2 = INF(I_W2) + (size_t)l1 * 2 * 64 * 1024; L.a2 = INF(I_A2) + (size_t)l1 * 2 * 64 * 1024; L.g2 = INF(I_G2) + (size_t)l1 * 160 * 1024;
                L.uq = INF(I_UQ) + (size_t)l1 * 768 * 1536; L.ukv = INF(I_UKV) + (size_t)l1 * 512 * 2048; L.br = INF(I_BR) + (size_t)l1 * 3 * 1024 * 2048; L.wo = INF(I_WO) + (size_t)l1 * 2048 * 2048; L.w1 = INF(I_W1) + (size_t)l1 * 2048 * 8192; L.w2m = INF(I_W2M) + (size_t)l1 * 8192 * 2048; L.wpe = INF(I_WPE) + (size_t)l1 * 256 * 2048; L.wpg = INF(I_WPG) + (size_t)l1 * 2048 * 2048;
                gu32* qc = ctl + CW_CVQ + 64 * l;
                for (;;) {
                    if (tid == 0) MISC[16] = __hip_atomic_fetch_add(qc, 1u, RLX_AGENT);
                    __syncthreads(); const unsigned ch = MISC[16]; __syncthreads();
                    if (ch * 8u >= (unsigned)TR_EARLY) break;
                    { const TrItem T = tr_which(L, ws, (int)ch * 8 + wave); float v[32]; tr_load(T, v, lane); tr_store(T, v, (LAS float*)(lds + wave * 16384), lane); }
                }
            }
            if (rep_ < DUPK(4)) xcd_barrier(bar); else SEAM(pb + 4);
        }
        if (ON(5) && IN(pb + 5)) for (int rep_ = 0; rep_ < 1 + DUPK(5); ++rep_) {
            const int tid = tid_opaque(), lane = tid & 63; const size_t gt = (size_t)bx * 512 + tid, NGT = (size_t)G * 512; (void)lane; (void)gt; (void)NGT;
            PostP P; P.gnw = INF(I_GNW) + l * 1024; P.gnb = INF(I_GNB) + l * 1024; P.rk = INF(I_RK) + l * 1024; P.hng = INF(I_HNG) + l * 128; P.ka = INF(I_KA) + l * 1024;
            for (int m = gw; m < M; m += NGW) post_token((size_t)m, P, ws, lane);
            if (PROBE_X2 == 7) { for (int m = gw; m < M; m += NGW) post_token((size_t)m, P, ws, lane); }
            if (rep_ < DUPK(5)) xcd_barrier(bar); else SEAM(pb + 5);
        }
        if (ON(6) && IN(pb + 6)) for (int rep_ = 0; rep_ < 1 + DUPK(6); ++rep_) {
            const int tid = tid_opaque(), lane = tid & 63; const size_t gt = (size_t)bx * 512 + tid, NGT = (size_t)G * 512; (void)lane; (void)gt; (void)NGT;
            pg8::StaticOrder S; S.init(M, 2048, G, bx, WGM_O); const bf16* BR = (const bf16*)(ws + WS_BR);
            { pg8::Gemm g{(const bf16*)(ws + WS_YA), BR, M, 2048, 1024}; pg8::EpiBranch<0> E{Z, (float*)(ws + WS_MIX), (bf16*)(ws + WS_MIXED)}; pg8::gemm_phase<pg8::EpiBranch<0>, pg8::StaticOrder, true, true>(lds, g, S, E); }
            VM_WAIT(); __syncthreads();
            { pg8::Gemm g{(const bf16*)(ws + WS_YB), BR + (size_t)2048 * 1024, M, 2048, 1024}; pg8::EpiBranch<1> E{Z, (float*)(ws + WS_MIX), (bf16*)(ws + WS_MIXED)}; pg8::gemm_phase<pg8::EpiBranch<1>, pg8::StaticOrder, true, true>(lds, g, S, E); }
            VM_WAIT(); __syncthreads();
            { pg8::Gemm g{(const bf16*)(ws + WS_YC), BR + (size_t)2 * 2048 * 1024, M, 2048, 1024}; pg8::EpiBranch<2> E{Z, (float*)(ws + WS_MIX), (bf16*)(ws + WS_MIXED)}; pg8::gemm_phase<pg8::EpiBranch<2>, pg8::StaticOrder, true, true>(lds, g, S, E); }
            if (rep_ < DUPK(6)) xcd_barrier(bar); else SEAM(pb + 6);
        }
        if (ON(7) && IN(pb + 7)) for (int rep_ = 0; rep_ < 1 + DUPK(7); ++rep_) {
            const int tid = tid_opaque(), lane = tid & 63; const size_t gt = (size_t)bx * 512 + tid, NGT = (size_t)G * 512; (void)lane; (void)gt; (void)NGT;
            pg8::Gemm g{(const bf16*)(ws + WS_MIXED), (const bf16*)(ws + WS_WO), M, 2048, 2048}; pg8::StaticOrder S; S.init(M, 2048, G, bx, WGM_O);
            pg8::EpiResid<2> E{H, XN, INF(I_LN2) + l * 2048, (float*)(ws + WS_SS) + (size_t)M * 32};
            pg8::gemm_phase<pg8::EpiResid<2>, pg8::StaticOrder, true, true>(lds, g, S, E);
            if (rep_ < DUPK(7)) xcd_barrier(bar); else SEAM(pb + 7);
        }
        if (ON(8) && IN(pb + 8)) for (int rep_ = 0; rep_ < 1 + DUPK(8); ++rep_) {
            const int tid = tid_opaque(), lane = tid & 63; const size_t gt = (size_t)bx * 512 + tid, NGT = (size_t)G * 512; (void)lane; (void)gt; (void)NGT;
            { const float* SSP = (const float*)(ws + WS_SS) + (size_t)M * 32; float* RSO = (float*)(ws + WS_RSTD) + M; for (int m0 = gw * 2 + (lane >> 5); m0 < M; m0 += NGW * 8) { float q4_[4];
#pragma unroll
              for (int i = 0; i < 4; ++i) { const int m = m0 + i * NGW * 2; q4_[i] = m < M ? SSP[(size_t)m * 32 + (lane & 31)] : 0.f; }
#pragma unroll
              for (int i = 0; i < 4; ++i) { const int m = m0 + i * NGW * 2; float q = q4_[i]; q += __shfl_xor(q, 1); q += __shfl_xor(q, 2); q += __shfl_xor(q, 4); q += __shfl_xor(q, 8); q += __shfl_xor(q, 16); if ((lane & 31) == 0 && m < M) RSO[m] = __builtin_amdgcn_rsqf(q * (1.0f / 2048.0f) + 1e-6f); } } }
            pg8::Gemm g{PB, (const bf16*)(ws + WS_WPE), M, 2048, 256}; pg8::StaticOrder S; S.init(M, 2048, G, bx, WGM_O);
            pg8::EpiB16<0> E{(bf16*)(ws + WS_PE), 2048, nullptr, nullptr};
            pg8::gemm_phase<pg8::EpiB16<0>, pg8::StaticOrder, true, true>(lds, g, S, E);
            if (rep_ < DUPK(8)) xcd_barrier(bar); else SEAM(pb + 8);
        }
        if (ON(9) && IN(pb + 9)) for (int rep_ = 0; rep_ < 1 + DUPK(9); ++rep_) {
            const int tid = tid_opaque(), lane = tid & 63; const size_t gt = (size_t)bx * 512 + tid, NGT = (size_t)G * 512; (void)lane; (void)gt; (void)NGT;
            pg8::Gemm g{XN, (const bf16*)(ws + WS_W1), M, DFF, 2048}; pg8::StaticOrder S; S.init(M, DFF, G, bx, WGM_M1);
            pg8::EpiB16<2> E{(bf16*)(ws + WS_HID), DFF, (const float*)(ws + WS_RSTD) + M, nullptr};
            pg8::gemm_phase<pg8::EpiB16<2>, pg8::StaticOrder, true, true>(lds, g, S, E);
            if (PROBE_X2 == 4) { __syncthreads(); pg8::gemm_phase<pg8::EpiB16<2>, pg8::StaticOrder, true, true>(lds, g, S, E); }
            if (rep_ < DUPK(9)) xcd_barrier(bar); else SEAM(pb + 9);
        }
        if (ON(10) && IN(pb + 10)) for (int rep_ = 0; rep_ < 1 + DUPK(10); ++rep_) {
            const int tid = tid_opaque(), lane = tid & 63; const size_t gt = (size_t)bx * 512 + tid, NGT = (size_t)G * 512; (void)lane; (void)gt; (void)NGT;
            pg8::Gemm g{(const bf16*)(ws + WS_HID), (const bf16*)(ws + WS_W2), M, 2048, DFF}; pg8::StaticOrder S; S.init(M, 2048, G, bx, WGM_M2);
            pg8::EpiResid<1> E{H, (bf16*)(ws + WS_HB), nullptr, nullptr};
            pg8::gemm_phase<pg8::EpiResid<1>, pg8::StaticOrder, true, true>(lds, g, S, E);
            if (rep_ < DUPK(10)) xcd_barrier(bar); else SEAM(pb + 10);
        }
        if (ON(11) && IN(pb + 11)) for (int rep_ = 0; rep_ < 1 + DUPK(11); ++rep_) {
            const int tid = tid_opaque(), lane = tid & 63; const size_t gt = (size_t)bx * 512 + tid, NGT = (size_t)G * 512; (void)lane; (void)gt; (void)NGT;
            pg8::Gemm g{(const bf16*)(ws + WS_HB), (const bf16*)(ws + WS_WPG), M, 2048, 2048}; pg8::StaticOrder S; S.init(M, 2048, G, bx, WGM_O);
            pg8::EpiPG E{H, (const bf16*)(ws + WS_PE), XN, l + 1 < DEPTH ? INF(I_LN1) + (l + 1) * 2048 : INF(I_FG), (float*)(ws + WS_SS)};
            pg8::gemm_phase<pg8::EpiPG, pg8::StaticOrder, true, true>(lds, g, S, E);
            if (rep_ < DUPK(11)) xcd_barrier(bar); else SEAM(pb + 11);
        }
    }
    if (IN(NPHASES - 1)) {
        const int lane = tid_opaque() & 63;
        const float* SSf = (const float*)(ws + WS_SS);
        for (int m = gw; m < M; m += NGW) { float q = lane < 32 ? SSf[(size_t)m * 32 + lane] : 0.f; q = wave_sum(q); const float rstd = __builtin_amdgcn_rsqf(q * (1.0f / 2048.0f) + 1e-6f); f32x4* hr = (f32x4*)(H + (size_t)m * 2048) + lane;
#pragma unroll
            for (int j = 0; j < 8; ++j) hr[64 * j] = hr[64 * j] * rstd * ((const f32x4*)INF(I_FG))[64 * j + lane]; }
    }
#undef IN
#undef SEAM
}

extern "C" void kernel_launch(void* const* d_in, const int* in_sizes, int n_in, void* d_out, int out_size, void* d_ws, size_t ws_size, hipStream_t stream) {
    static int grid = 0;
    if (grid == 0) {
        if (n_in != 30 || out_size != M * DM || ws_size < WS_END) { fprintf(stderr, "kernel_launch: unexpected shapes: n_in %d out %d ws %zu (need %zu)\n", n_in, out_size, ws_size, (size_t)WS_END); grid = -1; return; }
        int dev = 0, cus = 0, per_cu = 0;
        if (hipGetDevice(&dev) != hipSuccess || hipDeviceGetAttribute(&cus, hipDeviceAttributeMultiprocessorCount, dev) != hipSuccess) { grid = -1; return; }
        if (hipFuncSetAttribute((const void*)fwd, hipFuncAttributeMaxDynamicSharedMemorySize, LDS_BYTES) != hipSuccess) { fprintf(stderr, "kernel_launch: hipFuncSetAttribute failed\n"); grid = -1; return; }
        if (hipOccupancyMaxActiveBlocksPerMultiprocessor(&per_cu, (const void*)fwd, NWAVES * 64, LDS_BYTES) != hipSuccess || per_cu < 1) fprintf(stderr, "kernel_launch: occupancy query reports %d blocks per CU\n", per_cu);
        (void)hipGetLastError();
        grid = cus;
        if (grid != 256) fprintf(stderr, "kernel_launch: %d CUs; the phase-4 role split assumes 256 workgroups\n", grid);
    }
    if (grid < 0) return;
    unsigned char* ws = (unsigned char*)d_ws;
    (void)hipMemsetAsync(ws + WS_CTL, 0, CTL_ZERO_BYTES, stream);
    Args a{};
    for (int i = 0; i < 30; ++i) a.in[i] = d_in[i];
    a.out = (float*)d_out; a.ws = ws;
    for (int li = 0; li < N_LAUNCHES; ++li) {
        if (N_LAUNCHES == 1) { a.ph_lo = 0; a.ph_hi = NPHASES; } else { a.ph_lo = li; a.ph_hi = li + 1; }
        hipLaunchKernelGGL(fwd, dim3(grid), dim3(NWAVES * 64), LDS_BYTES, stream, a);
        const hipError_t le = hipPeekAtLastError();
        if (le != hipSuccess) { fprintf(stderr, "kernel_launch: launch %d failed: %s\n", li, hipGetErrorName(le)); break; }
    }
}
```

```cpp
#include <hip/hip_runtime.h>
#include <cstdio>
#include <cstdint>
__device__ __forceinline__ int tid_opaque() { int t = threadIdx.x; asm volatile("" : "+v"(t)); return t; }

#ifndef MK_N_LAUNCHES
#define MK_N_LAUNCHES 1
#endif

constexpr int DM = 2048, NBATCH = 4, SEQ = 4096, DEPTH = 4, M = NBATCH * SEQ, BW = 1024;
constexpr int RWKV_W = 3488, IN_W = 16096, DFF = 8192, PLE = 256;
constexpr int ZW = 16384;
constexpr int ZO_A = 0, ZO_H = 3584, ZO_C = 8704, ZO_G = 10240;
constexpr int NPH_LAYER = 12, NPHASES = 2 + DEPTH * NPH_LAYER;

constexpr size_t MiB = 1u << 20;
constexpr size_t WS_CTL = 0, CTL_ZERO_BYTES = 1 * MiB;
constexpr size_t WS_COS = 1 * MiB, WS_SIN = 3 * MiB, WS_LB = 5 * MiB;
constexpr size_t WS_SS = 1402 * MiB, WS_RSTD = 1422 * MiB;
constexpr size_t WS_PB = 6 * MiB;
constexpr size_t WS_WIN = 14 * MiB, WS_LORA = 78 * MiB, WS_UQ = 83 * MiB, WS_UKV = 86 * MiB, WS_BR = 88 * MiB, WS_WO = 100 * MiB,
                 WS_W1 = 108 * MiB, WS_W2 = 140 * MiB, WS_WPE = 172 * MiB, WS_WPG = 173 * MiB;
constexpr size_t WS_XN = 182 * MiB;
constexpr size_t WS_ALORA = WS_XN, WS_CQN = WS_XN + 16 * MiB, WS_CKVN = WS_XN + 40 * MiB;
constexpr size_t WS_Z = 246 * MiB;
constexpr size_t WS_HID = WS_Z, WS_HB = WS_Z + 256 * MiB, WS_PE = WS_Z + 320 * MiB;
constexpr size_t WS_SCAN = 758 * MiB;
constexpr size_t WS_R = WS_SCAN, WS_KAP = WS_SCAN + 64 * MiB, WS_W = WS_SCAN + 128 * MiB, WS_A = WS_SCAN + 256 * MiB;
constexpr size_t WS_MIX = WS_SCAN, WS_MIXED = WS_SCAN + 128 * MiB;
constexpr size_t WS_QH = 1270 * MiB, WS_KH = 1334 * MiB, WS_GM = 1398 * MiB, WS_GL = 1400 * MiB;
constexpr size_t WS_KS = 1462 * MiB, WS_G = 1526 * MiB;
constexpr size_t WS_V = 1832 * MiB;
constexpr size_t WS_Q = 1558 * MiB, WS_KV = 1606 * MiB, WS_KR = 1670 * MiB;
constexpr size_t WS_YA = WS_Q, WS_YB = WS_Q + 32 * MiB;
constexpr size_t WS_YC = 1672 * MiB;
constexpr size_t WS_YS = 1704 * MiB, WS_OS = 1768 * MiB;
constexpr size_t WS_END = 1896 * MiB;
constexpr int CW_BAR = 4096, CW_ATTQ = 8192, CW_CVQ = 12288;

namespace pg8 {
#define PG8_LAS __attribute__((address_space(3)))
typedef unsigned short bf16_t;
typedef short bf16x8 __attribute__((ext_vector_type(8)));
typedef float f32x4 __attribute__((ext_vector_type(4)));
typedef unsigned u32x4 __attribute__((ext_vector_type(4)));
constexpr int BM = 256, BK = 64, HALF = 128, HTB = HALF * BK * 2  , STAGE_BYTES = 8 * HTB, NXCD = 8, WGM = 4;

__host__ __device__ __forceinline__ int lds_byte(int r, int c) { const int st = (r >> 4) * 2 + (c >> 5), rr = r & 15, cc = c & 31, ob = rr * 64 + cc * 2; return st * 1024 + (ob ^ (((ob >> 9) & 1) << 5)); }
__host__ __device__ __forceinline__ void stage_rc(int b, int& R, int& C) { const int st = b / 1024, sb = b % 1024, swz = sb ^ (((sb >> 9) & 1) << 5); R = (st >> 1) * 16 + swz / 64; C = (st & 1) * 32 + (swz % 64) / 2; }
__host__ __device__ __forceinline__ int perm32(int rho) { const int n = rho >> 4, i = rho & 15; return 8 * (i >> 2) + 4 * n + (i & 3); }

struct Unit { int pm, pn; };
struct Gemm { const bf16_t* A; const bf16_t* Bt; int M, N, K; };

struct StaticOrder {
    int nM, nN, nwg, G, c, wgm, rev;
    __host__ __device__ void init(int M, int N, int G_, int c_, int wgm_ = WGM, int rev_ = 0) { nM = M / BM; nN = N / BM; nwg = nM * nN; G = G_; c = c_; wgm = wgm_; rev = rev_; }
    __host__ __device__ bool next(int i, Unit& u) const {
        if (rev) { const int per = (nwg - c + G - 1) / G; if (i >= per) return false; i = per - 1 - i; }
        const long L = (long)i * G + c; if (L >= nwg) return false;
        int wgid = (int)L; { const int q = nwg / NXCD, r = nwg % NXCD, xcd = wgid % NXCD, off = wgid / NXCD; wgid = (xcd < r ? xcd * (q + 1) : r * (q + 1) + (xcd - r) * q) + off; }
        const int nig = wgm * nN, gid = wgid / nig, fm = gid * wgm, gsz = (nM - fm) < wgm ? (nM - fm) : wgm;
        u.pm = fm + ((wgid % nig) % gsz); u.pn = (wgid % nig) / gsz; return true;
    }
    __device__ __forceinline__ void a_ready(const Unit&) const {}
    __device__ __forceinline__ void done(const Unit&) const {}
};

typedef float cvt_f32x2 __attribute__((ext_vector_type(2))); typedef __bf16 cvt_bf16x2 __attribute__((ext_vector_type(2))); typedef _Float16 cvt_h16x2 __attribute__((ext_vector_type(2)));
__device__ __forceinline__ unsigned cvt_pk_bf16(float lo, float hi) { const cvt_f32x2 v = {lo, hi}; return __builtin_bit_cast(unsigned, __builtin_convertvector(v, cvt_bf16x2)); }
typedef float f32x2 __attribute__((ext_vector_type(2)));
typedef unsigned u32x2 __attribute__((ext_vector_type(2)));
__device__ __forceinline__ float sigm(float x) { return __builtin_amdgcn_rcpf(1.0f + __expf(-x)); }
__device__ __forceinline__ f32x4 sigm4(f32x4 v) { f32x4 o; o[0] = sigm(v[0]); o[1] = sigm(v[1]); o[2] = sigm(v[2]); o[3] = sigm(v[3]); return o; }
__device__ __forceinline__ f32x4 bf4_to_f32(u32x2 w) { f32x4 o; o[0] = __uint_as_float(w.x << 16); o[1] = __uint_as_float(w.x & 0xffff0000u); o[2] = __uint_as_float(w.y << 16); o[3] = __uint_as_float(w.y & 0xffff0000u); return o; }
__device__ __forceinline__ u32x2 f32_to_bf4(f32x4 v) { u32x2 w; w.x = cvt_pk_bf16(v[0], v[1]); w.y = cvt_pk_bf16(v[2], v[3]); return w; }
#define EPI_ROWS(ai, m) _Pragma("unroll") for (int ai = 0; ai < 2; ++ai) _Pragma("unroll") for (int m = 0; m < 4; ++m)
#define EPI_COLS(bj, n) _Pragma("unroll") for (int bj = 0; bj < 2; ++bj) _Pragma("unroll") for (int n = 0; n < 2; ++n)

template <int MODE> struct EpiB16 {
    static constexpr bool PERM = true, AFTER_DRAIN = false;
    bf16_t* O; int ldc; const float* COS; const float* SIN;
    __device__ __forceinline__ void operator()(const f32x4 (&acc)[2][2][4][2], const Unit& u, int wr, int wc, int fr, int fq) const {
        const int row0 = u.pm * BM + wr * 64 + fr, col0 = u.pn * BM + wc * 32 + 8 * fq;
        float rs[2][4];
        if (MODE == 1 || MODE == 2) { EPI_ROWS(ai, m) rs[ai][m] = COS[row0 + ai * HALF + m * 16]; }
        EPI_ROWS(ai, m) { const int row = row0 + ai * HALF + m * 16; bf16_t* rowp = O + (size_t)row * ldc + col0;
            float rstd = 1.f; if (MODE == 1 || MODE == 2) rstd = rs[ai][m];
#pragma unroll
            for (int bj = 0; bj < 2; ++bj) { f32x4 v0 = acc[ai][bj][m][0], v1 = acc[ai][bj][m][1];
                if (MODE == 1) { v0 = v0 * rstd; v1 = v1 * rstd; if (u.pn >= 40) { v0 = sigm4(v0); v1 = sigm4(v1); } }
                if (MODE == 2) {
#pragma unroll
                    for (int j = 0; j < 4; ++j) { const float a = fmaxf(v0[j], 0.f) * rstd, b = fmaxf(v1[j], 0.f) * rstd; v0[j] = a * a; v1[j] = b * b; } }
                if (MODE == 3) { const int j192 = (col0 + bj * HALF) % 192;
                    if (j192 >= 128) { const int i0 = (j192 - 128) >> 1; const f32x4 c = *(const f32x4*)(COS + (size_t)row * 32 + i0), s = *(const f32x4*)(SIN + (size_t)row * 32 + i0);
                        f32x4 a, b; a[0] = v0[0] * c[0] - v0[1] * s[0]; a[1] = v0[1] * c[0] + v0[0] * s[0]; a[2] = v0[2] * c[1] - v0[3] * s[1]; a[3] = v0[3] * c[1] + v0[2] * s[1];
                        b[0] = v1[0] * c[2] - v1[1] * s[2]; b[1] = v1[1] * c[2] + v1[0] * s[2]; b[2] = v1[2] * c[3] - v1[3] * s[3]; b[3] = v1[3] * c[3] + v1[2] * s[3]; v0 = a; v1 = b; } }
                u32x4 w; w.x = cvt_pk_bf16(v0[0], v0[1]); w.y = cvt_pk_bf16(v0[2], v0[3]); w.z = cvt_pk_bf16(v1[0], v1[1]); w.w = cvt_pk_bf16(v1[2], v1[3]);
                if (MODE == 1) __builtin_nontemporal_store(w, (u32x4*)(rowp + bj * HALF)); else *(u32x4*)(rowp + bj * HALF) = w; } }
    }
};
struct EpiLora {
    static constexpr bool PERM = false, AFTER_DRAIN = false;
    const float* w0; const float* a0;
    unsigned short* W; bf16_t* A; bf16_t* G; int pn_off;
    __device__ __forceinline__ void operator()(const f32x4 (&acc)[2][2][4][2], const Unit& u, int wr, int wc, int fr, int fq) const {
        const int pn = u.pn + pn_off; const int row0 = u.pm * BM + wr * 64 + fr, cc0 = (pn & 3) * BM + wc * 32 + 4 * fq;
        if (pn < 8) { const int dir = pn >> 2; f32x4 wv[2][2];
            EPI_COLS(bj, n) wv[bj][n] = *(const f32x4*)(w0 + dir * 1024 + cc0 + bj * HALF + n * 16);
            EPI_ROWS(ai, m) { unsigned short* rowp = W + ((size_t)dir * M + row0 + ai * HALF + m * 16) * 1024 + cc0;
                EPI_COLS(bj, n) { const f32x4 s = sigm4(wv[bj][n] + acc[ai][bj][m][n]); f32x4 o;
#pragma unroll
                    for (int j = 0; j < 4; ++j) o[j] = __expf(-0.606531f * s[j]);
                    const cvt_f32x2 oa = {o[0], o[1]}, ob = {o[2], o[3]}; u32x2 wv_; wv_.x = __builtin_bit_cast(unsigned, __builtin_convertvector(oa, cvt_h16x2)); wv_.y = __builtin_bit_cast(unsigned, __builtin_convertvector(ob, cvt_h16x2));
                    *(u32x2*)(rowp + bj * HALF + n * 16) = wv_; } }
        } else if (pn < 16) { const int dir = (pn - 8) >> 2; f32x4 av[2][2];
            EPI_COLS(bj, n) av[bj][n] = *(const f32x4*)(a0 + dir * 1024 + cc0 + bj * HALF + n * 16);
            EPI_ROWS(ai, m) { bf16_t* rowp = A + ((size_t)dir * M + row0 + ai * HALF + m * 16) * 1024 + cc0;
                EPI_COLS(bj, n) *(u32x2*)(rowp + bj * HALF + n * 16) = f32_to_bf4(sigm4(av[bj][n] + acc[ai][bj][m][n])); }
        } else {
            EPI_ROWS(ai, m) { bf16_t* rowp = G + (size_t)(row0 + ai * HALF + m * 16) * 1024 + cc0;
                EPI_COLS(bj, n) *(u32x2*)(rowp + bj * HALF + n * 16) = f32_to_bf4(acc[ai][bj][m][n]); }
        }
    }
};
template <int NB> struct EpiBranch {
    static constexpr bool PERM = false, AFTER_DRAIN = false;
    const bf16_t* Z; float* MIX; bf16_t* MIXED;
    __device__ __forceinline__ void operator()(const f32x4 (&acc)[2][2][4][2], const Unit& u, int wr, int wc, int fr, int fq) const {
        const int row0 = u.pm * BM + wr * 64 + fr, col0 = u.pn * BM + wc * 32 + 4 * fq;
#pragma unroll
        for (int ai = 0; ai < 2; ++ai)
#pragma unroll
            for (int mh = 0; mh < 2; ++mh) { u32x2 gq[2][2][2]; f32x4 mq[2][2][2];
#pragma unroll
                for (int e = 0; e < 2; ++e) { const size_t row = (size_t)(row0 + ai * HALF + (2 * mh + e) * 16); const bf16_t* gp = Z + row * 16384 + 10240 + NB * 2048 + col0; const float* mp = MIX + row * 2048 + col0;
                    EPI_COLS(bj, n) { const int co = bj * HALF + n * 16; gq[e][bj][n] = *(const u32x2*)(gp + co); if (NB >= 1) mq[e][bj][n] = *(const f32x4*)(mp + co); } }
#pragma unroll
                for (int e = 0; e < 2; ++e) { const int m = 2 * mh + e; const size_t row = (size_t)(row0 + ai * HALF + m * 16); float* mp = MIX + row * 2048 + col0;
                    EPI_COLS(bj, n) { const int co = bj * HALF + n * 16; f32x4 v = bf4_to_f32(gq[e][bj][n]) * acc[ai][bj][m][n];
                        if (NB >= 1) v += mq[e][bj][n];
                        if (NB < 2) *(f32x4*)(mp + co) = v; else *(u32x2*)(MIXED + row * 2048 + col0 + co) = f32_to_bf4(v); } } }
    }
};
__device__ __forceinline__ void norm_feed(const f32x4 (&h)[2][2], const float* g, bf16_t* xn, float* ss, int fq) {
    float q = 0.f;
    EPI_COLS(bj, n) { const f32x4 v = h[bj][n]; q += (v[0] * v[0] + v[1] * v[1]) + (v[2] * v[2] + v[3] * v[3]);
        *(u32x2*)(xn + bj * HALF + n * 16) = f32_to_bf4(v * *(const f32x4*)(g + bj * HALF + n * 16)); }
    q += __shfl_xor(q, 16); q += __shfl_xor(q, 32);
    if (fq == 0) *ss = q;
}
template <int MODE> struct EpiResid {
    static constexpr bool PERM = false, AFTER_DRAIN = false;
    float* H; bf16_t* HB; const float* G; float* SS;
    __device__ __forceinline__ void operator()(const f32x4 (&acc)[2][2][4][2], const Unit& u, int wr, int wc, int fr, int fq) const {
        const int row0 = u.pm * BM + wr * 64 + fr, col0 = u.pn * BM + wc * 32 + 4 * fq;
#pragma unroll
        for (int ai = 0; ai < 2; ++ai)
#pragma unroll
            for (int mp = 0; mp < 2; ++mp) { f32x4 hv[2][2][2];
#pragma unroll
                for (int e = 0; e < 2; ++e) { const size_t ro = (size_t)(row0 + ai * HALF + (2 * mp + e) * 16) * 2048 + col0; EPI_COLS(bj, n) hv[e][bj][n] = *(const f32x4*)(H + ro + bj * HALF + n * 16); }
#pragma unroll
                for (int e = 0; e < 2; ++e) { const int m = 2 * mp + e, row = row0 + ai * HALF + m * 16; const size_t ro = (size_t)row * 2048 + col0;
                    EPI_COLS(bj, n) { const int co = bj * HALF + n * 16; const f32x4 v = hv[e][bj][n] + acc[ai][bj][m][n]; *(f32x4*)(H + ro + co) = v; hv[e][bj][n] = v;
                        if (MODE == 1) *(u32x2*)(HB + ro + co) = f32_to_bf4(v); }
                    if (MODE == 2) norm_feed(hv[e], G + col0, HB + ro, SS + (size_t)row * 32 + u.pn * 4 + wc, fq); } }
    }
};
struct EpiPG {
    static constexpr bool PERM = false, AFTER_DRAIN = false;
    float* H; const bf16_t* PE; bf16_t* XN; const float* G; float* SS;
    __device__ __forceinline__ void operator()(const f32x4 (&acc)[2][2][4][2], const Unit& u, int wr, int wc, int fr, int fq) const {
        const int row0 = u.pm * BM + wr * 64 + fr, col0 = u.pn * BM + wc * 32 + 4 * fq;
#pragma unroll
        for (int ai = 0; ai < 2; ++ai)
#pragma unroll
            for (int mp = 0; mp < 2; ++mp) { f32x4 hv[2][2][2]; u32x2 pq_[2][2][2];
#pragma unroll
                for (int e = 0; e < 2; ++e) { const size_t ro = (size_t)(row0 + ai * HALF + (2 * mp + e) * 16) * 2048 + col0; EPI_COLS(bj, n) { const int co = bj * HALF + n * 16; pq_[e][bj][n] = *(const u32x2*)(PE + ro + co); hv[e][bj][n] = *(const f32x4*)(H + ro + co); } }
#pragma unroll
                for (int e = 0; e < 2; ++e) { const int m = 2 * mp + e, row = row0 + ai * HALF + m * 16; const size_t ro = (size_t)row * 2048 + col0;
                    EPI_COLS(bj, n) { const int co = bj * HALF + n * 16; const f32x4 v = hv[e][bj][n] + sigm4(acc[ai][bj][m][n]) * bf4_to_f32(pq_[e][bj][n]); *(f32x4*)(H + ro + co) = v; hv[e][bj][n] = v; }
                    norm_feed(hv[e], G + col0, XN + ro, SS + (size_t)row * 32 + u.pn * 4 + wc, fq); } }
    }
};

template <class Epi, class Sched, bool ALIGN_EPI = false, bool SP2 = false>
__device__ __forceinline__ void gemm_phase(PG8_LAS unsigned char* lds, const Gemm g, const Sched& S, const Epi& E) {
    const int tid = tid_opaque(), wid = __builtin_amdgcn_readfirstlane(tid >> 6), lane = tid & 63, wr = wid >> 2, wc = wid & 3, fr = lane & 15, fq = lane >> 4;
    int K_ = g.K; asm volatile("" : "+s"(K_)); const int K = K_, nt = K / BK;
    unsigned voffA[2], voffB[2];
#pragma unroll
    for (int i = 0; i < 2; ++i) { int R, C; stage_rc(tid * 16 + i * 8192, R, C); const int Rb = Epi::PERM ? ((R & ~31) + perm32(R & 31)) : R;
        voffA[i] = (unsigned)(R * K + C) * 2u; voffB[i] = (unsigned)(Rb * K + C) * 2u; }
    const size_t kstep = (size_t)(BK * 2);
    const size_t hstep = (size_t)HALF * K * 2;
    const size_t tstep = 2 * hstep;
    const unsigned ldsw = (unsigned)wid * 1024u;
    const int aoff = lds_byte(wr * 64 + fr, fq * 8), boff = lds_byte(wc * 32 + fr, fq * 8);
#define PG8_SA(b, h) (((b) * 2 + (h)) * HTB)
#define PG8_SB(b, h) ((4 + (b) * 2 + (h)) * HTB)
#define PG8_STAGE(bufoff, gbase, voff) do { _Pragma("unroll") for (int _i = 0; _i < 2; ++_i) \
        __builtin_amdgcn_global_load_lds((const unsigned*)((const char*)(gbase) + (voff)[_i]), (PG8_LAS unsigned*)(lds + (bufoff) + ldsw + _i * 8192), 16, 0, 0); } while (0)
#define PG8_LDA(dst, b, h) do { _Pragma("unroll") for (int m = 0; m < 4; ++m) _Pragma("unroll") for (int k = 0; k < 2; ++k) dst[m][k] = *(const PG8_LAS bf16x8*)(lds + PG8_SA(b, h) + aoff + m * 2048 + k * 1024); } while (0)
#define PG8_LDB(dst, b, h) do { _Pragma("unroll") for (int n = 0; n < 2; ++n) _Pragma("unroll") for (int k = 0; k < 2; ++k) dst[n][k] = *(const PG8_LAS bf16x8*)(lds + PG8_SB(b, h) + boff + n * 2048 + k * 1024); } while (0)
#define PG8_MMA(ai, bj, At, Bt) do { __builtin_amdgcn_s_setprio(1); _Pragma("unroll") for (int m = 0; m < 4; ++m) _Pragma("unroll") for (int n = 0; n < 2; ++n) _Pragma("unroll") for (int k = 0; k < 2; ++k) \
        acc[ai][bj][m][n] = __builtin_amdgcn_mfma_f32_16x16x32_bf16(Bt[n][k], At[m][k], acc[ai][bj][m][n], 0, 0, 0); __builtin_amdgcn_s_setprio(0); } while (0)
#define PG8_WAIT_V(n) asm volatile("s_waitcnt vmcnt(" #n ")" ::: "memory")
#define PG8_WAIT_L(n) asm volatile("s_waitcnt lgkmcnt(" #n ")" ::: "memory")
#define PG8_BAR __builtin_amdgcn_s_barrier()
#define PG8_SCHED __builtin_amdgcn_sched_barrier(0)
    Unit cur, nxt; int ui = 0;
    if (!S.next(0, cur)) return;
    f32x4 acc[2][2][4][2];
#pragma unroll
    for (int a = 0; a < 2; ++a)
#pragma unroll
        for (int b = 0; b < 2; ++b)
#pragma unroll
            for (int m = 0; m < 4; ++m)
#pragma unroll
                for (int n = 0; n < 2; ++n) acc[a][b][m][n] = (f32x4){0.f, 0.f, 0.f, 0.f};
    bf16x8 At[4][2], B0[2][2], B1[2][2];
    const char* cA = (const char*)g.A + (size_t)cur.pm * tstep; const char* cB = (const char*)g.Bt + (size_t)cur.pn * tstep;
    S.a_ready(cur);
    if constexpr (SP2) {
        PG8_STAGE(PG8_SB(0, 0), cB, voffB); PG8_STAGE(PG8_SB(0, 1), cB + hstep, voffB); PG8_STAGE(PG8_SA(0, 0), cA, voffA); PG8_STAGE(PG8_SA(0, 1), cA + hstep, voffA);
        if (wr == 1) PG8_BAR;
        PG8_WAIT_V(2); PG8_BAR;
        PG8_STAGE(PG8_SB(1, 0), cB + kstep, voffB); PG8_STAGE(PG8_SA(1, 0), cA + kstep, voffA); PG8_STAGE(PG8_SB(1, 1), cB + hstep + kstep, voffB);
        PG8_WAIT_V(6); PG8_BAR;
    } else {
        PG8_STAGE(PG8_SB(0, 0), cB, voffB); PG8_STAGE(PG8_SA(0, 0), cA, voffA); PG8_STAGE(PG8_SB(0, 1), cB + hstep, voffB); PG8_STAGE(PG8_SA(0, 1), cA + hstep, voffA);
        if (wr == 1) PG8_BAR;
        PG8_WAIT_V(4); PG8_BAR;
        PG8_STAGE(PG8_SB(1, 0), cB + kstep, voffB); PG8_STAGE(PG8_SA(1, 0), cA + kstep, voffA); PG8_STAGE(PG8_SB(1, 1), cB + hstep + kstep, voffB);
        PG8_WAIT_V(6); PG8_BAR;
    }
    for (;;) {
        const bool has_next = S.next(ui + 1, nxt);
        const char* nA = has_next ? (const char*)g.A + (size_t)nxt.pm * tstep : cA; const char* nB = has_next ? (const char*)g.Bt + (size_t)nxt.pn * tstep : cB;
        for (int t = 0; t < nt; t += 2) {
            const bool last = (t == nt - 2);
            const char* a1 = cA + (size_t)(t + 1) * kstep;
            const char* a2 = last ? nA : cA + (size_t)(t + 2) * kstep; const char* b2 = last ? nB : cB + (size_t)(t + 2) * kstep;
            const char* a3 = a2 + kstep; const char* b3 = b2 + kstep;
            if (last && has_next) S.a_ready(nxt);
            if constexpr (SP2) {
            PG8_LDB(B0, 0, 0); PG8_LDB(B1, 0, 1); PG8_SCHED; PG8_LDA(At, 0, 0); PG8_STAGE(PG8_SA(1, 1), a1 + hstep, voffA);
            PG8_WAIT_V(8); PG8_WAIT_L(0); PG8_BAR; PG8_MMA(0, 0, At, B0); PG8_MMA(0, 1, At, B1); PG8_BAR; PG8_SCHED;
            PG8_LDA(At, 0, 1); PG8_STAGE(PG8_SB(0, 0), b2, voffB); PG8_STAGE(PG8_SB(0, 1), b2 + hstep, voffB); PG8_STAGE(PG8_SA(0, 0), a2, voffA);
            PG8_WAIT_V(8); PG8_WAIT_L(0); PG8_BAR; PG8_MMA(1, 0, At, B0); PG8_MMA(1, 1, At, B1); PG8_BAR; PG8_SCHED;
            PG8_LDB(B0, 1, 0); PG8_LDB(B1, 1, 1); PG8_SCHED; PG8_LDA(At, 1, 0); PG8_STAGE(PG8_SA(0, 1), a2 + hstep, voffA);
            PG8_WAIT_V(8); PG8_WAIT_L(0); PG8_BAR; PG8_MMA(0, 0, At, B0); PG8_MMA(0, 1, At, B1); PG8_BAR; PG8_SCHED;
            PG8_LDA(At, 1, 1); PG8_STAGE(PG8_SB(1, 0), b3, voffB); PG8_STAGE(PG8_SB(1, 1), b3 + hstep, voffB); PG8_STAGE(PG8_SA(1, 0), a3, voffA);
            PG8_WAIT_V(8); PG8_WAIT_L(0); PG8_BAR; PG8_MMA(1, 0, At, B0); PG8_MMA(1, 1, At, B1); PG8_BAR; PG8_SCHED;
            } else {
            PG8_LDB(B0, 0, 0); PG8_SCHED; PG8_LDA(At, 0, 0); PG8_STAGE(PG8_SA(1, 1), a1 + hstep, voffA);
            PG8_WAIT_L(8); PG8_BAR; PG8_WAIT_L(0); PG8_MMA(0, 0, At, B0); PG8_BAR; PG8_SCHED;
            PG8_LDB(B1, 0, 1); PG8_STAGE(PG8_SB(0, 0), b2, voffB);
            PG8_BAR; PG8_WAIT_L(0); PG8_MMA(0, 1, At, B1); PG8_BAR;
            PG8_LDA(At, 0, 1); PG8_STAGE(PG8_SA(0, 0), a2, voffA);
            PG8_BAR; PG8_WAIT_L(0); PG8_MMA(1, 0, At, B0); PG8_BAR; PG8_SCHED;
            PG8_STAGE(PG8_SB(0, 1), b2 + hstep, voffB);
            PG8_WAIT_V(6); PG8_BAR; PG8_MMA(1, 1, At, B1); PG8_BAR;
            PG8_LDB(B0, 1, 0); PG8_SCHED; PG8_LDA(At, 1, 0); PG8_STAGE(PG8_SA(0, 1), a2 + hstep, voffA);
            PG8_WAIT_L(8); PG8_BAR; PG8_WAIT_L(0); PG8_MMA(0, 0, At, B0); PG8_BAR; PG8_SCHED;
            PG8_LDB(B1, 1, 1); PG8_STAGE(PG8_SB(1, 0), b3, voffB);
            PG8_BAR; PG8_WAIT_L(0); PG8_MMA(0, 1, At, B1); PG8_BAR;
            PG8_LDA(At, 1, 1); PG8_STAGE(PG8_SA(1, 0), a3, voffA);
            PG8_BAR; PG8_WAIT_L(0); PG8_MMA(1, 0, At, B0); PG8_BAR; PG8_SCHED;
            PG8_STAGE(PG8_SB(1, 1), b3 + hstep, voffB);
            PG8_WAIT_V(6); PG8_BAR; PG8_MMA(1, 1, At, B1); PG8_BAR;
            }
        }
        if constexpr (ALIGN_EPI) { if (wr == 0) PG8_BAR; }
        if constexpr (!Epi::AFTER_DRAIN) { E(acc, cur, wr, wc, fr, fq); S.done(cur); }
        if (!has_next) break;
#pragma unroll
        for (int a = 0; a < 2; ++a)
#pragma unroll
            for (int b = 0; b < 2; ++b)
#pragma unroll
                for (int m = 0; m < 4; ++m)
#pragma unroll
                    for (int n = 0; n < 2; ++n) acc[a][b][m][n] = (f32x4){0.f, 0.f, 0.f, 0.f};
        cur = nxt; cA = nA; cB = nB; ++ui;
        if constexpr (ALIGN_EPI) { if (wr == 1) PG8_BAR; }
    }
    PG8_WAIT_V(0);
    if constexpr (!ALIGN_EPI) { if (wr == 0) PG8_BAR; }
    PG8_BAR;
    if constexpr (Epi::AFTER_DRAIN) { E.fused(acc, cur, wr, wc, fr, fq, lds, wid, lane); S.done(cur); }
#undef PG8_SA
#undef PG8_SB
#undef PG8_STAGE
#undef PG8_LDA
#undef PG8_LDB
#undef PG8_MMA
#undef PG8_WAIT_V
#undef PG8_WAIT_L
#undef PG8_BAR
#undef PG8_SCHED
}
}
namespace att {
using bf16x8 = __attribute__((ext_vector_type(8))) short;
using s16x4  = __attribute__((ext_vector_type(4))) short;
using f32x16 = __attribute__((ext_vector_type(16))) float;
using u32x4  = __attribute__((ext_vector_type(4))) unsigned;
constexpr int NW = 8, QBLK = 32, KVBLK = 64;
constexpr float SCALE = 0.07216878364870322f;
constexpr float THR = 8.f;
constexpr int LDQ = 1536, LDK = 2048, LDR = 64, LDO = 1024;
constexpr size_t SHM_V = KVBLK * 128 * 2, SHM_K = KVBLK * 128 * 2, SHM_R = KVBLK * 64 * 2, SHM_QR = NW * 4096, SHM_ATTN = 2 * SHM_V + 2 * SHM_K + 2 * SHM_R + NW * 64 * 4 + SHM_QR;
#define KSWZ(row, colB) ((row) * 256 + ((colB) ^ (((row) & 7) << 4)))
#define RSWZ(row, colB) ((row) * 128 + ((colB) ^ (((row) & 7) << 4)))
#define SBAR() __builtin_amdgcn_sched_barrier(0)
__device__ __forceinline__ int crow(int r, int hi) { return (r & 3) + 8 * (r >> 2) + 4 * hi; }
__device__ __forceinline__ unsigned cvtpk(float lo, float hi) { return pg8::cvt_pk_bf16(lo, hi); }
__device__ __forceinline__ bf16x8 ld8(const unsigned short* p) { return *reinterpret_cast<const bf16x8*>(p); }
__device__ __forceinline__ unsigned bfr(float f) { return pg8::cvt_pk_bf16(f, 0.f) & 0xffffu; }
__device__ __forceinline__ unsigned bfpk(float lo, float hi) { return pg8::cvt_pk_bf16(lo, hi); }

__device__ __forceinline__ void partialSM(f32x16& p0, f32x16& p1, float& m_reg, float& mn, float& alpha) {
  constexpr float C = SCALE * 1.4426950408889634f;
  float pmax = p0[0];
#pragma unroll
  for (int r = 1; r < 16; ++r) pmax = fmaxf(pmax, p0[r]);
#pragma unroll
  for (int r = 0; r < 16; ++r) pmax = fmaxf(pmax, p1[r]);
  { auto rr = __builtin_amdgcn_permlane32_swap(__float_as_uint(pmax), __float_as_uint(pmax), false, false);
    pmax = fmaxf(__uint_as_float(rr[0]), __uint_as_float(rr[1])); }
  if (__builtin_expect(__all(pmax - m_reg <= THR / SCALE), 1)) { mn = m_reg; alpha = 1.f; }
  else { mn = fmaxf(m_reg, pmax); alpha = __builtin_amdgcn_exp2f((m_reg - mn) * C); m_reg = mn; }
  float mnC = -mn * C;
#pragma unroll
  for (int r = 0; r < 16; ++r) p0[r] = fmaf(p0[r], C, mnC);
#pragma unroll
  for (int r = 0; r < 16; ++r) p1[r] = fmaf(p1[r], C, mnC);
#pragma unroll
  for (int r = 0; r < 16; ++r) p0[r] = __builtin_amdgcn_exp2f(p0[r]);
}
__device__ __forceinline__ void finishSM(f32x16& p0, f32x16& p1, float alpha, float& l_reg, bf16x8& pa0, bf16x8& pa1, bf16x8& pa2, bf16x8& pa3) {
#pragma unroll
  for (int r = 0; r < 16; ++r) p1[r] = __builtin_amdgcn_exp2f(p1[r]);
  float ps = 0;
#pragma unroll
  for (int r = 0; r < 16; ++r) ps += p0[r];
#pragma unroll
  for (int r = 0; r < 16; ++r) ps += p1[r];
  { auto rr = __builtin_amdgcn_permlane32_swap(__float_as_uint(ps), __float_as_uint(ps), false, false);
    ps = __uint_as_float(rr[0]) + __uint_as_float(rr[1]); }
  l_reg = l_reg * alpha + ps;
#define PK4(P, BASE, OUT) do { unsigned a0 = cvtpk(P[BASE + 0], P[BASE + 1]), a1 = cvtpk(P[BASE + 2], P[BASE + 3]);   \
    unsigned b0 = cvtpk(P[BASE + 4], P[BASE + 5]), b1 = cvtpk(P[BASE + 6], P[BASE + 7]);                              \
    auto r0 = __builtin_amdgcn_permlane32_swap(a0, b0, false, false); auto r1 = __builtin_amdgcn_permlane32_swap(a1, b1, false, false); \
    u32x4 w = {r0[0], r1[0], r0[1], r1[1]}; OUT = *reinterpret_cast<bf16x8*>(&w); } while (0)
  PK4(p0, 0, pa0); PK4(p0, 8, pa1); PK4(p1, 0, pa2); PK4(p1, 8, pa3);
#undef PK4
}
__device__ __forceinline__ void qkt(f32x16& p0, f32x16& p1, const char* Ks, const char* Rs, const bf16x8* qr, const char* qrl, int r32, int hi) {
  p0 = f32x16{}; p1 = f32x16{};
#pragma unroll
  for (int d0 = 0; d0 < 8; ++d0) { int cb = (d0 * 16 + hi * 8) * 2;
    bf16x8 b0 = *reinterpret_cast<const bf16x8*>(Ks + KSWZ(r32, cb));
    bf16x8 b1 = *reinterpret_cast<const bf16x8*>(Ks + KSWZ(32 + r32, cb));
    p0 = __builtin_amdgcn_mfma_f32_32x32x16_bf16(b0, qr[d0], p0, 0, 0, 0);
    p1 = __builtin_amdgcn_mfma_f32_32x32x16_bf16(b1, qr[d0], p1, 0, 0, 0); }
#pragma unroll
  for (int d0 = 0; d0 < 4; ++d0) { int cb = (d0 * 16 + hi * 8) * 2;
    bf16x8 b0 = *reinterpret_cast<const bf16x8*>(Rs + RSWZ(r32, cb));
    bf16x8 b1 = *reinterpret_cast<const bf16x8*>(Rs + RSWZ(32 + r32, cb));
    const bf16x8 qv = *reinterpret_cast<const bf16x8*>(qrl + d0 * 1024);
    p0 = __builtin_amdgcn_mfma_f32_32x32x16_bf16(b0, qv, p0, 0, 0, 0);
    p1 = __builtin_amdgcn_mfma_f32_32x32x16_bf16(b1, qv, p1, 0, 0, 0); }
}
__device__ __forceinline__ int v_st(int k, int c) { const int kk = (k & ~0xC) | ((k & 4) << 1) | ((k & 8) >> 1); return ((kk >> 3) * 4 + (c >> 5)) * 512 + ((kk & 7) * 32 + (c & 31)) * 2; }
__device__ __forceinline__ int v_rd_base(int lane) { return ((lane & 3) << 3) | (((lane >> 2) & 3) << 6) | (((lane >> 4) & 1) << 5) | (((lane >> 5) & 1) << 8); }
constexpr int v_rd_off(int d0, int ks, int half) { return d0 * 512 + ks * 4096 + half * 2048; }
template <int OFF> __device__ __forceinline__ s16x4 tr_read(int vb) {
  s16x4 r; asm volatile("ds_read_b64_tr_b16 %0, %1 offset:%2" : "=&v"(r) : "v"(vb), "i"(OFF) : "memory"); return r;
}
template <int D0> __device__ __forceinline__ void pv_one(f32x16& od, int vb, bf16x8 pa0, bf16x8 pa1, bf16x8 pa2, bf16x8 pa3) {
  const s16x4 l0 = tr_read<v_rd_off(D0, 0, 0)>(vb), h0 = tr_read<v_rd_off(D0, 0, 1)>(vb), l1 = tr_read<v_rd_off(D0, 1, 0)>(vb), h1 = tr_read<v_rd_off(D0, 1, 1)>(vb);
  const s16x4 l2 = tr_read<v_rd_off(D0, 2, 0)>(vb), h2 = tr_read<v_rd_off(D0, 2, 1)>(vb), l3 = tr_read<v_rd_off(D0, 3, 0)>(vb), h3 = tr_read<v_rd_off(D0, 3, 1)>(vb);
  asm volatile("s_waitcnt lgkmcnt(0)" ::: "memory"); SBAR();
#define PK(L, H) (bf16x8){L[0], L[1], L[2], L[3], H[0], H[1], H[2], H[3]}
  od = __builtin_amdgcn_mfma_f32_32x32x16_bf16(pa0, PK(l0, h0), od, 0, 0, 0);
  od = __builtin_amdgcn_mfma_f32_32x32x16_bf16(pa1, PK(l1, h1), od, 0, 0, 0);
  od = __builtin_amdgcn_mfma_f32_32x32x16_bf16(pa2, PK(l2, h2), od, 0, 0, 0);
  od = __builtin_amdgcn_mfma_f32_32x32x16_bf16(pa3, PK(l3, h3), od, 0, 0, 0);
#undef PK
}
__device__ __forceinline__ void pv_d0(f32x16* o, int vb, bf16x8 pa0, bf16x8 pa1, bf16x8 pa2, bf16x8 pa3) {
  pv_one<0>(o[0], vb, pa0, pa1, pa2, pa3); pv_one<1>(o[1], vb, pa0, pa1, pa2, pa3); pv_one<2>(o[2], vb, pa0, pa1, pa2, pa3); pv_one<3>(o[3], vb, pa0, pa1, pa2, pa3);
}
__device__ __forceinline__ void attn_dense_body(const unsigned short* __restrict__ Qb, const unsigned short* __restrict__ Kh, const unsigned short* __restrict__ Vh,
                                                const unsigned short* __restrict__ Rh, unsigned short* __restrict__ Ob, int seq, char* lds) {
  const int tid = tid_opaque(), wid = tid >> 6, lane = tid & 63, r32 = lane & 31, hi = lane >> 5;
  char* V_lds = lds; char* K_lds = lds + 2 * SHM_V; char* R_lds = lds + 2 * SHM_V + 2 * SHM_K;
  float* ws = (float*)(lds + 2 * SHM_V + 2 * SHM_K + 2 * SHM_R) + wid * 64; float* li_l = ws; float* al_l = ws + 32;
  float m_reg = -1e30f, l_reg = 0; f32x16 o[4] = {}; bf16x8 qr[8]; char* qrl = lds + 2 * SHM_V + 2 * SHM_K + 2 * SHM_R + NW * 64 * 4 + wid * 4096 + lane * 16;
  const unsigned short* Qw = Qb + (long)(wid * QBLK + r32) * LDQ + hi * 8;
#pragma unroll
  for (int d0 = 0; d0 < 8; ++d0) qr[d0] = ld8(Qw + d0 * 16);
#pragma unroll
  for (int d0 = 0; d0 < 4; ++d0) *(bf16x8*)(qrl + d0 * 1024) = ld8(Qw + (8 + d0) * 16);
  const int sr = tid >> 4, sc = (tid & 15) * 8, vst0 = v_st(sr, sc), vst1 = v_st(32 + sr, sc);
  const int rr_ = tid >> 3, rc = (tid & 7) * 8;
  const int vb0 = (int)(uintptr_t)V_lds + v_rd_base(lane);
  struct { bf16x8 vs0, vs1, ks0, ks1, rs; } sr_[1];
#define SLOAD(i, k0) do { sr_[i].vs0 = ld8(&Vh[(long)((k0) + sr) * LDK + sc]); sr_[i].vs1 = ld8(&Vh[(long)((k0) + 32 + sr) * LDK + sc]); \
    sr_[i].ks0 = ld8(&Kh[(long)((k0) + sr) * LDK + sc]); sr_[i].ks1 = ld8(&Kh[(long)((k0) + 32 + sr) * LDK + sc]); sr_[i].rs = ld8(&Rh[(long)((k0) + rr_) * LDR + rc]); } while (0)
#define SWRITE(b, i) do { *(bf16x8*)(V_lds + (b) * SHM_V + vst0) = sr_[i].vs0;          \
    *(bf16x8*)(V_lds + (b) * SHM_V + vst1) = sr_[i].vs1; int kc = sc * 2;               \
    *(bf16x8*)(K_lds + (b) * SHM_K + KSWZ(sr, kc)) = sr_[i].ks0;                       \
    *(bf16x8*)(K_lds + (b) * SHM_K + KSWZ(32 + sr, kc)) = sr_[i].ks1;                  \
    *(bf16x8*)(R_lds + (b) * SHM_R + RSWZ(rr_, rc * 2)) = sr_[i].rs; } while (0)
#define SWAIT() asm volatile("s_waitcnt vmcnt(0)" ::: "memory")
#define RESC(a) do { if (__any((a) < 1.f)) { if (hi == 0) al_l[r32] = (a); asm volatile("s_waitcnt lgkmcnt(0)" ::: "memory"); \
    _Pragma("unroll") for (int d = 0; d < 4; ++d) _Pragma("unroll") for (int r = 0; r < 16; ++r) o[d][r] *= al_l[crow(r, hi)]; } } while (0)
  f32x16 pA0, pA1, pB0, pB1; float mnA, mnB, alA, alB; bf16x8 pa0, pa1, pa2, pa3; const int NT = seq / KVBLK;
  constexpr int SE = 0, SO = 0;
  SLOAD(SE, 0); asm volatile("s_waitcnt vmcnt(0)" ::: "memory"); SWRITE(0, SE); __syncthreads();
  qkt(pA0, pA1, K_lds, R_lds, qr, qrl, r32, hi); partialSM(pA0, pA1, m_reg, mnA, alA);
  SLOAD(SO, KVBLK);
  SWAIT(); SWRITE(1, SO); __syncthreads();
  for (int j = 1; j + 1 < NT; j += 2) {
    SBAR(); qkt(pB0, pB1, K_lds + SHM_K, R_lds + SHM_R, qr, qrl, r32, hi);
    finishSM(pA0, pA1, alA, l_reg, pa0, pa1, pa2, pa3); SBAR();
    SLOAD(SO, (j + 1) * KVBLK); SBAR();
    pv_d0(o, vb0, pa0, pa1, pa2, pa3); partialSM(pB0, pB1, m_reg, mnB, alB);
    __syncthreads(); SWAIT(); SWRITE(0, SE);
    RESC(alB); __syncthreads();
    SBAR(); qkt(pA0, pA1, K_lds, R_lds, qr, qrl, r32, hi);
    finishSM(pB0, pB1, alB, l_reg, pa0, pa1, pa2, pa3); SBAR();
    SLOAD(SE, (j + 2) * KVBLK); SBAR();
    pv_d0(o, vb0 + (int)SHM_V, pa0, pa1, pa2, pa3); partialSM(pA0, pA1, m_reg, mnA, alA);
    __syncthreads(); SWAIT(); SWRITE(1, SO);
    RESC(alA); __syncthreads();
  }
  SBAR(); qkt(pB0, pB1, K_lds + SHM_K, R_lds + SHM_R, qr, qrl, r32, hi);
  finishSM(pA0, pA1, alA, l_reg, pa0, pa1, pa2, pa3); SBAR();
  pv_d0(o, vb0, pa0, pa1, pa2, pa3); partialSM(pB0, pB1, m_reg, mnB, alB);
  __syncthreads(); RESC(alB);
  finishSM(pB0, pB1, alB, l_reg, pa0, pa1, pa2, pa3); SBAR();
  pv_d0(o, vb0 + (int)SHM_V, pa0, pa1, pa2, pa3);
  if (hi == 0) li_l[r32] = l_reg; asm volatile("s_waitcnt lgkmcnt(0)" ::: "memory");
  float rli[16];
#pragma unroll
  for (int r = 0; r < 16; ++r) rli[r] = __builtin_amdgcn_rcpf(li_l[crow(r, hi)]);
  unsigned short* Ow = Ob + (long)(wid * QBLK) * LDO;
#pragma unroll
  for (int r = 0; r < 16; ++r) { int orow = crow(r, hi);
#pragma unroll
    for (int d0 = 0; d0 < 4; ++d0) Ow[(long)orow * LDO + d0 * 32 + r32] = (unsigned short)(cvtpk(o[d0][r] * rli[r], 0.f) & 0xffffu); }
  __syncthreads();
#undef SLOAD
#undef SWRITE
#undef SWAIT
#undef RESC
}
__device__ __forceinline__ void hgrn_chunk_seq(const unsigned short* __restrict__ QH, const unsigned short* __restrict__ KH, const unsigned short* __restrict__ Zi, int ldz,
                                               const float* __restrict__ GM, const float* __restrict__ GL, unsigned short* __restrict__ OS, int dir, char* lds) {
  const int tid = tid_opaque(), wid = __builtin_amdgcn_readfirstlane(tid >> 6), lane = tid & 63, r32 = lane & 31, hi = lane >> 5, rb = wid & 1, vq = wid >> 1;
  char* Kimg = lds; char* KTimg = lds + 16384; char* Vimg = lds + 32768; char* Simg = lds + 49152; float* gtab = (float*)(lds + 81920);
  const int sr = tid >> 4, sc = (tid & 15) * 8;
  const int vbV = (int)(uintptr_t)Vimg + v_rd_base(lane) + vq * 512, vbS = (int)(uintptr_t)Simg + v_rd_base(lane) + vq * 512, vbK = (int)(uintptr_t)KTimg + v_rd_base(lane) + 2 * rb * 512;
  f32x16 St0 = {}, St1 = {};
#pragma unroll 1
  for (int c = 0; c < 64; ++c) {
    const int cn = dir ? 63 - c : c; const long n0 = (long)cn * 64;
    if (tid < 128) gtab[tid] = GM[cn * 1024 + tid]; else if (tid < 256) gtab[tid] = GL[cn * 1024 + tid - 128];
#pragma unroll
    for (int e = 0; e < 2; ++e) { const int t = sr + 32 * e; const long n = n0 + (dir ? 63 - t : t);
      const bf16x8 k8 = ld8(KH + n * 1024 + sc), v8 = ld8(Zi + n * ldz + sc);
      *(bf16x8*)(Kimg + KSWZ(t, sc * 2)) = k8; *(bf16x8*)(KTimg + v_st(t, sc)) = k8; *(bf16x8*)(Vimg + v_st(t, sc)) = v8; }
    bf16x8 qr[8];
    { const int t = 32 * rb + r32; const long n = n0 + (dir ? 63 - t : t);
#pragma unroll
      for (int d0 = 0; d0 < 8; ++d0) qr[d0] = ld8(QH + n * 1024 + d0 * 16 + hi * 8); }
    __syncthreads();
#pragma unroll
    for (int r = 0; r < 16; ++r) { const int k0 = 64 * rb + crow(r, hi), k1 = k0 + 32;
      St0[r] *= gtab[k0]; St1[r] *= gtab[k1];
      *(unsigned short*)(Simg + rb * 16384 + v_st(k0 & 63, 32 * vq + r32)) = (unsigned short)bfr(St0[r]);
      *(unsigned short*)(Simg + rb * 16384 + v_st(k1 & 63, 32 * vq + r32)) = (unsigned short)bfr(St1[r]); }
    __syncthreads();
    f32x16 p0 = {}, p1 = {};
#pragma unroll
    for (int d0 = 0; d0 < 8; ++d0) { const int cb = (d0 * 16 + hi * 8) * 2;
      const bf16x8 b0 = *reinterpret_cast<const bf16x8*>(Kimg + KSWZ(r32, cb));
      p0 = __builtin_amdgcn_mfma_f32_32x32x16_bf16(b0, qr[d0], p0, 0, 0, 0);
      if (rb) { const bf16x8 b1 = *reinterpret_cast<const bf16x8*>(Kimg + KSWZ(32 + r32, cb)); p1 = __builtin_amdgcn_mfma_f32_32x32x16_bf16(b1, qr[d0], p1, 0, 0, 0); } }
#pragma unroll
    for (int r = 0; r < 16; ++r) { const bool keep = crow(r, hi) <= r32; if (rb) p1[r] = keep ? p1[r] : 0.f; else p0[r] = keep ? p0[r] : 0.f; }
    bf16x8 pa0, pa1, pa2, pa3;
#define PK4(P, BASE, OUT) do { unsigned a0 = bfpk(P[BASE + 0], P[BASE + 1]), a1 = bfpk(P[BASE + 2], P[BASE + 3]);   \
    unsigned b0 = bfpk(P[BASE + 4], P[BASE + 5]), b1 = bfpk(P[BASE + 6], P[BASE + 7]);                              \
    auto r0 = __builtin_amdgcn_permlane32_swap(a0, b0, false, false); auto r1 = __builtin_amdgcn_permlane32_swap(a1, b1, false, false); \
    u32x4 w = {r0[0], r1[0], r0[1], r1[1]}; OUT = *reinterpret_cast<bf16x8*>(&w); } while (0)
    PK4(p0, 0, pa0); PK4(p0, 8, pa1); PK4(p1, 0, pa2); PK4(p1, 8, pa3);
#undef PK4
    f32x16 o = {};
    pv_one<0>(o, vbV, pa0, pa1, pa2, pa3);
    pv_one<0>(o, vbS, qr[0], qr[1], qr[2], qr[3]);
    pv_one<0>(o, vbS + 16384, qr[4], qr[5], qr[6], qr[7]);
#pragma unroll
    for (int r = 0; r < 16; ++r) { const int t = 32 * rb + crow(r, hi); const long n = n0 + (dir ? 63 - t : t);
      OS[n * 1024 + 32 * vq + r32] = (unsigned short)bfr(o[r]); }
#define PKF(L, H) (bf16x8){L[0], L[1], L[2], L[3], H[0], H[1], H[2], H[3]}
    { const s16x4 vl0 = tr_read<v_rd_off(0, 0, 0)>(vbV), vh0 = tr_read<v_rd_off(0, 0, 1)>(vbV), vl1 = tr_read<v_rd_off(0, 1, 0)>(vbV), vh1 = tr_read<v_rd_off(0, 1, 1)>(vbV);
      const s16x4 vl2 = tr_read<v_rd_off(0, 2, 0)>(vbV), vh2 = tr_read<v_rd_off(0, 2, 1)>(vbV), vl3 = tr_read<v_rd_off(0, 3, 0)>(vbV), vh3 = tr_read<v_rd_off(0, 3, 1)>(vbV);
      const s16x4 al0 = tr_read<v_rd_off(0, 0, 0)>(vbK), ah0 = tr_read<v_rd_off(0, 0, 1)>(vbK), al1 = tr_read<v_rd_off(0, 1, 0)>(vbK), ah1 = tr_read<v_rd_off(0, 1, 1)>(vbK);
      const s16x4 al2 = tr_read<v_rd_off(0, 2, 0)>(vbK), ah2 = tr_read<v_rd_off(0, 2, 1)>(vbK), al3 = tr_read<v_rd_off(0, 3, 0)>(vbK), ah3 = tr_read<v_rd_off(0, 3, 1)>(vbK);
      const s16x4 bl0 = tr_read<v_rd_off(1, 0, 0)>(vbK), bh0 = tr_read<v_rd_off(1, 0, 1)>(vbK), bl1 = tr_read<v_rd_off(1, 1, 0)>(vbK), bh1 = tr_read<v_rd_off(1, 1, 1)>(vbK);
      const s16x4 bl2 = tr_read<v_rd_off(1, 2, 0)>(vbK), bh2 = tr_read<v_rd_off(1, 2, 1)>(vbK), bl3 = tr_read<v_rd_off(1, 3, 0)>(vbK), bh3 = tr_read<v_rd_off(1, 3, 1)>(vbK);
      asm volatile("s_waitcnt lgkmcnt(0)" ::: "memory"); SBAR();
      St0 = __builtin_amdgcn_mfma_f32_32x32x16_bf16(PKF(al0, ah0), PKF(vl0, vh0), St0, 0, 0, 0); St0 = __builtin_amdgcn_mfma_f32_32x32x16_bf16(PKF(al1, ah1), PKF(vl1, vh1), St0, 0, 0, 0);
      St0 = __builtin_amdgcn_mfma_f32_32x32x16_bf16(PKF(al2, ah2), PKF(vl2, vh2), St0, 0, 0, 0); St0 = __builtin_amdgcn_mfma_f32_32x32x16_bf16(PKF(al3, ah3), PKF(vl3, vh3), St0, 0, 0, 0);
      St1 = __builtin_amdgcn_mfma_f32_32x32x16_bf16(PKF(bl0, bh0), PKF(vl0, vh0), St1, 0, 0, 0); St1 = __builtin_amdgcn_mfma_f32_32x32x16_bf16(PKF(bl1, bh1), PKF(vl1, vh1), St1, 0, 0, 0);
      St1 = __builtin_amdgcn_mfma_f32_32x32x16_bf16(PKF(bl2, bh2), PKF(vl2, vh2), St1, 0, 0, 0); St1 = __builtin_amdgcn_mfma_f32_32x32x16_bf16(PKF(bl3, bh3), PKF(vl3, vh3), St1, 0, 0, 0); }
#undef PKF
#pragma unroll
    for (int r = 0; r < 16; ++r) { const int k0 = 64 * rb + crow(r, hi); St0[r] *= gtab[128 + k0]; St1[r] *= gtab[128 + k0 + 32]; }
    __syncthreads();
  }
}
}

constexpr int NWAVES = 8;
#define GAS __attribute__((address_space(1)))
#define LAS __attribute__((address_space(3)))
#define CAS __attribute__((address_space(4)))
typedef unsigned short bf16;
typedef unsigned v4u __attribute__((ext_vector_type(4)));
typedef unsigned v2u __attribute__((ext_vector_type(2)));
typedef float f32x4 __attribute__((ext_vector_type(4)));
typedef float f32x2 __attribute__((ext_vector_type(2)));
typedef float f32x16 __attribute__((ext_vector_type(16)));
typedef GAS unsigned gu32;
#define RLX_AGENT __ATOMIC_RELAXED, __HIP_MEMORY_SCOPE_AGENT
#define LDS_WAIT() asm volatile("s_waitcnt lgkmcnt(0)" ::: "memory")
#define VM_WAIT() asm volatile("s_waitcnt vmcnt(0)" ::: "memory")
constexpr int RING_BYTES = 131072, MISC_OFF = RING_BYTES + 320, LDS_BYTES = 147456;

__device__ __forceinline__ float bf2f(unsigned short b) { return __uint_as_float(((unsigned)b) << 16); }
__device__ __forceinline__ unsigned f2bf(float f) { unsigned u = __float_as_uint(f); return (u + 0x7fffu + ((u >> 16) & 1u)) >> 16; }
__device__ __forceinline__ unsigned pk2(float lo, float hi) { return pg8::cvt_pk_bf16(lo, hi); }
__device__ __forceinline__ float sigmf(float x) { return __builtin_amdgcn_rcpf(1.0f + __expf(-x)); }
__device__ __forceinline__ float wave_sum(float v) {
#pragma unroll
    for (int o = 1; o < 64; o <<= 1) v += __shfl_xor(v, o);
    return v;
}
__device__ __forceinline__ void ld16bf(const bf16* p, float (&f)[16]) {
    const v4u a = *(const v4u*)p, b = *(const v4u*)(p + 8);
    const unsigned w[8] = {a.x, a.y, a.z, a.w, b.x, b.y, b.z, b.w};
#pragma unroll
    for (int i = 0; i < 8; ++i) { f[2 * i] = __uint_as_float(w[i] << 16); f[2 * i + 1] = __uint_as_float(w[i] & 0xffff0000u); }
}
__device__ __forceinline__ void ld8bf(const bf16* p, float (&f)[8]) {
    const v4u a = *(const v4u*)p; const unsigned w[4] = {a.x, a.y, a.z, a.w};
#pragma unroll
    for (int i = 0; i < 4; ++i) { f[2 * i] = __uint_as_float(w[i] << 16); f[2 * i + 1] = __uint_as_float(w[i] & 0xffff0000u); }
}
__device__ __forceinline__ void ld16f(const float* p, float (&f)[16]) {
#pragma unroll
    for (int i = 0; i < 4; ++i) { const f32x4 v = *(const f32x4*)(p + 4 * i); f[4 * i] = v[0]; f[4 * i + 1] = v[1]; f[4 * i + 2] = v[2]; f[4 * i + 3] = v[3]; }
}
__device__ __forceinline__ void st16f(float* p, const float (&f)[16]) {
#pragma unroll
    for (int i = 0; i < 4; ++i) *(f32x4*)(p + 4 * i) = (f32x4){f[4 * i], f[4 * i + 1], f[4 * i + 2], f[4 * i + 3]};
}
__device__ __forceinline__ void st16bf(bf16* p, const float (&f)[16]) {
    v4u a, b; a.x = pk2(f[0], f[1]); a.y = pk2(f[2], f[3]); a.z = pk2(f[4], f[5]); a.w = pk2(f[6], f[7]);
    b.x = pk2(f[8], f[9]); b.y = pk2(f[10], f[11]); b.z = pk2(f[12], f[13]); b.w = pk2(f[14], f[15]);
    *(v4u*)p = a; *(v4u*)(p + 8) = b;
}
__device__ __forceinline__ void st8bf(bf16* p, const float (&f)[8]) {
    v4u a; a.x = pk2(f[0], f[1]); a.y = pk2(f[2], f[3]); a.z = pk2(f[4], f[5]); a.w = pk2(f[6], f[7]); *(v4u*)p = a;
}

#define XB_TMO      128
#define XB_XCNT(j)  (256  + 64 * (j))
#define XB_XSUB(j)  (1280 + 64 * (j))
#define XB_XGEN(j)  (2304 + 64 * (j))
#define XB_TOP      3328
#define XB_TOPGEN   3392
#define XCD_BAR_WORDS 3456
#define XB_SPIN_CAP (1u << 18)

__device__ __forceinline__ unsigned xb_ld(unsigned* p)              { return __hip_atomic_load(p, __ATOMIC_RELAXED, __HIP_MEMORY_SCOPE_AGENT); }
__device__ __forceinline__ unsigned xb_add(unsigned* p, unsigned v) { return __hip_atomic_fetch_add(p, v, __ATOMIC_RELAXED, __HIP_MEMORY_SCOPE_AGENT); }
__device__ __forceinline__ unsigned xb_xcc_id() { return (unsigned)__builtin_amdgcn_s_getreg((3 << 11) | 20) & 0xFu; }
#define XB_SPIN(cond, bar) do { unsigned _sp = 0; while (cond) { __builtin_amdgcn_s_sleep(1); \
    if ((++_sp & 255u) == 0u) { if (xb_ld(&(bar)[XB_TMO])) break; if (_sp > XB_SPIN_CAP) { atomicAdd(&(bar)[XB_TMO], 1u); break; } } } } while (0)

struct XcdBarrier {
    unsigned* bar; unsigned x;
    volatile LAS unsigned* st;
};

__device__ __forceinline__ XcdBarrier xcd_barrier_post(unsigned* bar, volatile LAS unsigned* st) {
    XcdBarrier b; b.bar = bar; b.x = xb_xcc_id(); b.st = st;
    if (threadIdx.x == 0) (void)xb_add(&bar[XB_XCNT(b.x)], 1u);
    return b;
}
__device__ __forceinline__ void xcd_barrier_complete(unsigned* bar, unsigned x, unsigned& nloc, unsigned& nx) {
    const unsigned G = gridDim.x * gridDim.y * gridDim.z;
    unsigned sum, cnt, mine, sp = 0u;
    for (;;) {
        sum = 0u; cnt = 0u; mine = 0u;
#pragma unroll
        for (unsigned j = 0; j < 16; ++j) { const unsigned c = xb_ld(&bar[XB_XCNT(j)]); sum += c; cnt += (c > 0u) ? 1u : 0u; mine = (j == x) ? c : mine; }
        if (sum == G) break;
        __builtin_amdgcn_s_sleep(1);
        if ((++sp & 255u) == 0u) { if (xb_ld(&bar[XB_TMO])) break; if (sp > XB_SPIN_CAP) { atomicAdd(&bar[XB_TMO], 1u); break; } }
    }
    nloc = mine > 0u ? mine : 1u; nx = cnt > 0u ? cnt : 1u;
}

__device__ __forceinline__ void xcd_barrier(const XcdBarrier& b) {
    asm volatile("s_waitcnt vmcnt(0)" ::: "memory");
    __syncthreads();
    if (threadIdx.x == 0) {
        unsigned* bar = b.bar;
        __builtin_amdgcn_s_waitcnt(0);
        unsigned nloc = b.st[0], nx = b.st[1];
        if (nloc == 0u) { xcd_barrier_complete(bar, b.x, nloc, nx); b.st[0] = nloc; b.st[1] = nx; }
        const unsigned old = xb_add(&bar[XB_XSUB(b.x)], 1u);
        const unsigned gen = old / nloc;
        if (old + 1u == (gen + 1u) * nloc) {
            __builtin_amdgcn_fence(__ATOMIC_RELEASE, "agent");
            asm volatile("s_waitcnt vmcnt(0)" ::: "memory");
            const unsigned og = xb_add(&bar[XB_TOP], 1u);
            const unsigned tg = og / nx;
            if (og + 1u == (tg + 1u) * nx) xb_add(&bar[XB_TOPGEN], 1u);
            else XB_SPIN(xb_ld(&bar[XB_TOPGEN]) == tg, bar);
            __builtin_amdgcn_fence(__ATOMIC_ACQUIRE, "agent");
            xb_add(&bar[XB_XGEN(b.x)], 1u);
            asm volatile("s_waitcnt vmcnt(0)" ::: "memory");
        } else {
            XB_SPIN(xb_ld(&bar[XB_XGEN(b.x)]) == gen, bar);
            __builtin_amdgcn_fence(__ATOMIC_ACQUIRE, "agent");
            asm volatile("s_waitcnt vmcnt(0)" ::: "memory");
        }
    }
    __syncthreads();
}

__device__ __forceinline__ int uq_perm(int n) { const int h = n / 192, j = n % 192; if (j < 128) return n; const int jj = j - 128; return h * 192 + 128 + 2 * (jj & 31) + (jj >> 5); }
struct TrItem { const float* W; bf16* WT; int ldn, k0, kvalid, n0, ldk, kd0, drow0, perm; };
__device__ __forceinline__ void tr_load(const TrItem& T, float (&v)[32], int lane) {
#pragma unroll
    for (int i = 0; i < 32; ++i) { const int kk = 2 * i + (lane >> 5); v[i] = kk < T.kvalid ? __builtin_nontemporal_load(&T.W[(size_t)(T.k0 + kk) * T.ldn + T.n0 + (lane & 31)]) : 0.f; }
}
__device__ __forceinline__ void tr_store(const TrItem& T, const float (&v)[32], LAS float* scr, int lane) {
#pragma unroll
    for (int i = 0; i < 32; ++i) scr[(2 * i + (lane >> 5)) * 33 + (lane & 31)] = v[i];
    LDS_WAIT(); asm volatile("" ::: "memory");
    const int c = lane & 7;
#pragma unroll
    for (int j = 0; j < 4; ++j) { const int n = (lane >> 3) + 8 * j; const LAS float* s = scr + (8 * c) * 33 + n;
        v4u o; o.x = pk2(s[0 * 33], s[1 * 33]); o.y = pk2(s[2 * 33], s[3 * 33]); o.z = pk2(s[4 * 33], s[5 * 33]); o.w = pk2(s[6 * 33], s[7 * 33]);
        const int drow = T.perm ? uq_perm(T.n0 + n) : T.drow0 + n;
        *(GAS v4u*)(T.WT + (size_t)drow * T.ldk + T.kd0 + 8 * c) = o; }
    LDS_WAIT(); asm volatile("" ::: "memory");
}
struct LayerW { const float *w_in, *w2, *a2, *g2, *uq, *ukv, *br, *wo, *w1, *w2m, *wpe, *wpg; };
__device__ __forceinline__ TrItem tr_which(const LayerW& L, unsigned char* ws, int it) {
    bf16* WIN = (bf16*)(ws + WS_WIN); bf16* LORA = (bf16*)(ws + WS_LORA); bf16* UQ = (bf16*)(ws + WS_UQ); bf16* UKV = (bf16*)(ws + WS_UKV); bf16* BR = (bf16*)(ws + WS_BR);
    bf16* WO = (bf16*)(ws + WS_WO); bf16* W1 = (bf16*)(ws + WS_W1); bf16* W2 = (bf16*)(ws + WS_W2); bf16* WPE = (bf16*)(ws + WS_WPE); bf16* WPG = (bf16*)(ws + WS_WPG);
    constexpr int I_IN = 32 * 503, I_LW = 64, I_LA = 64, I_LG = 96, I_UQ = 12 * 48, I_UKV = 8 * 64, I_BR = 3 * 16 * 64, I_WO = 32 * 64, I_W1 = 32 * 256, I_W2 = 128 * 64, I_PE = 4 * 64;
    int r = it;
    if (r < I_IN) { const int kb = r / 503, n0 = (r % 503) * 32; const int drow = n0 < 3488 ? n0 : (n0 < 9952 ? n0 + 96 : n0 + 288); return TrItem{L.w_in, WIN, IN_W, kb * 64, 64, n0, 2048, kb * 64, drow, 0}; } r -= I_IN;
    if (r < I_LW) { const int d = r >> 5, n0 = (r & 31) * 32; return TrItem{L.w2 + d * 65536, LORA, 1024, 0, 64, n0, 256, 64 * d, d * 1024 + n0, 0}; } r -= I_LW;
    if (r < I_LA) { const int d = r >> 5, n0 = (r & 31) * 32; return TrItem{L.a2 + d * 65536, LORA, 1024, 0, 64, n0, 256, 128 + 64 * d, 2048 + d * 1024 + n0, 0}; } r -= I_LA;
    if (r < I_LG) { const int kb = r >> 5, n0 = (r & 31) * 32; return TrItem{L.g2, LORA + (size_t)4096 * 256, 1024, kb * 64, 160 - kb * 64, n0, 256, 64 * kb, n0, 0}; } r -= I_LG;
    if (r < I_UQ) { const int kb = r / 48, n0 = (r % 48) * 32; return TrItem{L.uq, UQ, 1536, kb * 64, 64, n0, 768, kb * 64, 0, 1}; } r -= I_UQ;
    if (r < I_UKV) { const int kb = r >> 6, n0 = (r & 63) * 32; return TrItem{L.ukv, UKV, 2048, kb * 64, 64, n0, 512, kb * 64, n0, 0}; } r -= I_UKV;
    if (r < I_BR) { const int nb3 = r >> 10, q = r & 1023, kb = q >> 6, n0 = (q & 63) * 32; return TrItem{L.br + (size_t)nb3 * 1024 * 2048, BR + (size_t)nb3 * 2048 * 1024, 2048, kb * 64, 64, n0, 1024, kb * 64, n0, 0}; } r -= I_BR;
    if (r < I_WO) { const int kb = r >> 6, n0 = (r & 63) * 32; return TrItem{L.wo, WO, 2048, kb * 64, 64, n0, 2048, kb * 64, n0, 0}; } r -= I_WO;
    if (r < I_W1) { const int kb = r >> 8, n0 = (r & 255) * 32; return TrItem{L.w1, W1, 8192, kb * 64, 64, n0, 2048, kb * 64, n0, 0}; } r -= I_W1;
    if (r < I_W2) { const int kb = r >> 6, n0 = (r & 63) * 32; return TrItem{L.w2m, W2, 2048, kb * 64, 64, n0, 8192, kb * 64, n0, 0}; } r -= I_W2;
    if (r < I_PE) { const int kb = r >> 6, n0 = (r & 63) * 32; return TrItem{L.wpe, WPE, 2048, kb * 64, 64, n0, 256, kb * 64, n0, 0}; } r -= I_PE;
    { const int kb = r >> 6, n0 = (r & 63) * 32; return TrItem{L.wpg, WPG, 2048, kb * 64, 64, n0, 2048, kb * 64, n0, 0}; }
}
constexpr int TR_EARLY = 32 * 503 + 64 + 64 + 96 + 12 * 48 + 8 * 64;
static_assert(TR_EARLY % 8 == 0, "the phase-4 filler hands out chunks of 8 items");
__device__ __forceinline__ void convert_weights(const LayerW& L, unsigned char* ws, LAS float* scr, int gw, int NGW, int lane, int first) {
    constexpr int NITEMS = 32 * 503 + 64 + 64 + 96 + 12 * 48 + 8 * 64 + 3 * 16 * 64 + 32 * 64 + 32 * 256 + 128 * 64 + 4 * 64 + 32 * 64;
    if (first + gw >= NITEMS) return;
    TrItem cur = tr_which(L, ws, first + gw); float v[32]; tr_load(cur, v, lane);
#pragma unroll 1
    for (int it = first + gw; it < NITEMS; it += NGW) {
        const int nx = it + NGW; TrItem nxt = cur; float w[32];
        if (nx < NITEMS) { nxt = tr_which(L, ws, nx); tr_load(nxt, w, lane); }
        tr_store(cur, v, scr, lane);
        if (nx < NITEMS) {
#pragma unroll
            for (int i = 0; i < 32; ++i) v[i] = w[i]; }
        cur = nxt;
    }
}
template <bool OUT32> __device__ __forceinline__ void rms_row(const float* xrow, const float* g, void* orow, int lane) {
    const f32x4* xr = (const f32x4*)xrow + lane; f32x4 v[8]; float s = 0.f;
#pragma unroll
    for (int j = 0; j < 8; ++j) { v[j] = xr[64 * j]; s += (v[j][0] * v[j][0] + v[j][1] * v[j][1]) + (v[j][2] * v[j][2] + v[j][3] * v[j][3]); }
    const float rstd = __builtin_amdgcn_rsqf(wave_sum(s) * (1.0f / 2048.0f) + 1e-6f);
#pragma unroll
    for (int j = 0; j < 8; ++j) { const f32x4 gv = ((const f32x4*)g)[64 * j + lane]; const f32x4 o = v[j] * rstd * gv;
        if (OUT32) ((f32x4*)orow)[64 * j + lane] = o; else { v2u w; w.x = pk2(o[0], o[1]); w.y = pk2(o[2], o[3]); ((v2u*)orow)[64 * j + lane] = w; } }
}
template <int NCH> __device__ __forceinline__ void shiftN(const bf16* Z, size_t m, bool hp, bool hn, int c, const float* mu, float (&u)[NCH]) {
    float z[NCH], zp[NCH], zn[NCH];
    if constexpr (NCH == 16) { ld16bf(Z + m * ZW + c, z); if (hp) ld16bf(Z + (m - 1) * ZW + c, zp); if (hn) ld16bf(Z + (m + 1) * ZW + c, zn); }
    else { ld8bf(Z + m * ZW + c, z); if (hp) ld8bf(Z + (m - 1) * ZW + c, zp); if (hn) ld8bf(Z + (m + 1) * ZW + c, zn); }
#pragma unroll
    for (int i = 0; i < NCH; i += 4) { const f32x4 m0 = *(const f32x4*)(mu + c + i), m1 = *(const f32x4*)(mu + RWKV_W + c + i);
#pragma unroll
        for (int j = 0; j < 4; ++j) { const float zz = z[i + j], p = hp ? zp[i + j] : 0.f, n = hn ? zn[i + j] : 0.f; u[i + j] = zz + m0[j] * (p - zz) + m1[j] * (n - zz); } }
}
struct PreP { const float *mu, *kk, *lb, *qg, *kvg, *COS, *SIN; };
__device__ __forceinline__ void unpk8(const v4u a, float (&f)[8]) { const unsigned w[4] = {a.x, a.y, a.z, a.w};
#pragma unroll
    for (int i = 0; i < 4; ++i) { f[2 * i] = __uint_as_float(w[i] << 16); f[2 * i + 1] = __uint_as_float(w[i] & 0xffff0000u); } }
__device__ __forceinline__ void pre_run_rwkv(size_t m0, const PreP& P, unsigned char* ws, int lane) {
    const bf16* Z = (const bf16*)(ws + WS_Z);
    const int s0 = (int)(m0 & (SEQ - 1)); const bool hp = s0 > 0, hn = s0 + 4 < SEQ;
    unsigned z_ = 0u; asm volatile("" : "+v"(z_)); const v4u zero4 = {z_, z_, z_, z_};
    v4u ra[6], rb[6];
#pragma unroll
    for (int i = 0; i < 6; ++i) { const bool ok = i == 0 ? hp : (i == 5 ? hn : true); const bf16* p = Z + (m0 + i - 1) * ZW + 16 * lane; ra[i] = ok ? *(const v4u*)p : zero4; rb[i] = ok ? *(const v4u*)(p + 8) : zero4; }
#pragma unroll
    for (int sec = 0; sec < 3; ++sec) {
        const int c = sec * 1024 + 16 * lane;
        v4u na[6], nb[6];
#pragma unroll
        for (int i = 0; i < 6; ++i) { const bool ok = i == 0 ? hp : (i == 5 ? hn : true);
            if (sec < 2) { const bf16* p = Z + (m0 + i - 1) * ZW + c + 1024; na[i] = ok ? *(const v4u*)p : zero4; nb[i] = ok ? *(const v4u*)(p + 8) : zero4; }
            else { na[i] = (ok && lane < 52) ? *(const v4u*)(Z + (m0 + i - 1) * ZW + 3072 + 8 * lane) : zero4; nb[i] = zero4; } }
        float m0v[16], m1v[16]; ld16f(P.mu + c, m0v); ld16f(P.mu + RWKV_W + c, m1v);
        float kkv[16]; if (sec == 1) ld16f(P.kk + 16 * lane, kkv);
#pragma unroll
        for (int t = 0; t < 4; ++t) { float zp[16], zz[16], zn[16], u[16];
            { float h0[8], h1[8]; unpk8(ra[t], h0); unpk8(rb[t], h1);
#pragma unroll
              for (int i = 0; i < 8; ++i) { zp[i] = h0[i]; zp[8 + i] = h1[i]; } }
            { float h0[8], h1[8]; unpk8(ra[t + 1], h0); unpk8(rb[t + 1], h1);
#pragma unroll
              for (int i = 0; i < 8; ++i) { zz[i] = h0[i]; zz[8 + i] = h1[i]; } }
            { float h0[8], h1[8]; unpk8(ra[t + 2], h0); unpk8(rb[t + 2], h1);
#pragma unroll
              for (int i = 0; i < 8; ++i) { zn[i] = h0[i]; zn[8 + i] = h1[i]; } }
#pragma unroll
            for (int i = 0; i < 16; ++i) u[i] = zz[i] + m0v[i] * (zp[i] - zz[i]) + m1v[i] * (zn[i] - zz[i]);
            const size_t o = (m0 + t) * 1024 + 16 * lane;
            if (sec == 0) st16bf((bf16*)(ws + WS_R) + o, u);
            else if (sec == 2) st16bf((bf16*)(ws + WS_V) + o, u);
            else { st16bf((bf16*)(ws + WS_KS) + o, u); float ss = 0.f;
#pragma unroll
                for (int i = 0; i < 16; ++i) { u[i] *= kkv[i]; ss += u[i] * u[i]; }
                ss += __shfl_xor(ss, 1); ss += __shfl_xor(ss, 2);
                const float inv = __builtin_amdgcn_rsqf(fmaxf(ss, 1e-24f));
                if ((lane & 3) == 0) ((float*)(ws + WS_KAP))[(m0 + t) * 16 + (lane >> 2)] = inv; } }
#pragma unroll
        for (int i = 0; i < 6; ++i) { ra[i] = na[i]; rb[i] = nb[i]; }
    }
    {
        const int c = 3072 + 8 * lane;
        if (lane < 52) {
            float m0v[8], m1v[8];
#pragma unroll
            for (int i = 0; i < 8; i += 4) { const f32x4 a = *(const f32x4*)(P.mu + c + i), b = *(const f32x4*)(P.mu + RWKV_W + c + i);
#pragma unroll
                for (int j = 0; j < 4; ++j) { m0v[i + j] = a[j]; m1v[i + j] = b[j]; } }
#pragma unroll
            for (int t = 0; t < 4; ++t) { float zp[8], zz[8], zn[8], u[8]; unpk8(ra[t], zp); unpk8(ra[t + 1], zz); unpk8(ra[t + 2], zn);
#pragma unroll
                for (int i = 0; i < 8; ++i) { u[i] = zz[i] + m0v[i] * (zp[i] - zz[i]) + m1v[i] * (zn[i] - zz[i]); if (lane < 16) { const float e_ = __builtin_amdgcn_exp2f(-2.8853900817779268f * __builtin_fabsf(u[i])), th_ = (1.0f - e_) * __builtin_amdgcn_rcpf(1.0f + e_); u[i] = u[i] < 0.f ? -th_ : th_; }     else if (lane >= 32) u[i] = sigmf(u[i]); }
                st8bf((bf16*)(ws + WS_ALORA) + (lane < 32 ? (size_t)0 : (size_t)M * 256) + (m0 + t) * 256 + 8 * (lane & 31), u); }
        } else {
#pragma unroll
            for (int t = 0; t < 4; ++t) *(v4u*)((bf16*)(ws + WS_ALORA) + (size_t)M * 256 + (m0 + t) * 256 + 8 * (lane & 31)) = zero4;
        }
    }
}
__device__ __forceinline__ void pre_token(size_t m, const PreP& P, unsigned char* ws, int lane) {
    const bf16* Z = (const bf16*)(ws + WS_Z);
    float a[8], b[8], kvv[8]; ld8bf(Z + m * ZW + ZO_C + 8 * lane, a); if (lane < 32) ld8bf(Z + m * ZW + ZO_C + 512 + 8 * lane, b); ld8bf(Z + m * ZW + ZO_C + 768 + 8 * lane, kvv);
    const float tr = bf2f(Z[m * ZW + ZO_C + 1280 + lane]); const float cc_ = P.COS[m * 32 + (lane & 31)], sn_ = P.SIN[m * 32 + (lane & 31)];
    { float ss = 0.f;
#pragma unroll
      for (int i = 0; i < 8; ++i) { ss += a[i] * a[i]; if (lane < 32) ss += b[i] * b[i]; }
      const float rstd = __builtin_amdgcn_rsqf(wave_sum(ss) * (1.0f / 768.0f) + 1e-6f);
      bf16* O = (bf16*)(ws + WS_CQN) + m * 768;
#pragma unroll
      for (int i = 0; i < 8; ++i) a[i] = a[i] * rstd * P.qg[8 * lane + i];
      st8bf(O + 8 * lane, a);
      if (lane < 32) {
#pragma unroll
          for (int i = 0; i < 8; ++i) b[i] = b[i] * rstd * P.qg[512 + 8 * lane + i];
          st8bf(O + 512 + 8 * lane, b); } }
    { float ss = 0.f;
#pragma unroll
      for (int i = 0; i < 8; ++i) ss += kvv[i] * kvv[i];
      const float rstd = __builtin_amdgcn_rsqf(wave_sum(ss) * (1.0f / 512.0f) + 1e-6f);
#pragma unroll
      for (int i = 0; i < 8; ++i) kvv[i] = kvv[i] * rstd * P.kvg[8 * lane + i];
      st8bf((bf16*)(ws + WS_CKVN) + m * 512 + 8 * lane, kvv); }
    { const float o = __shfl_xor(tr, 32); const int i = lane & 31;
      const float r = lane < 32 ? tr * cc_ - o * sn_ : tr * cc_ + o * sn_;
      ((bf16*)(ws + WS_KR))[m * 64 + 2 * i + (lane >> 5)] = (bf16)f2bf(r); }
}
__device__ __forceinline__ void hgrn_gate(float z, float lb, float ol, float& key, float& lf2) {
    const float e = __builtin_amdgcn_exp2f(-1.4426950408889634f * __builtin_fabsf(z)), s = __builtin_amdgcn_rcpf(1.0f + e), es = e * s;
    const float sp = z >= 0.f ? s : es, sn = z >= 0.f ? es : s;
    key = ol * sn; lf2 = __builtin_amdgcn_logf(fmaxf(lb + ol * sp, 1e-30f));
}
__device__ __forceinline__ void hgrn_prep(int u, const float* lbl, unsigned char* ws, int lane) {
    const bf16* Z = (const bf16*)(ws + WS_Z); const int cg = u >> 3, h = u & 7, c0 = 128 * h + 2 * lane; const size_t n0 = (size_t)cg * 64;
    const float lb0 = lbl[c0], lb1 = lbl[c0 + 1], ol0 = 1.0f - lb0, ol1 = 1.0f - lb1;
    const bf16* zq = Z + ZO_H + c0; const bf16* zf = zq + 1024; const bf16* zb = zq + 2048;
    bf16* QH = (bf16*)(ws + WS_QH) + c0; bf16* KH = (bf16*)(ws + WS_KH) + c0; constexpr size_t DS = (size_t)M * 1024; constexpr float CL = 115.41560327111707f;
    float* GM = (float*)(ws + WS_GM); float* GL = (float*)(ws + WS_GL); const size_t go = (size_t)cg * 1024 + c0, gd = (size_t)256 * 1024;
    float x00 = 0.f, x01 = 0.f, x10 = 0.f, x11 = 0.f;
#pragma unroll 1
    for (int bt = 0; bt < 4; ++bt) {
        const bool up = bt < 2; const int tb = up ? 32 + 16 * bt : 31 - 16 * (bt - 2), ts = up ? 1 : -1;
        if (bt == 2) { *(f32x2*)(GL + go) = (f32x2){__builtin_amdgcn_exp2f(x00), __builtin_amdgcn_exp2f(x01)}; *(f32x2*)(GM + gd + go) = (f32x2){__builtin_amdgcn_exp2f(x10), __builtin_amdgcn_exp2f(x11)};
                       x00 = 0.f; x01 = 0.f; x10 = 0.f; x11 = 0.f; }
        unsigned wf[16], wb[16], wq[16];
#pragma unroll
        for (int i = 0; i < 16; ++i) { const size_t n = n0 + (size_t)(tb + ts * i); wf[i] = *(const unsigned*)(zf + n * ZW); wb[i] = *(const unsigned*)(zb + n * ZW); wq[i] = *(const unsigned*)(zq + n * ZW); }
#pragma unroll
        for (int i = 0; i < 16; ++i) { const size_t n = n0 + (size_t)(tb + ts * i);
            const float q0 = __uint_as_float(wq[i] << 16), q1 = __uint_as_float(wq[i] & 0xffff0000u);
            const float s0 = q0 * __builtin_amdgcn_rcpf(1.0f + __builtin_amdgcn_exp2f(-1.4426950408889634f * q0)), s1 = q1 * __builtin_amdgcn_rcpf(1.0f + __builtin_amdgcn_exp2f(-1.4426950408889634f * q1));
            float k00, k01, k10, k11, l00, l01, l10, l11;
            hgrn_gate(__uint_as_float(wf[i] << 16), lb0, ol0, k00, l00); hgrn_gate(__uint_as_float(wf[i] & 0xffff0000u), lb1, ol1, k01, l01);
            hgrn_gate(__uint_as_float(wb[i] << 16), lb0, ol0, k10, l10); hgrn_gate(__uint_as_float(wb[i] & 0xffff0000u), lb1, ol1, k11, l11);
            const float y00 = x00 + l00, y01 = x01 + l01, y10 = x10 + l10, y11 = x11 + l11;
            const float e00 = up ? y00 : -x00, e01 = up ? y01 : -x01, e10 = up ? -x10 : y10, e11 = up ? -x11 : y11;
            x00 = y00; x01 = y01; x10 = y10; x11 = y11;
            *(unsigned*)(QH + n * 1024) = pk2(s0 * __builtin_amdgcn_exp2f(fminf(e00, CL)), s1 * __builtin_amdgcn_exp2f(fminf(e01, CL)));
            *(unsigned*)(KH + n * 1024) = pk2(k00 * __builtin_amdgcn_exp2f(fminf(-e00, CL)), k01 * __builtin_amdgcn_exp2f(fminf(-e01, CL)));
            *(unsigned*)(QH + DS + n * 1024) = pk2(s0 * __builtin_amdgcn_exp2f(fminf(e10, CL)), s1 * __builtin_amdgcn_exp2f(fminf(e11, CL)));
            *(unsigned*)(KH + DS + n * 1024) = pk2(k10 * __builtin_amdgcn_exp2f(fminf(-e10, CL)), k11 * __builtin_amdgcn_exp2f(fminf(-e11, CL))); }
    }
    *(f32x2*)(GM + go) = (f32x2){__builtin_amdgcn_exp2f(x00), __builtin_amdgcn_exp2f(x01)}; *(f32x2*)(GL + gd + go) = (f32x2){__builtin_amdgcn_exp2f(x10), __builtin_amdgcn_exp2f(x11)};
}
struct PostP { const float *gnw, *gnb, *rk, *hng, *ka; };
__device__ __forceinline__ void post_token(size_t m, const PostP& P, unsigned char* ws, int lane) {
    const int c16 = 16 * lane; const size_t o = m * 1024 + c16;
    float of[16], ob[16], gz[16];
    ld16bf((const bf16*)(ws + WS_OS) + o, of); ld16bf((const bf16*)(ws + WS_OS) + (size_t)M * 1024 + o, ob); ld16bf((const bf16*)(ws + WS_Z) + m * ZW + ZO_H + 4096 + c16, gz);
    { float yf[16], yb[16]; ld16bf((const bf16*)(ws + WS_YS) + o, yf); ld16bf((const bf16*)(ws + WS_YS) + (size_t)M * 1024 + o, yb);
      float s1 = 0.f;
#pragma unroll
      for (int i = 0; i < 16; ++i) { yf[i] += yb[i]; s1 += yf[i]; }
      s1 += __shfl_xor(s1, 1); s1 += __shfl_xor(s1, 2); const float mean = s1 * (1.0f / 64.0f); float s2 = 0.f;
#pragma unroll
      for (int i = 0; i < 16; ++i) { yf[i] -= mean; s2 += yf[i] * yf[i]; }
      s2 += __shfl_xor(s2, 1); s2 += __shfl_xor(s2, 2); const float rstd = __builtin_amdgcn_rsqf(s2 * (1.0f / 64.0f) + 64e-5f);
      float r[16], k0[16], k1[16], t[16]; ld16bf((const bf16*)(ws + WS_R) + o, r); ld16bf((const bf16*)(ws + WS_A) + o, k0); ld16bf((const bf16*)(ws + WS_A) + (size_t)M * 1024 + o, k1); ld16f(P.rk + c16, t);
      float bs = 0.f;
      { float ks[16], ka[16]; ld16bf((const bf16*)(ws + WS_KS) + o, ks); ld16f(P.ka + c16, ka);
#pragma unroll
        for (int i = 0; i < 16; ++i) bs += r[i] * ks[i] * (2.0f + (k0[i] + k1[i] - 2.0f) * ka[i]) * t[i]; }
      bs += __shfl_xor(bs, 1); bs += __shfl_xor(bs, 2);
      float gw_[16], gb_[16], v[16], g[16]; ld16f(P.gnw + c16, gw_); ld16f(P.gnb + c16, gb_); ld16bf((const bf16*)(ws + WS_V) + o, v); ld16bf((const bf16*)(ws + WS_G) + o, g);
#pragma unroll
      for (int i = 0; i < 16; ++i) yf[i] = (yf[i] * rstd * gw_[i] + gb_[i] + bs * v[i]) * g[i];
      st16bf((bf16*)(ws + WS_YA) + o, yf); }
    { float ss = 0.f;
#pragma unroll
      for (int i = 0; i < 16; ++i) { of[i] += ob[i]; ss += of[i] * of[i]; }
      ss += __shfl_xor(ss, 1); ss += __shfl_xor(ss, 2); ss += __shfl_xor(ss, 4);
      const float rstd = __builtin_amdgcn_rsqf(ss * (1.0f / 128.0f) + 1e-6f);
      float ng[16]; ld16f(P.hng + (c16 & 127), ng);
#pragma unroll
      for (int i = 0; i < 16; ++i) of[i] = of[i] * rstd * ng[i] * (gz[i] * sigmf(gz[i]));
      st16bf((bf16*)(ws + WS_YB) + o, of); }
}
#define SCAN_BAR() do { asm volatile("s_waitcnt lgkmcnt(0)" ::: "memory"); __builtin_amdgcn_s_barrier(); asm volatile("" ::: "memory"); } while (0)
__device__ __forceinline__ float quad_sum(float x) {
    x += __builtin_bit_cast(float, __builtin_amdgcn_update_dpp(0, __builtin_bit_cast(int, x), 0xB1, 0xF, 0xF, true));
    x += __builtin_bit_cast(float, __builtin_amdgcn_update_dpp(0, __builtin_bit_cast(int, x), 0x4E, 0xF, 0xF, true));
    return x;
}
__device__ __forceinline__ float oct_sum(float x) {
    x += __builtin_bit_cast(float, __builtin_amdgcn_update_dpp(0, __builtin_bit_cast(int, x), 0xB1, 0xF, 0xF, true));
    x += __builtin_bit_cast(float, __builtin_amdgcn_update_dpp(0, __builtin_bit_cast(int, x), 0x4E, 0xF, 0xF, true));
    x += __builtin_bit_cast(float, __builtin_amdgcn_update_dpp(0, __builtin_bit_cast(int, x), 0x141, 0xF, 0xF, true));
    return x;
}
__device__ __forceinline__ void rwkv_scan(int sid, const float* kal, const float* kkl, unsigned char* ws, LAS unsigned char* lds) {
    const int tid = tid_opaque(), wave = __builtin_amdgcn_readfirstlane(tid >> 6), lane = tid & 63;
    const int dir = sid & 1, bh = sid >> 1, h = bh & 15, b = bh >> 4;
    constexpr int NB = SEQ / 16;
    constexpr int O_XI = 0, O_B2T = 16384, O_VT = 32768, O_YI = 49152, O_MN = 61440, O_GS = 73728, O_SB = 81920, O_OUT = 90112, O_WRAW = 98304, O_LAM = 106496;
    LAS float* outb = (LAS float*)(lds + O_OUT); LAS float* lamb = (LAS float*)(lds + O_LAM);
#define SW128(row, k) ((row) * 128 + (((((k) >> 3) << 4)) ^ (((row) & 7) << 4)) + ((k) & 7) * 2)
#define SW64(row, kk) ((row) * 64 + (((((kk) >> 3) << 4)) ^ ((((row) >> 2) & 3) << 4)) + ((kk) & 7) * 2)
#define NK(t_) (((t_) & 3) + 8 * ((t_) >> 2))
    if (wave >= 4) {
        const int j = tid - 256, st = j & 15, q4 = j >> 4;
        const size_t dofs = (size_t)dir * M * 1024;
        const int co = h * 64 + q4 * 4;
        const float* b0 = (const float*)(ws + WS_KAP) + h;     const unsigned short* b1 = (const unsigned short*)(ws + WS_W) + dofs + co; const bf16* b2 = (const bf16*)(ws + WS_A) + dofs + co;
        const bf16* b3 = (const bf16*)(ws + WS_KS) + co; const bf16* b4 = (const bf16*)(ws + WS_R) + co; const bf16* b5 = (const bf16*)(ws + WS_V) + co;
        const f32x4 ka4 = *(const f32x4*)(kal + co), kk4 = *(const f32x4*)(kkl + co);
        bf16* YS = (bf16*)(ws + WS_YS) + dofs + co;
        const int nk = NK(st), nr = nk + 4;
        const int q4p = (q4 & 12) | ((q4 & 1) << 1) | ((q4 & 2) >> 1);
        struct Raw { v2u a, ks, r, v, w; float ki; };
        typedef _Float16 h16x4_ __attribute__((ext_vector_type(4)));
        Raw A, B, C;
#define RW_TOK(nb_) ((size_t)(b * SEQ + (dir ? SEQ - 1 - ((nb_) * 16 + st) : (nb_) * 16 + st)) * 1024)
#define RW_LOAD(X, nb_) do { const size_t o_ = RW_TOK(nb_); X.ki = b0[(o_ >> 10) * 16]; X.w = *(const v2u*)(b1 + o_); X.a = *(const v2u*)(b2 + o_); X.ks = *(const v2u*)(b3 + o_); X.r = *(const v2u*)(b4 + o_); X.v = *(const v2u*)(b5 + o_); } while (0)
#define BF4(w_) ((f32x4){__uint_as_float((w_).x << 16), __uint_as_float((w_).x & 0xffff0000u), __uint_as_float((w_).y << 16), __uint_as_float((w_).y & 0xffff0000u)})
#define PK4B(v_) ((v2u){pg8::cvt_pk_bf16((v_)[0], (v_)[1]), pg8::cvt_pk_bf16((v_)[2], (v_)[3])})
#define RW_SHR(x_, n_) __builtin_bit_cast(float, __builtin_amdgcn_update_dpp(0x3f800000, __builtin_bit_cast(int, x_), 0x110 + (n_), 0xF, 0xF, false))
#define RW_SCALE(X, nb_) do { f32x4 lt_ = __builtin_convertvector(__builtin_bit_cast(h16x4_, X.w), f32x4), lp_; \
        _Pragma("unroll") for (int e_ = 0; e_ < 4; ++e_) { float x_ = lt_[e_]; x_ *= RW_SHR(x_, 1); x_ *= RW_SHR(x_, 2); x_ *= RW_SHR(x_, 4); x_ *= RW_SHR(x_, 8); lt_[e_] = x_; lp_[e_] = RW_SHR(x_, 1); } \
        f32x4 il_; il_[0] = __builtin_amdgcn_rcpf(lt_[0]); il_[1] = __builtin_amdgcn_rcpf(lt_[1]); il_[2] = __builtin_amdgcn_rcpf(lt_[2]); il_[3] = __builtin_amdgcn_rcpf(lt_[3]); \
        const f32x4 af_ = BF4(X.a), sf_ = BF4(X.ks), kf_ = sf_ * kk4 * X.ki; const int p3_ = ((nb_) & 3) * 4096, p2_ = ((nb_) % 3) * 4096; \
        const f32x4 kh_ = kf_ * lp_, bh_ = (kf_ * af_) * il_, th_ = (sf_ * (1.0f + (af_ - 1.0f) * ka4)) * il_, rh_ = BF4(X.r) * lt_; \
        *(LAS v2u*)(lds + O_XI + p3_ + SW128(nk, 4 * q4p)) = PK4B(kh_); *(LAS v2u*)(lds + O_XI + p3_ + SW128(nr, 4 * q4p)) = PK4B(rh_); \
        *(LAS v2u*)(lds + O_YI + p2_ + SW128(st, 4 * q4p)) = PK4B(bh_); *(LAS v2u*)(lds + O_YI + p2_ + SW128(16 + st, 4 * q4p)) = PK4B(th_); \
        _Pragma("unroll") for (int e_ = 0; e_ < 4; ++e_) { const unsigned w2_ = pg8::cvt_pk_bf16(bh_[e_], th_[e_]); *(LAS unsigned short*)(lds + O_B2T + p3_ + SW64(4 * q4 + e_, st)) = (unsigned short)(w2_ & 0xffffu); *(LAS unsigned short*)(lds + O_B2T + p3_ + SW64(4 * q4 + e_, 16 + st)) = (unsigned short)(w2_ >> 16); } \
        { const unsigned vw_[4] = {X.v.x & 0xffffu, X.v.x >> 16, X.v.y & 0xffffu, X.v.y >> 16}; \
          _Pragma("unroll") for (int e_ = 0; e_ < 4; ++e_) *(LAS unsigned short*)(lds + O_VT + p3_ + SW64(4 * q4 + e_, 16 + st)) = (unsigned short)vw_[e_]; } \
        if (st == 15) *(LAS f32x4*)(lamb + ((nb_) & 3) * 64 + q4 * 4) = lt_; } while (0)
#define RW_FLUSH(nb_) do { const f32x4 y_ = *(const LAS f32x4*)(outb + (((nb_) & 1) * 16 + st) * 64 + ((q4 ^ st) << 2)); v2u w_; w_.x = pk2(y_[0], y_[1]); w_.y = pk2(y_[2], y_[3]); *(v2u*)(YS + RW_TOK(nb_)) = w_; } while (0)
#define RW_ITER(nb_, X1, X2) do { if ((nb_) + 3 < NB) RW_SCALE(X1, (nb_) + 3); if ((nb_) + 6 < NB) RW_LOAD(X1, (nb_) + 6); if ((nb_) > 0) RW_FLUSH((nb_) - 1); SCAN_BAR(); } while (0)
        RW_LOAD(A, 0); RW_LOAD(B, 1); RW_LOAD(C, 2);
        SCAN_BAR();
        RW_SCALE(A, 0); RW_LOAD(A, 3);
        SCAN_BAR();
        RW_SCALE(B, 1); RW_LOAD(B, 4);
        SCAN_BAR();
        RW_SCALE(C, 2); RW_LOAD(C, 5);
        SCAN_BAR();
        for (int nb = 0; nb + 2 < NB; nb += 3) { RW_ITER(nb, A, B); RW_ITER(nb + 1, B, C); RW_ITER(nb + 2, C, A); }
        RW_ITER(NB - 1, A, B);
        static_assert(NB % 3 == 1, "stager loop tail assumes NB = 1 (mod 3)");
        RW_FLUSH(NB - 1);
#undef RW_TOK
#undef RW_LOAD
#undef RW_SHR
#undef RW_SCALE
#undef RW_FLUSH
#undef RW_ITER
#undef BF4
#undef PK4B
    } else if (wave < 2) {
        typedef short bfx8 __attribute__((ext_vector_type(8))); typedef float f16v __attribute__((ext_vector_type(16))); typedef unsigned u4v __attribute__((ext_vector_type(4)));
        const int vl = lane & 31, hi = lane >> 5, vrow = 32 * wave + vl;
        f16v St0 = {}, St1 = {};
        bfx8 so0 = {}, so1 = {}, so2 = {}, so3 = {};
        SCAN_BAR(); SCAN_BAR(); SCAN_BAR(); SCAN_BAR();
#pragma unroll 1
        for (int nb = 0; nb < NB; ++nb) {
            const int p3 = (nb & 3) * 4096, p2 = (nb % 3) * 4096;
            const LAS unsigned char* xi = lds + O_XI + p3; const LAS unsigned char* b2t = lds + O_B2T + p3; LAS unsigned char* vt = lds + O_VT + p3; const LAS unsigned char* mn = lds + O_MN + p2;
            f16v pq = {};
#pragma unroll
            for (int q = 0; q < 4; ++q) { const bfx8 ax = *(const LAS bfx8*)(xi + SW128(vl, 16 * q + 8 * hi)); pq = __builtin_amdgcn_mfma_f32_32x32x16_bf16(ax, q == 0 ? so0 : (q == 1 ? so1 : (q == 2 ? so2 : so3)), pq, 0, 0, 0); }
            f32x4 lm0[4], lm1[4];
#pragma unroll
            for (int g4 = 0; g4 < 4; ++g4) { lm0[g4] = *(const LAS f32x4*)(lamb + (nb & 3) * 64 + 8 * g4 + 4 * hi); lm1[g4] = *(const LAS f32x4*)(lamb + (nb & 3) * 64 + 32 + 8 * g4 + 4 * hi); }
            bfx8 pa0, pa1;
#define PK4(P, BASE, OUT) do { const unsigned a0 = pg8::cvt_pk_bf16(P[BASE + 0], P[BASE + 1]), a1 = pg8::cvt_pk_bf16(P[BASE + 2], P[BASE + 3]), b0_ = pg8::cvt_pk_bf16(P[BASE + 4], P[BASE + 5]), b1_ = pg8::cvt_pk_bf16(P[BASE + 6], P[BASE + 7]); \
        const auto r0 = __builtin_amdgcn_permlane32_swap(a0, b0_, false, false); const auto r1 = __builtin_amdgcn_permlane32_swap(a1, b1_, false, false); \
        const u4v w_ = {r0[0], r1[0], r0[1], r1[1]}; OUT = __builtin_bit_cast(bfx8, w_); } while (0)
            PK4(pq, 0, pa0); PK4(pq, 8, pa1);
#undef PK4
            f16v d = {};
            const bfx8 pv = *(const LAS bfx8*)(vt + SW64(vrow, 16 + 8 * hi));
            const bfx8 bk00 = *(const LAS bfx8*)(b2t + SW64(vl, 8 * hi)), bk10 = *(const LAS bfx8*)(b2t + SW64(32 + vl, 8 * hi)), bk01 = *(const LAS bfx8*)(b2t + SW64(vl, 16 + 8 * hi)), bk11 = *(const LAS bfx8*)(b2t + SW64(32 + vl, 16 + 8 * hi));
            { const bfx8 m0 = *(const LAS bfx8*)(mn + SW128(vl, 8 * hi)), m1 = *(const LAS bfx8*)(mn + SW128(vl, 16 + 8 * hi)), m2 = *(const LAS bfx8*)(mn + SW128(vl, 32 + 8 * hi));
              d = __builtin_amdgcn_mfma_f32_32x32x16_bf16(m0, pa0, d, 0, 0, 0); d = __builtin_amdgcn_mfma_f32_32x32x16_bf16(m1, pa1, d, 0, 0, 0); d = __builtin_amdgcn_mfma_f32_32x32x16_bf16(m2, pv, d, 0, 0, 0); }
            bfx8 av0;
            { const unsigned w0x = pg8::cvt_pk_bf16(d[0], d[1]), w0y = pg8::cvt_pk_bf16(d[2], d[3]), w0z = pg8::cvt_pk_bf16(d[4], d[5]), w0w = pg8::cvt_pk_bf16(d[6], d[7]);
              const unsigned w1x = pg8::cvt_pk_bf16(d[8], d[9]), w1y = pg8::cvt_pk_bf16(d[10], d[11]), w1z = pg8::cvt_pk_bf16(d[12], d[13]), w1w = pg8::cvt_pk_bf16(d[14], d[15]);
              const auto e0 = __builtin_amdgcn_permlane32_swap(w0x, w1x, false, false); const auto e1 = __builtin_amdgcn_permlane32_swap(w0y, w1y, false, false);
              const auto e2 = __builtin_amdgcn_permlane32_swap(w0z, w1z, false, false); const auto e3 = __builtin_amdgcn_permlane32_swap(w0w, w1w, false, false);
              const u4v w_ = {e0[0], e1[0], e2[0], e3[0]}; av0 = __builtin_bit_cast(bfx8, w_); }
            if (hi == 1) { LAS float* po = outb + (nb & 1) * 16 * 64 + (vrow & 3);
#pragma unroll
                for (int t = 0; t < 16; ++t) po[t * 64 + (((vrow >> 2) ^ t) << 2)] = d[t]; }
            St0 = __builtin_amdgcn_mfma_f32_32x32x16_bf16(bk00, av0, St0, 0, 0, 0); St1 = __builtin_amdgcn_mfma_f32_32x32x16_bf16(bk10, av0, St1, 0, 0, 0);
            St0 = __builtin_amdgcn_mfma_f32_32x32x16_bf16(bk01, pv, St0, 0, 0, 0); St1 = __builtin_amdgcn_mfma_f32_32x32x16_bf16(bk11, pv, St1, 0, 0, 0);
            {
#pragma unroll
              for (int r = 0; r < 16; ++r) { St0[r] *= lm0[r >> 2][r & 3]; St1[r] *= lm1[r >> 2][r & 3]; }
              u4v w_;
              w_ = (u4v){pg8::cvt_pk_bf16(St0[0], St0[1]), pg8::cvt_pk_bf16(St0[2], St0[3]), pg8::cvt_pk_bf16(St0[4], St0[5]), pg8::cvt_pk_bf16(St0[6], St0[7])}; so0 = __builtin_bit_cast(bfx8, w_);
              w_ = (u4v){pg8::cvt_pk_bf16(St0[8], St0[9]), pg8::cvt_pk_bf16(St0[10], St0[11]), pg8::cvt_pk_bf16(St0[12], St0[13]), pg8::cvt_pk_bf16(St0[14], St0[15])}; so1 = __builtin_bit_cast(bfx8, w_);
              w_ = (u4v){pg8::cvt_pk_bf16(St1[0], St1[1]), pg8::cvt_pk_bf16(St1[2], St1[3]), pg8::cvt_pk_bf16(St1[4], St1[5]), pg8::cvt_pk_bf16(St1[6], St1[7])}; so2 = __builtin_bit_cast(bfx8, w_);
              w_ = (u4v){pg8::cvt_pk_bf16(St1[8], St1[9]), pg8::cvt_pk_bf16(St1[10], St1[11]), pg8::cvt_pk_bf16(St1[12], St1[13]), pg8::cvt_pk_bf16(St1[14], St1[15])}; so3 = __builtin_bit_cast(bfx8, w_); }
            SCAN_BAR();
        }
    } else {
        typedef short bfx8 __attribute__((ext_vector_type(8))); typedef float f16v __attribute__((ext_vector_type(16))); typedef unsigned u4v __attribute__((ext_vector_type(4)));
        const int vl = lane & 31, hi = lane >> 5, j = lane & 15, grp = lane >> 4;
        LAS float* gk = (LAS float*)(lds + O_GS + (wave - 2) * 4096); LAS float* gr = gk + 512;
        const int col = grp == 0 ? NK(j) : (grp == 1 ? 32 + j : (grp == 2 ? NK(j) + 4 : 48 + j));
#define MK_SPLIT 9
#define MK_BATCH(kb_) do { const LAS unsigned char* xi = lds + O_XI + ((kb_) & 3) * 4096; const LAS unsigned char* yi = lds + O_YI + ((kb_) % 3) * 4096; LAS unsigned char* mo = lds + O_MN + ((kb_) % 3) * 4096; \
        f16v g = {}; \
        _Pragma("unroll") for (int q = 0; q < 4; ++q) { const bfx8 ay = *(const LAS bfx8*)(yi + SW128(vl, 16 * q + 8 * hi)), bx = *(const LAS bfx8*)(xi + SW128(vl, 16 * q + 8 * hi)); g = __builtin_amdgcn_mfma_f32_32x32x16_bf16(ay, bx, g, 0, 0, 0); } \
        { const int tb_ = (vl >> 2) & 1, t_ = (vl & 3) + 4 * (vl >> 3); LAS float* gp_ = gk + tb_ * 512 + t_ * 32; \
          _Pragma("unroll") for (int r = 0; r < 16; ++r) gp_[(r & 3) + 8 * (r >> 2) + 4 * hi] = g[r]; } \
        asm volatile("s_waitcnt lgkmcnt(0)" ::: "memory"); \
        float x[16]; const float m0_ = grp == 0 ? -1.0f : 0.f, m1_ = grp == 1 ? -1.0f : 0.f; \
        f32x4 Lr[2][4]; float gq[2]; \
        _Pragma("unroll") for (int s4 = 0; s4 < 4; ++s4) Lr[0][s4] = *(const LAS f32x4*)(gk + 4 * s4); gq[0] = gk[16 + j]; \
        _Pragma("unroll") for (int t = 0; t < 16; ++t) {             \
            if (t == MK_SPLIT) SCAN_BAR();            \
            if (t + 1 < 16) { _Pragma("unroll") for (int s4 = 0; s4 < 4; ++s4) { if (4 * s4 < t + 1) Lr[(t + 1) & 1][s4] = *(const LAS f32x4*)(gk + (t + 1) * 32 + 4 * s4); } gq[(t + 1) & 1] = gk[(t + 1) * 32 + 16 + j]; } \
            float rhs = (t == j ? m0_ : 0.f) + (j < t ? m1_ * gq[t & 1] : 0.f); \
            _Pragma("unroll") for (int s = 0; s < 16; ++s) if (s < t) rhs = __builtin_fmaf(-Lr[t & 1][s >> 2][s & 3], x[s], rhs); \
            x[t] = rhs; asm volatile("" : "+v"(x[t]) :: "memory"); } \
          \
        f16v cm = {}; unsigned xp_s_[8]; \
        { const f32x4 b0_ = *(const LAS f32x4*)(gr + (vl & 15) * 32 + 8 * hi), b1_ = *(const LAS f32x4*)(gr + (vl & 15) * 32 + 8 * hi + 4); float bb_[8]; \
          _Pragma("unroll") for (int e = 0; e < 4; ++e) { bb_[e] = (vl < 16 && 8 * hi + e <= vl) ? b0_[e] : 0.f; bb_[4 + e] = (vl < 16 && 8 * hi + 4 + e <= vl) ? b1_[e] : 0.f; } \
          const u4v aw_ = {pg8::cvt_pk_bf16(bb_[0], bb_[1]), pg8::cvt_pk_bf16(bb_[2], bb_[3]), pg8::cvt_pk_bf16(bb_[4], bb_[5]), pg8::cvt_pk_bf16(bb_[6], bb_[7])}; \
          _Pragma("unroll") for (int q = 0; q < 8; ++q) xp_s_[q] = pg8::cvt_pk_bf16(x[2 * q], x[2 * q + 1]); \
          u4v bw_; _Pragma("unroll") for (int q = 0; q < 4; ++q) { const auto r_ = __builtin_amdgcn_permlane32_swap(xp_s_[q], xp_s_[4 + q], false, false); bw_[q] = r_[0]; }     \
          cm = __builtin_amdgcn_mfma_f32_32x32x16_bf16(__builtin_bit_cast(bfx8, aw_), __builtin_bit_cast(bfx8, bw_), cm, 0, 0, 0); } \
          \
        { const int cj_ = vl & 15; const bool c2_ = vl >= 16; float b2_[8]; \
          _Pragma("unroll") for (int r = 0; r < 8; ++r) { const int t = (r & 3) + 8 * (r >> 2) + 4 * hi; b2_[r] = gr[t * 32 + 16 + cj_]; } \
          const int colc_ = c2_ ? 32 + cj_ : NK(cj_); \
          if (hi == 0) { _Pragma("unroll") for (int q = 0; q < 8; ++q) { *(LAS unsigned short*)(mo + SW128(NK(2 * q), colc_)) = (unsigned short)(xp_s_[q] & 0xffffu); *(LAS unsigned short*)(mo + SW128(NK(2 * q + 1), colc_)) = (unsigned short)(xp_s_[q] >> 16); } } \
          _Pragma("unroll") for (int r = 0; r < 8; r += 2) { const int t0 = (r & 3) + 8 * (r >> 2) + 4 * hi; \
              const float c0_ = cm[r] + ((c2_ && cj_ <= t0) ? b2_[r] : 0.f), c1_ = cm[r + 1] + ((c2_ && cj_ <= t0 + 1) ? b2_[r + 1] : 0.f); const unsigned w2_ = pg8::cvt_pk_bf16(c0_, c1_); \
              *(LAS unsigned short*)(mo + SW128(NK(t0) + 4, colc_)) = (unsigned short)(w2_ & 0xffffu); *(LAS unsigned short*)(mo + SW128(NK(t0 + 1) + 4, colc_)) = (unsigned short)(w2_ >> 16); } } } while (0)
        if (wave == 2) {
            unsigned z_ = 0u; asm volatile("" : "+v"(z_));
#pragma unroll
            for (int i = 0; i < 12; ++i) *(LAS v4u*)(lds + O_MN + (i * 64 + lane) * 16) = (v4u){z_, z_, z_, z_};
            asm volatile("s_waitcnt lgkmcnt(0)" ::: "memory");
            if (lane < 48) { const int bi_ = lane >> 4, t = lane & 15; *(LAS unsigned short*)(lds + O_MN + bi_ * 4096 + SW128(NK(t) + 4, NK(t) + 4)) = (unsigned short)0x3f80u; } }
        if (wave == 2) { SCAN_BAR(); SCAN_BAR(); MK_BATCH(0); SCAN_BAR();
#pragma unroll 1
            for (int k = 2; k < NB; k += 2) { MK_BATCH(k); SCAN_BAR(); }
            SCAN_BAR(); SCAN_BAR(); }
        else { SCAN_BAR(); SCAN_BAR(); SCAN_BAR(); MK_BATCH(1); SCAN_BAR();
#pragma unroll 1
            for (int k = 3; k < NB; k += 2) { MK_BATCH(k); SCAN_BAR(); }
            SCAN_BAR(); }
#undef MK_BATCH
#undef MK_SPLIT
    }
#undef SW128
#undef SW64
#undef NK
}

constexpr int N_LAUNCHES = MK_N_LAUNCHES;
struct Args { const void* in[30]; float* out; unsigned char* ws; int ph_lo, ph_hi; };
enum { I_X = 0, I_P, I_POS, I_LN1, I_WIN, I_MU, I_W0, I_W2, I_A0, I_A2, I_G2, I_KK, I_KA, I_RK, I_GNW, I_GNB, I_HLB, I_HNG, I_QG, I_KVG, I_UQ, I_UKV, I_BR, I_WO, I_LN2, I_W1, I_W2M, I_WPE, I_WPG, I_FG };
#define INF(i) ((const float*)args.in[i])

__global__ void __launch_bounds__(NWAVES * 64, 2) fwd(Args args) {
    extern __shared__ __attribute__((aligned(16))) unsigned char lds_[];
    LAS unsigned char* lds = (LAS unsigned char*)lds_;
    volatile LAS unsigned* MISC = (volatile LAS unsigned*)(lds + MISC_OFF);
    const int tid = threadIdx.x, lane = tid & 63, wave = __builtin_amdgcn_readfirstlane(tid >> 6), G = gridDim.x, bx = blockIdx.x;
    const int gw = bx * NWAVES + wave, NGW = G * NWAVES;
    unsigned char* ws = args.ws; gu32* ctl = (gu32*)(ws + WS_CTL);
    float* H = args.out;
    for (int u = tid; u < (LDS_BYTES - RING_BYTES) / 4; u += NWAVES * 64) ((LAS unsigned*)(lds + RING_BYTES))[u] = 0u;
    __syncthreads();
    XcdBarrier bar; bar.bar = (unsigned*)(ctl + CW_BAR); bar.x = 0; bar.st = nullptr;
    if (N_LAUNCHES == 1) bar = xcd_barrier_post((unsigned*)(ctl + CW_BAR), MISC + 8);
    const int lo = args.ph_lo, hi = args.ph_hi;
#ifndef PHMASK
#define PHMASK 0xFFFFFF
#endif
#define IN(k) (lo <= (k) && (k) < hi)
#define ON(k) ((PHMASK >> (k)) & 1)
#ifndef CVFILL
#define CVFILL 1
#endif
#ifndef WGM_Z
#define WGM_Z 4
#define WGM_M1 4
#define WGM_M2 4
#define WGM_O 2
#endif
#ifndef DUP_MASK
#define DUP_MASK 0
#endif
#define DUPK(k) ((DUP_MASK >> (k)) & 1)
#ifndef PROBE_X2
#define PROBE_X2 0
#endif
#ifndef DUP_SUB
#define DUP_SUB 7
#endif
#define SEAM(k) do { if (N_LAUNCHES == 1) { if (IN(k) && IN((k) + 1)) xcd_barrier(bar); } } while (0)
    bf16* XN = (bf16*)(ws + WS_XN); bf16* Z = (bf16*)(ws + WS_Z); float* COS = (float*)(ws + WS_COS); float* SIN = (float*)(ws + WS_SIN); float* LB = (float*)(ws + WS_LB);
    bf16* PB = (bf16*)(ws + WS_PB);

    if (IN(0)) {
        const int tid = tid_opaque(); const size_t gt = (size_t)bx * 512 + tid, NGT = (size_t)G * 512;
        const int* pos = (const int*)args.in[I_POS];
        for (size_t i = gt; i < (size_t)M * 32; i += NGT) { const int m = (int)(i >> 5), j = (int)(i & 31);
            const float inv = __builtin_amdgcn_exp2f(-13.287712379549449f * (float)j * (1.0f / 32.0f)); const float ang = (float)pos[m] * inv;
            const float k = rintf(ang * 0.15915494309189535f); float r = fmaf(-k, 6.28125f, ang); r = fmaf(-k, 0.0019353071795864769f, r);
            COS[i] = __cosf(r); SIN[i] = __sinf(r); }
        { unsigned z_ = 0u; asm volatile("" : "+v"(z_)); const v4u z4_ = {z_, z_, z_, z_};
          v4u* p1_ = (v4u*)(ws + WS_WIN + (size_t)3488 * 4096); v4u* p2_ = (v4u*)(ws + WS_WIN + (size_t)10048 * 4096); v4u* p3_ = (v4u*)(ws + WS_LORA);
          for (size_t i = gt; i < (size_t)96 * 4096 / 16; i += NGT) p1_[i] = z4_;
          for (size_t i = gt; i < (size_t)192 * 4096 / 16; i += NGT) p2_[i] = z4_;
          for (size_t i = gt; i < (size_t)5120 * 512 * 2 / 16; i += NGT) p3_[i] = z4_; }
        if (gt < 1024) { const float* hl = INF(I_HLB); float e[4], mx = -1e30f, sum = 0.f;
#pragma unroll
            for (int l = 0; l < 4; ++l) { e[l] = hl[l * 1024 + gt]; mx = fmaxf(mx, e[l]); }
#pragma unroll
            for (int l = 0; l < 4; ++l) { e[l] = expf(e[l] - mx); sum += e[l]; }
            float cum = 0.f; const float w0 = e[0] / sum;
#pragma unroll
            for (int l = 0; l < 4; ++l) { cum += e[l] / sum; LB[l * 1024 + gt] = cum - w0; } }
        { const int lane = tid & 63; float* RS0 = (float*)(ws + WS_RSTD); const float* g0 = INF(I_LN1);
          for (int m = gw; m < M; m += NGW) { const f32x4* xr = (const f32x4*)(INF(I_X) + (size_t)m * 2048) + lane; f32x4* hr = (f32x4*)(H + (size_t)m * 2048) + lane; v2u* xo = (v2u*)(XN + (size_t)m * 2048) + lane; float q = 0.f;
#pragma unroll
              for (int j = 0; j < 8; ++j) { const f32x4 v = xr[64 * j]; hr[64 * j] = v; q += (v[0] * v[0] + v[1] * v[1]) + (v[2] * v[2] + v[3] * v[3]); const f32x4 o = v * ((const f32x4*)g0)[64 * j + lane]; v2u w; w.x = pk2(o[0], o[1]); w.y = pk2(o[2], o[3]); xo[64 * j] = w; }
              q = wave_sum(q); if (lane == 0) RS0[m] = __builtin_amdgcn_rsqf(q * (1.0f / 2048.0f) + 1e-6f); } }
        SEAM(0);
    }

    for (int l = 0; l < DEPTH; ++l) {
        const int pb = 1 + NPH_LAYER * l;
        if (hi <= pb || lo >= pb + NPH_LAYER) continue;
        if (ON(0) && IN(pb + 0)) for (int rep_ = 0; rep_ < 1 + DUPK(0); ++rep_) {
            const int tid = tid_opaque(), lane = tid & 63; const size_t gt = (size_t)bx * 512 + tid, NGT = (size_t)G * 512; (void)lane; (void)gt; (void)NGT;
            LayerW L; L.w_in = INF(I_WIN) + (size_t)l * 2048 * IN_W; L.w2 = INF(I_W2) + (size_t)l * 2 * 64 * 1024; L.a2 = INF(I_A2) + (size_t)l * 2 * 64 * 1024; L.g2 = INF(I_G2) + (size_t)l * 160 * 1024;
            L.uq = INF(I_UQ) + (size_t)l * 768 * 1536; L.ukv = INF(I_UKV) + (size_t)l * 512 * 2048; L.br = INF(I_BR) + (size_t)l * 3 * 1024 * 2048; L.wo = INF(I_WO) + (size_t)l * 2048 * 2048;
            L.w1 = INF(I_W1) + (size_t)l * 2048 * 8192; L.w2m = INF(I_W2M) + (size_t)l * 8192 * 2048; L.wpe = INF(I_WPE) + (size_t)l * 256 * 2048; L.wpg = INF(I_WPG) + (size_t)l * 2048 * 2048;
            convert_weights(L, ws, (LAS float*)(lds + wave * 16384), gw, NGW, lane, (l > 0 && CVFILL) ? TR_EARLY : 0);
            const float* pl = INF(I_P) + (size_t)l * M * 256;
            for (size_t i = gt; i < (size_t)M * 256 / 8; i += NGT) { const f32x4 a = *(const f32x4*)(pl + 8 * i), b = *(const f32x4*)(pl + 8 * i + 4);
                v4u o; o.x = pk2(a[0], a[1]); o.y = pk2(a[2], a[3]); o.z = pk2(b[0], b[1]); o.w = pk2(b[2], b[3]); *(v4u*)(PB + 8 * i) = o; }
            if (l > 0) { const float* SSP = (const float*)(ws + WS_SS); float* RSO = (float*)(ws + WS_RSTD); for (int m0 = gw * 2 + (lane >> 5); m0 < M; m0 += NGW * 8) { float q4_[4];
#pragma unroll
              for (int i = 0; i < 4; ++i) { const int m = m0 + i * NGW * 2; q4_[i] = m < M ? SSP[(size_t)m * 32 + (lane & 31)] : 0.f; }
#pragma unroll
              for (int i = 0; i < 4; ++i) { const int m = m0 + i * NGW * 2; float q = q4_[i]; q += __shfl_xor(q, 1); q += __shfl_xor(q, 2); q += __shfl_xor(q, 4); q += __shfl_xor(q, 8); q += __shfl_xor(q, 16); if ((lane & 31) == 0 && m < M) RSO[m] = __builtin_amdgcn_rsqf(q * (1.0f / 2048.0f) + 1e-6f); } } }
            if (PROBE_X2 == 5) { convert_weights(L, ws, (LAS float*)(lds + wave * 16384), gw, NGW, lane, 0); for (int m = gw; m < M; m += NGW) rms_row<false>(H + (size_t)m * 2048, INF(I_LN1) + l * 2048, XN + (size_t)m * 2048, lane); }
            if (rep_ < DUPK(0)) xcd_barrier(bar); else SEAM(pb + 0);
        }
        if (ON(1) && IN(pb + 1)) for (int rep_ = 0; rep_ < 1 + DUPK(1); ++rep_) {
            const int tid = tid_opaque(), lane = tid & 63; const size_t gt = (size_t)bx * 512 + tid, NGT = (size_t)G * 512; (void)lane; (void)gt; (void)NGT;
            pg8::Gemm g{XN, (const bf16*)(ws + WS_WIN), M, ZW, 2048}; pg8::StaticOrder S; S.init(M, ZW, G, bx, WGM_Z);
            pg8::EpiB16<1> E{Z, ZW, (const float*)(ws + WS_RSTD), nullptr};
            pg8::gemm_phase<pg8::EpiB16<1>, pg8::StaticOrder, true, true>(lds, g, S, E);
            if (PROBE_X2 == 3) { __syncthreads(); pg8::gemm_phase<pg8::EpiB16<1>, pg8::StaticOrder, true, true>(lds, g, S, E); }
            if (rep_ < DUPK(1)) xcd_barrier(bar); else SEAM(pb + 1);
        }
        if (ON(2) && IN(pb + 2)) for (int rep_ = 0; rep_ < 1 + DUPK(2); ++rep_) {
            const int tid = tid_opaque(), lane = tid & 63; const size_t gt = (size_t)bx * 512 + tid, NGT = (size_t)G * 512; (void)lane; (void)gt; (void)NGT;
            PreP P; P.mu = INF(I_MU) + (size_t)l * 2 * RWKV_W; P.kk = INF(I_KK) + l * 1024; P.lb = LB + l * 1024; P.qg = INF(I_QG) + l * 768; P.kvg = INF(I_KVG) + l * 512; P.COS = COS; P.SIN = SIN;
            for (int r = gw; r < M / 4; r += NGW) pre_run_rwkv((size_t)r * 4, P, ws, lane);
            for (int m = gw; m < M; m += NGW) pre_token((size_t)m, P, ws, lane);
            for (int u = gw; u < 2048; u += NGW) hgrn_prep(u, LB + l * 1024, ws, lane);
            if (rep_ < DUPK(2)) xcd_barrier(bar); else SEAM(pb + 2);
        }
        if (ON(3) && IN(pb + 3)) for (int rep_ = 0; rep_ < 1 + DUPK(3); ++rep_) {
            const int tid = tid_opaque(), lane = tid & 63; const size_t gt = (size_t)bx * 512 + tid, NGT = (size_t)G * 512; (void)lane; (void)gt; (void)NGT;
            if (ON(16)) { pg8::Gemm g{(const bf16*)(ws + WS_ALORA), (const bf16*)(ws + WS_LORA), M, 4096, 256}; pg8::StaticOrder S; S.init(M, 4096, G, bx, WGM_O);
              pg8::EpiLora E{INF(I_W0) + l * 2048, INF(I_A0) + l * 2048, (unsigned short*)(ws + WS_W), (bf16*)(ws + WS_A), (bf16*)(ws + WS_G), 0};
              pg8::gemm_phase<pg8::EpiLora, pg8::StaticOrder, true, true>(lds, g, S, E); }
            if (ON(16) && (G != 256 || bx >= 128)) { pg8::Gemm g{(const bf16*)(ws + WS_ALORA) + (size_t)M * 256, (const bf16*)(ws + WS_LORA) + (size_t)4096 * 256, M, 1024, 256}; pg8::StaticOrder S; if (G == 256) S.init(M, 1024, 128, bx - 128, WGM_O); else S.init(M, 1024, G, bx, WGM_O);
              pg8::EpiLora E{INF(I_W0) + l * 2048, INF(I_A0) + l * 2048, (unsigned short*)(ws + WS_W), (bf16*)(ws + WS_A), (bf16*)(ws + WS_G), 16};
              pg8::gemm_phase<pg8::EpiLora, pg8::StaticOrder, true, true>(lds, g, S, E); }
            if (ON(17)) { pg8::Gemm g{(const bf16*)(ws + WS_CQN), (const bf16*)(ws + WS_UQ), M, 1536, 768}; pg8::StaticOrder S; S.init(M, 1536, G, bx, WGM_O);
              pg8::EpiB16<3> E{(bf16*)(ws + WS_Q), 1536, COS, SIN};
              pg8::gemm_phase<pg8::EpiB16<3>, pg8::StaticOrder, true, true>(lds, g, S, E); }
            if (ON(18)) { pg8::Gemm g{(const bf16*)(ws + WS_CKVN), (const bf16*)(ws + WS_UKV), M, 2048, 512}; pg8::StaticOrder S; S.init(M, 2048, G, bx, WGM_O);
              pg8::EpiB16<0> E{(bf16*)(ws + WS_KV), 2048, nullptr, nullptr};
              pg8::gemm_phase<pg8::EpiB16<0>, pg8::StaticOrder, true, true>(lds, g, S, E); }
            if (rep_ < DUPK(3)) xcd_barrier(bar); else SEAM(pb + 3);
        }
        if (ON(4) && IN(pb + 4)) for (int rep_ = 0; rep_ < 1 + DUPK(4); ++rep_) {
            const int tid = tid_opaque(), lane = tid & 63; const size_t gt = (size_t)bx * 512 + tid, NGT = (size_t)G * 512; (void)lane; (void)gt; (void)NGT;
            if (bx < 128) { if (ON(19) && (rep_ == 0 || (DUP_SUB & 1))) rwkv_scan(bx, INF(I_KA) + l * 1024, INF(I_KK) + l * 1024, ws, lds);
                if (PROBE_X2 == 1) { __syncthreads(); rwkv_scan(bx, INF(I_KA) + l * 1024, INF(I_KK) + l * 1024, ws, lds); } }
            else if (bx < 192) { if (ON(20) && (rep_ == 0 || (DUP_SUB & 4))) { const int qid = bx - 128, dir = qid & 1, bh = qid >> 1, h = bh & 7, b = bh >> 3;
                att::hgrn_chunk_seq((const bf16*)(ws + WS_QH) + ((size_t)dir * M + (size_t)b * SEQ) * 1024 + 128 * h, (const bf16*)(ws + WS_KH) + ((size_t)dir * M + (size_t)b * SEQ) * 1024 + 128 * h,
                                    (const bf16*)(ws + WS_Z) + (size_t)b * SEQ * ZW + ZO_H + 3072 + 128 * h, ZW, (const float*)(ws + WS_GM) + ((size_t)dir * 256 + b * 64) * 1024 + 128 * h,
                                    (const float*)(ws + WS_GL) + ((size_t)dir * 256 + b * 64) * 1024 + 128 * h, (bf16*)(ws + WS_OS) + ((size_t)dir * M + (size_t)b * SEQ) * 1024 + 128 * h, dir, (char*)lds_);
                if (PROBE_X2 == 2) att::hgrn_chunk_seq((const bf16*)(ws + WS_QH) + ((size_t)dir * M + (size_t)b * SEQ) * 1024 + 128 * h, (const bf16*)(ws + WS_KH) + ((size_t)dir * M + (size_t)b * SEQ) * 1024 + 128 * h,
                                    (const bf16*)(ws + WS_Z) + (size_t)b * SEQ * ZW + ZO_H + 3072 + 128 * h, ZW, (const float*)(ws + WS_GM) + ((size_t)dir * 256 + b * 64) * 1024 + 128 * h,
                                    (const float*)(ws + WS_GL) + ((size_t)dir * 256 + b * 64) * 1024 + 128 * h, (bf16*)(ws + WS_OS) + ((size_t)dir * M + (size_t)b * SEQ) * 1024 + 128 * h, dir, (char*)lds_); } }
            __syncthreads();
            {
                gu32* qh = ctl + CW_ATTQ + 64 * (l + 4 * rep_);
                const bf16* Q = (const bf16*)(ws + WS_Q); const bf16* KV = (const bf16*)(ws + WS_KV); const bf16* KR = (const bf16*)(ws + WS_KR); bf16* YC = (bf16*)(ws + WS_YC);
                for (;ON(21) && (rep_ == 0 || (DUP_SUB & 2));) {
                    if (tid == 0) MISC[16] = __hip_atomic_fetch_add(qh, 1u, RLX_AGENT);
                    __syncthreads(); const unsigned u = MISC[16]; __syncthreads();
                    if (u >= 512u) break;
                    const int bh = (int)(u >> 4), qb = (int)(u & 15), b = bh >> 3, h = bh & 7; const size_t row0 = (size_t)b * SEQ + (size_t)qb * 256, kr0 = (size_t)b * SEQ;
                    att::attn_dense_body(Q + row0 * 1536 + h * 192, KV + kr0 * 2048 + h * 256, KV + kr0 * 2048 + h * 256 + 128, KR + kr0 * 64, YC + row0 * 1024 + h * 128, SEQ, (char*)lds_);
                }
            }
            if (CVFILL && l + 1 < DEPTH && rep_ == 0) {
                const int l1 = l + 1; LayerW L; L.w_in = INF(I_WIN) + (size_t)l1 * 2048 * IN_W; L.w2 = INF(I_W2) + (size_t)l1 * 2 * 64 * 1024; L.a2 = INF(I_A2) + (size_t)l1 * 2 * 64 * 1024; L.g2 = INF(I_G2) + (size_t)l1 * 160 * 1024;
                L.uq = INF(I_UQ) + (size_t)l1 * 768 * 1536; L.ukv = INF(I_UKV) + (size_t)l1 * 512 * 2048; L.br = INF(I_BR) + (size_t)l1 * 3 * 1024 * 2048; L.wo = INF(I_WO) + (size_t)l1 * 2048 * 2048; L.w1 = INF(I_W1) + (size_t)l1 * 2048 * 8192; L.w2m = INF(I_W2M) + (size_t)l1 * 8192 * 2048; L.wpe = INF(I_WPE) + (size_t)l1 * 256 * 2048; L.wpg = INF(I_WPG) + (size_t)l1 * 2048 * 2048;
                gu32* qc = ctl + CW_CVQ + 64 * l;
                for (;;) {
                    if (tid == 0) MISC[16] = __hip_atomic_fetch_add(qc, 1u, RLX_AGENT);
                    __syncthreads(); const unsigned ch = MISC[16]; __syncthreads();
                    if (ch * 8u >= (unsigned)TR_EARLY) break;
                    { const TrItem T = tr_which(L, ws, (int)ch * 8 + wave); float v[32]; tr_load(T, v, lane); tr_store(T, v, (LAS float*)(lds + wave * 16384), lane); }
                }
            }
            if (rep_ < DUPK(4)) xcd_barrier(bar); else SEAM(pb + 4);
        }
        if (ON(5) && IN(pb + 5)) for (int rep_ = 0; rep_ < 1 + DUPK(5); ++rep_) {
            const int tid = tid_opaque(), lane = tid & 63; const size_t gt = (size_t)bx * 512 + tid, NGT = (size_t)G * 512; (void)lane; (void)gt; (void)NGT;
            PostP P; P.gnw = INF(I_GNW) + l * 1024; P.gnb = INF(I_GNB) + l * 1024; P.rk = INF(I_RK) + l * 1024; P.hng = INF(I_HNG) + l * 128; P.ka = INF(I_KA) + l * 1024;
            for (int m = gw; m < M; m += NGW) post_token((size_t)m, P, ws, lane);
            if (PROBE_X2 == 7) { for (int m = gw; m < M; m += NGW) post_token((size_t)m, P, ws, lane); }
            if (rep_ < DUPK(5)) xcd_barrier(bar); else SEAM(pb + 5);
        }
        if (ON(6) && IN(pb + 6)) for (int rep_ = 0; rep_ < 1 + DUPK(6); ++rep_) {
            const int tid = tid_opaque(), lane = tid & 63; const size_t gt = (size_t)bx * 512 + tid, NGT = (size_t)G * 512; (void)lane; (void)gt; (void)NGT;
            pg8::StaticOrder S; S.init(M, 2048, G, bx, WGM_O); const bf16* BR = (const bf16*)(ws + WS_BR);
            { pg8::Gemm g{(const bf16*)(ws + WS_YA), BR, M, 2048, 1024}; pg8::EpiBranch<0> E{Z, (float*)(ws + WS_MIX), (bf16*)(ws + WS_MIXED)}; pg8::gemm_phase<pg8::EpiBranch<0>, pg8::StaticOrder, true, true>(lds, g, S, E); }
            VM_WAIT(); __syncthreads();
            { pg8::Gemm g{(const bf16*)(ws + WS_YB), BR + (size_t)2048 * 1024, M, 2048, 1024}; pg8::EpiBranch<1> E{Z, (float*)(ws + WS_MIX), (bf16*)(ws + WS_MIXED)}; pg8::gemm_phase<pg8::EpiBranch<1>, pg8::StaticOrder, true, true>(lds, g, S, E); }
            VM_WAIT(); __syncthreads();
            { pg8::Gemm g{(const bf16*)(ws + WS_YC), BR + (size_t)2 * 2048 * 1024, M, 2048, 1024}; pg8::EpiBranch<2> E{Z, (float*)(ws + WS_MIX), (bf16*)(ws + WS_MIXED)}; pg8::gemm_phase<pg8::EpiBranch<2>, pg8::StaticOrder, true, true>(lds, g, S, E); }
            if (rep_ < DUPK(6)) xcd_barrier(bar); else SEAM(pb + 6);
        }
        if (ON(7) && IN(pb + 7)) for (int rep_ = 0; rep_ < 1 + DUPK(7); ++rep_) {
            const int tid = tid_opaque(), lane = tid & 63; const size_t gt = (size_t)bx * 512 + tid, NGT = (size_t)G * 512; (void)lane; (void)gt; (void)NGT;
            pg8::Gemm g{(const bf16*)(ws + WS_MIXED), (const bf16*)(ws + WS_WO), M, 2048, 2048}; pg8::StaticOrder S; S.init(M, 2048, G, bx, WGM_O, 1);
            pg8::EpiResid<2> E{H, XN, INF(I_LN2) + l * 2048, (float*)(ws + WS_SS) + (size_t)M * 32};
            pg8::gemm_phase<pg8::EpiResid<2>, pg8::StaticOrder, true, true>(lds, g, S, E);
            if (rep_ < DUPK(7)) xcd_barrier(bar); else SEAM(pb + 7);
        }
        if (ON(8) && IN(pb + 8)) for (int rep_ = 0; rep_ < 1 + DUPK(8); ++rep_) {
            const int tid = tid_opaque(), lane = tid & 63; const size_t gt = (size_t)bx * 512 + tid, NGT = (size_t)G * 512; (void)lane; (void)gt; (void)NGT;
            { const float* SSP = (const float*)(ws + WS_SS) + (size_t)M * 32; float* RSO = (float*)(ws + WS_RSTD) + M; for (int m0 = gw * 2 + (lane >> 5); m0 < M; m0 += NGW * 8) { float q4_[4];
#pragma unroll
              for (int i = 0; i < 4; ++i) { const int m = m0 + i * NGW * 2; q4_[i] = m < M ? SSP[(size_t)m * 32 + (lane & 31)] : 0.f; }
#pragma unroll
              for (int i = 0; i < 4; ++i) { const int m = m0 + i * NGW * 2; float q = q4_[i]; q += __shfl_xor(q, 1); q += __shfl_xor(q, 2); q += __shfl_xor(q, 4); q += __shfl_xor(q, 8); q += __shfl_xor(q, 16); if ((lane & 31) == 0 && m < M) RSO[m] = __builtin_amdgcn_rsqf(q * (1.0f / 2048.0f) + 1e-6f); } } }
            pg8::Gemm g{PB, (const bf16*)(ws + WS_WPE), M, 2048, 256}; pg8::StaticOrder S; S.init(M, 2048, G, bx, WGM_O);
            pg8::EpiB16<0> E{(bf16*)(ws + WS_PE), 2048, nullptr, nullptr};
            pg8::gemm_phase<pg8::EpiB16<0>, pg8::StaticOrder, true, true>(lds, g, S, E);
            if (rep_ < DUPK(8)) xcd_barrier(bar); else SEAM(pb + 8);
        }
        if (ON(9) && IN(pb + 9)) for (int rep_ = 0; rep_ < 1 + DUPK(9); ++rep_) {
            const int tid = tid_opaque(), lane = tid & 63; const size_t gt = (size_t)bx * 512 + tid, NGT = (size_t)G * 512; (void)lane; (void)gt; (void)NGT;
            pg8::Gemm g{XN, (const bf16*)(ws + WS_W1), M, DFF, 2048}; pg8::StaticOrder S; S.init(M, DFF, G, bx, WGM_M1);
            pg8::EpiB16<2> E{(bf16*)(ws + WS_HID), DFF, (const float*)(ws + WS_RSTD) + M, nullptr};
            pg8::gemm_phase<pg8::EpiB16<2>, pg8::StaticOrder, true, true>(lds, g, S, E);
            if (PROBE_X2 == 4) { __syncthreads(); pg8::gemm_phase<pg8::EpiB16<2>, pg8::StaticOrder, true, true>(lds, g, S, E); }
            if (rep_ < DUPK(9)) xcd_barrier(bar); else SEAM(pb + 9);
        }
        if (ON(10) && IN(pb + 10)) for (int rep_ = 0; rep_ < 1 + DUPK(10); ++rep_) {
            const int tid = tid_opaque(), lane = tid & 63; const size_t gt = (size_t)bx * 512 + tid, NGT = (size_t)G * 512; (void)lane; (void)gt; (void)NGT;
            pg8::Gemm g{(const bf16*)(ws + WS_HID), (const bf16*)(ws + WS_W2), M, 2048, DFF}; pg8::StaticOrder S; S.init(M, 2048, G, bx, WGM_M2, 1);
            pg8::EpiResid<1> E{H, (bf16*)(ws + WS_HB), nullptr, nullptr};
            pg8::gemm_phase<pg8::EpiResid<1>, pg8::StaticOrder, true, true>(lds, g, S, E);
            if (rep_ < DUPK(10)) xcd_barrier(bar); else SEAM(pb + 10);
        }
        if (ON(11) && IN(pb + 11)) for (int rep_ = 0; rep_ < 1 + DUPK(11); ++rep_) {
            const int tid = tid_opaque(), lane = tid & 63; const size_t gt = (size_t)bx * 512 + tid, NGT = (size_t)G * 512; (void)lane; (void)gt; (void)NGT;
            pg8::Gemm g{(const bf16*)(ws + WS_HB), (const bf16*)(ws + WS_WPG), M, 2048, 2048}; pg8::StaticOrder S; S.init(M, 2048, G, bx, WGM_O);
            pg8::EpiPG E{H, (const bf16*)(ws + WS_PE), XN, l + 1 < DEPTH ? INF(I_LN1) + (l + 1) * 2048 : INF(I_FG), (float*)(ws + WS_SS)};
            pg8::gemm_phase<pg8::EpiPG, pg8::StaticOrder, true, true>(lds, g, S, E);
            if (rep_ < DUPK(11)) xcd_barrier(bar); else SEAM(pb + 11);
        }
    }
    if (IN(NPHASES - 1)) {
        const int lane = tid_opaque() & 63;
        const float* SSf = (const float*)(ws + WS_SS);
        for (int m = gw; m < M; m += NGW) { float q = lane < 32 ? SSf[(size_t)m * 32 + lane] : 0.f; q = wave_sum(q); const float rstd = __builtin_amdgcn_rsqf(q * (1.0f / 2048.0f) + 1e-6f); f32x4* hr = (f32x4*)(H + (size_t)m * 2048) + lane;
#pragma unroll
            for (int j = 0; j < 8; ++j) hr[64 * j] = hr[64 * j] * rstd * ((const f32x4*)INF(I_FG))[64 * j + lane]; }
    }
#undef IN
#undef SEAM
}

extern "C" void kernel_launch(void* const* d_in, const int* in_sizes, int n_in, void* d_out, int out_size, void* d_ws, size_t ws_size, hipStream_t stream) {
    static int grid = 0;
    if (grid == 0) {
        if (n_in != 30 || out_size != M * DM || ws_size < WS_END) { fprintf(stderr, "kernel_launch: unexpected shapes: n_in %d out %d ws %zu (need %zu)\n", n_in, out_size, ws_size, (size_t)WS_END); grid = -1; return; }
        int dev = 0, cus = 0, per_cu = 0;
        if (hipGetDevice(&dev) != hipSuccess || hipDeviceGetAttribute(&cus, hipDeviceAttributeMultiprocessorCount, dev) != hipSuccess) { grid = -1; return; }
        if (hipFuncSetAttribute((const void*)fwd, hipFuncAttributeMaxDynamicSharedMemorySize, LDS_BYTES) != hipSuccess) { fprintf(stderr, "kernel_launch: hipFuncSetAttribute failed\n"); grid = -1; return; }
        if (hipOccupancyMaxActiveBlocksPerMultiprocessor(&per_cu, (const void*)fwd, NWAVES * 64, LDS_BYTES) != hipSuccess || per_cu < 1) fprintf(stderr, "kernel_launch: occupancy query reports %d blocks per CU\n", per_cu);
        (void)hipGetLastError();
        grid = cus;
        if (grid != 256) fprintf(stderr, "kernel_launch: %d CUs; the phase-4 role split assumes 256 workgroups\n", grid);
    }
    if (grid < 0) return;
    unsigned char* ws = (unsigned char*)d_ws;
    (void)hipMemsetAsync(ws + WS_CTL, 0, CTL_ZERO_BYTES, stream);
    Args a{};
    for (int i = 0; i < 30; ++i) a.in[i] = d_in[i];
    a.out = (float*)d_out; a.ws = ws;
    for (int li = 0; li < N_LAUNCHES; ++li) {
        if (N_LAUNCHES == 1) { a.ph_lo = 0; a.ph_hi = NPHASES; } else { a.ph_lo = li; a.ph_hi = li + 1; }
        hipLaunchKernelGGL(fwd, dim3(grid), dim3(NWAVES * 64), LDS_BYTES, stream, a);
        const hipError_t le = hipPeekAtLastError();
        if (le != hipSuccess) { fprintf(stderr, "kernel_launch: launch %d failed: %s\n", li, hipGetErrorName(le)); break; }
    }
}
```

```cpp
#include <hip/hip_runtime.h>
#include <cstdio>
#include <cstdint>
__device__ __forceinline__ int tid_opaque() { int t = threadIdx.x; asm volatile("" : "+v"(t)); return t; }

#ifndef MK_N_LAUNCHES
#define MK_N_LAUNCHES 1
#endif

constexpr int DM = 2048, NBATCH = 4, SEQ = 4096, DEPTH = 4, M = NBATCH * SEQ, BW = 1024;
constexpr int RWKV_W = 3488, IN_W = 16096, DFF = 8192, PLE = 256;
constexpr int ZW = 16384;
constexpr int ZO_A = 0, ZO_H = 3584, ZO_C = 8704, ZO_G = 10240;
constexpr int NPH_LAYER = 12, NPHASES = 2 + DEPTH * NPH_LAYER;

constexpr size_t MiB = 1u << 20;
constexpr size_t WS_CTL = 0, CTL_ZERO_BYTES = 1 * MiB;
constexpr size_t WS_COS = 1 * MiB, WS_SIN = 3 * MiB, WS_LB = 5 * MiB;
constexpr size_t WS_SS = 1402 * MiB, WS_RSTD = 1422 * MiB;
constexpr size_t WS_PB = 6 * MiB;
constexpr size_t WS_WIN = 14 * MiB, WS_LORA = 78 * MiB, WS_UQ = 83 * MiB, WS_UKV = 86 * MiB, WS_BR = 88 * MiB, WS_WO = 100 * MiB,
                 WS_W1 = 108 * MiB, WS_W2 = 140 * MiB, WS_WPE = 172 * MiB, WS_WPG = 173 * MiB;
constexpr size_t WS_XN = 182 * MiB;
constexpr size_t WS_ALORA = WS_XN, WS_CQN = WS_XN + 16 * MiB, WS_CKVN = WS_XN + 40 * MiB;
constexpr size_t WS_Z = 246 * MiB;
constexpr size_t WS_HID = WS_Z, WS_HB = WS_Z + 256 * MiB, WS_PE = WS_Z + 320 * MiB;
constexpr size_t WS_SCAN = 758 * MiB;
constexpr size_t WS_R = WS_SCAN, WS_KAP = WS_SCAN + 64 * MiB, WS_W = WS_SCAN + 128 * MiB, WS_A = WS_SCAN + 256 * MiB;
constexpr size_t WS_MIX = WS_SCAN, WS_MIXED = WS_SCAN + 128 * MiB;
constexpr size_t WS_QH = 1270 * MiB, WS_KH = 1334 * MiB, WS_GM = 1398 * MiB, WS_GL = 1400 * MiB;
constexpr size_t WS_KS = 1462 * MiB, WS_G = 1526 * MiB;
constexpr size_t WS_V = 1832 * MiB;
constexpr size_t WS_Q = 1558 * MiB, WS_KV = 1606 * MiB, WS_KR = 1670 * MiB;
constexpr size_t WS_YA = WS_Q, WS_YB = WS_Q + 32 * MiB;
constexpr size_t WS_YC = 1672 * MiB;
constexpr size_t WS_YS = 1704 * MiB, WS_OS = 1768 * MiB;
constexpr size_t WS_END = 1896 * MiB;
constexpr int CW_BAR = 4096, CW_ATTQ = 8192, CW_CVQ = 12288;

namespace pg8 {
#define PG8_LAS __attribute__((address_space(3)))
typedef unsigned short bf16_t;
typedef short bf16x8 __attribute__((ext_vector_type(8)));
typedef float f32x4 __attribute__((ext_vector_type(4)));
typedef unsigned u32x4 __attribute__((ext_vector_type(4)));
constexpr int BM = 256, BK = 64, HALF = 128, HTB = HALF * BK * 2  , STAGE_BYTES = 8 * HTB, NXCD = 8, WGM = 4;

__host__ __device__ __forceinline__ int lds_byte(int r, int c) { const int st = (r >> 4) * 2 + (c >> 5), rr = r & 15, cc = c & 31, ob = rr * 64 + cc * 2; return st * 1024 + (ob ^ (((ob >> 9) & 1) << 5)); }
__host__ __device__ __forceinline__ void stage_rc(int b, int& R, int& C) { const int st = b / 1024, sb = b % 1024, swz = sb ^ (((sb >> 9) & 1) << 5); R = (st >> 1) * 16 + swz / 64; C = (st & 1) * 32 + (swz % 64) / 2; }
__host__ __device__ __forceinline__ int perm32(int rho) { const int n = rho >> 4, i = rho & 15; return 8 * (i >> 2) + 4 * n + (i & 3); }

struct Unit { int pm, pn; };
struct Gemm { const bf16_t* A; const bf16_t* Bt; int M, N, K; };

struct StaticOrder {
    int nM, nN, nwg, G, c, wgm, rev;
    __host__ __device__ void init(int M, int N, int G_, int c_, int wgm_ = WGM, int rev_ = 0) { nM = M / BM; nN = N / BM; nwg = nM * nN; G = G_; c = c_; wgm = wgm_; rev = rev_; }
    __host__ __device__ bool next(int i, Unit& u) const {
        if (rev) { const int per = (nwg - c + G - 1) / G; if (i >= per) return false; i = per - 1 - i; }
        const long L = (long)i * G + c; if (L >= nwg) return false;
        int wgid = (int)L; { const int q = nwg / NXCD, r = nwg % NXCD, xcd = wgid % NXCD, off = wgid / NXCD; wgid = (xcd < r ? xcd * (q + 1) : r * (q + 1) + (xcd - r) * q) + off; }
        const int nig = wgm * nN, gid = wgid / nig, fm = gid * wgm, gsz = (nM - fm) < wgm ? (nM - fm) : wgm;
        u.pm = fm + ((wgid % nig) % gsz); u.pn = (wgid % nig) / gsz; return true;
    }
    __device__ __forceinline__ void a_ready(const Unit&) const {}
    __device__ __forceinline__ void done(const Unit&) const {}
};

typedef float cvt_f32x2 __attribute__((ext_vector_type(2))); typedef __bf16 cvt_bf16x2 __attribute__((ext_vector_type(2))); typedef _Float16 cvt_h16x2 __attribute__((ext_vector_type(2)));
__device__ __forceinline__ unsigned cvt_pk_bf16(float lo, float hi) { const cvt_f32x2 v = {lo, hi}; return __builtin_bit_cast(unsigned, __builtin_convertvector(v, cvt_bf16x2)); }
typedef float f32x2 __attribute__((ext_vector_type(2)));
typedef unsigned u32x2 __attribute__((ext_vector_type(2)));
__device__ __forceinline__ float sigm(float x) { return __builtin_amdgcn_rcpf(1.0f + __expf(-x)); }
__device__ __forceinline__ f32x4 sigm4(f32x4 v) { f32x4 o; o[0] = sigm(v[0]); o[1] = sigm(v[1]); o[2] = sigm(v[2]); o[3] = sigm(v[3]); return o; }
__device__ __forceinline__ f32x4 bf4_to_f32(u32x2 w) { f32x4 o; o[0] = __uint_as_float(w.x << 16); o[1] = __uint_as_float(w.x & 0xffff0000u); o[2] = __uint_as_float(w.y << 16); o[3] = __uint_as_float(w.y & 0xffff0000u); return o; }
__device__ __forceinline__ u32x2 f32_to_bf4(f32x4 v) { u32x2 w; w.x = cvt_pk_bf16(v[0], v[1]); w.y = cvt_pk_bf16(v[2], v[3]); return w; }
#define EPI_ROWS(ai, m) _Pragma("unroll") for (int ai = 0; ai < 2; ++ai) _Pragma("unroll") for (int m = 0; m < 4; ++m)
#define EPI_COLS(bj, n) _Pragma("unroll") for (int bj = 0; bj < 2; ++bj) _Pragma("unroll") for (int n = 0; n < 2; ++n)

template <int MODE> struct EpiB16 {
    static constexpr bool PERM = true, AFTER_DRAIN = false;
    bf16_t* O; int ldc; const float* COS; const float* SIN;
    __device__ __forceinline__ void operator()(const f32x4 (&acc)[2][2][4][2], const Unit& u, int wr, int wc, int fr, int fq) const {
        const int row0 = u.pm * BM + wr * 64 + fr, col0 = u.pn * BM + wc * 32 + 8 * fq;
        float rs[2][4];
        if (MODE == 1 || MODE == 2) { EPI_ROWS(ai, m) rs[ai][m] = COS[row0 + ai * HALF + m * 16]; }
        EPI_ROWS(ai, m) { const int row = row0 + ai * HALF + m * 16; bf16_t* rowp = O + (size_t)row * ldc + col0;
            float rstd = 1.f; if (MODE == 1 || MODE == 2) rstd = rs[ai][m];
#pragma unroll
            for (int bj = 0; bj < 2; ++bj) { f32x4 v0 = acc[ai][bj][m][0], v1 = acc[ai][bj][m][1];
                if (MODE == 1) { v0 = v0 * rstd; v1 = v1 * rstd; if (u.pn >= 40) { v0 = sigm4(v0); v1 = sigm4(v1); } }
                if (MODE == 2) {
#pragma unroll
                    for (int j = 0; j < 4; ++j) { const float a = fmaxf(v0[j], 0.f) * rstd, b = fmaxf(v1[j], 0.f) * rstd; v0[j] = a * a; v1[j] = b * b; } }
                if (MODE == 3) { const int j192 = (col0 + bj * HALF) % 192;
                    if (j192 >= 128) { const int i0 = (j192 - 128) >> 1; const f32x4 c = *(const f32x4*)(COS + (size_t)row * 32 + i0), s = *(const f32x4*)(SIN + (size_t)row * 32 + i0);
                        f32x4 a, b; a[0] = v0[0] * c[0] - v0[1] * s[0]; a[1] = v0[1] * c[0] + v0[0] * s[0]; a[2] = v0[2] * c[1] - v0[3] * s[1]; a[3] = v0[3] * c[1] + v0[2] * s[1];
                        b[0] = v1[0] * c[2] - v1[1] * s[2]; b[1] = v1[1] * c[2] + v1[0] * s[2]; b[2] = v1[2] * c[3] - v1[3] * s[3]; b[3] = v1[3] * c[3] + v1[2] * s[3]; v0 = a; v1 = b; } }
                u32x4 w; w.x = cvt_pk_bf16(v0[0], v0[1]); w.y = cvt_pk_bf16(v0[2], v0[3]); w.z = cvt_pk_bf16(v1[0], v1[1]); w.w = cvt_pk_bf16(v1[2], v1[3]);
                if (MODE == 1) __builtin_nontemporal_store(w, (u32x4*)(rowp + bj * HALF)); else *(u32x4*)(rowp + bj * HALF) = w; } }
    }
};
struct EpiLora {
    static constexpr bool PERM = false, AFTER_DRAIN = false;
    const float* w0; const float* a0;
    unsigned short* W; bf16_t* A; bf16_t* G; int pn_off;
    __device__ __forceinline__ void operator()(const f32x4 (&acc)[2][2][4][2], const Unit& u, int wr, int wc, int fr, int fq) const {
        const int pn = u.pn + pn_off; const int row0 = u.pm * BM + wr * 64 + fr, cc0 = (pn & 3) * BM + wc * 32 + 4 * fq;
        if (pn < 8) { const int dir = pn >> 2; f32x4 wv[2][2];
            EPI_COLS(bj, n) wv[bj][n] = *(const f32x4*)(w0 + dir * 1024 + cc0 + bj * HALF + n * 16);
            EPI_ROWS(ai, m) { unsigned short* rowp = W + ((size_t)dir * M + row0 + ai * HALF + m * 16) * 1024 + cc0;
                EPI_COLS(bj, n) { const f32x4 s = sigm4(wv[bj][n] + acc[ai][bj][m][n]); f32x4 o;
#pragma unroll
                    for (int j = 0; j < 4; ++j) o[j] = __expf(-0.606531f * s[j]);
                    const cvt_f32x2 oa = {o[0], o[1]}, ob = {o[2], o[3]}; u32x2 wv_; wv_.x = __builtin_bit_cast(unsigned, __builtin_convertvector(oa, cvt_h16x2)); wv_.y = __builtin_bit_cast(unsigned, __builtin_convertvector(ob, cvt_h16x2));
                    *(u32x2*)(rowp + bj * HALF + n * 16) = wv_; } }
        } else if (pn < 16) { const int dir = (pn - 8) >> 2; f32x4 av[2][2];
            EPI_COLS(bj, n) av[bj][n] = *(const f32x4*)(a0 + dir * 1024 + cc0 + bj * HALF + n * 16);
            EPI_ROWS(ai, m) { bf16_t* rowp = A + ((size_t)dir * M + row0 + ai * HALF + m * 16) * 1024 + cc0;
                EPI_COLS(bj, n) *(u32x2*)(rowp + bj * HALF + n * 16) = f32_to_bf4(sigm4(av[bj][n] + acc[ai][bj][m][n])); }
        } else {
            EPI_ROWS(ai, m) { bf16_t* rowp = G + (size_t)(row0 + ai * HALF + m * 16) * 1024 + cc0;
                EPI_COLS(bj, n) *(u32x2*)(rowp + bj * HALF + n * 16) = f32_to_bf4(acc[ai][bj][m][n]); }
        }
    }
};
template <int NB> struct EpiBranch {
    static constexpr bool PERM = false, AFTER_DRAIN = false;
    const bf16_t* Z; float* MIX; bf16_t* MIXED;
    __device__ __forceinline__ void operator()(const f32x4 (&acc)[2][2][4][2], const Unit& u, int wr, int wc, int fr, int fq) const {
        const int row0 = u.pm * BM + wr * 64 + fr, col0 = u.pn * BM + wc * 32 + 4 * fq;
#pragma unroll
        for (int ai = 0; ai < 2; ++ai)
#pragma unroll
            for (int mh = 0; mh < 2; ++mh) { u32x2 gq[2][2][2]; f32x4 mq[2][2][2];
#pragma unroll
                for (int e = 0; e < 2; ++e) { const size_t row = (size_t)(row0 + ai * HALF + (2 * mh + e) * 16); const bf16_t* gp = Z + row * 16384 + 10240 + NB * 2048 + col0; const float* mp = MIX + row * 2048 + col0;
                    EPI_COLS(bj, n) { const int co = bj * HALF + n * 16; gq[e][bj][n] = *(const u32x2*)(gp + co); if (NB >= 1) mq[e][bj][n] = *(const f32x4*)(mp + co); } }
#pragma unroll
                for (int e = 0; e < 2; ++e) { const int m = 2 * mh + e; const size_t row = (size_t)(row0 + ai * HALF + m * 16); float* mp = MIX + row * 2048 + col0;
                    EPI_COLS(bj, n) { const int co = bj * HALF + n * 16; f32x4 v = bf4_to_f32(gq[e][bj][n]) * acc[ai][bj][m][n];
                        if (NB >= 1) v += mq[e][bj][n];
                        if (NB < 2) *(f32x4*)(mp + co) = v; else *(u32x2*)(MIXED + row * 2048 + col0 + co) = f32_to_bf4(v); } } }
    }
};
__device__ __forceinline__ void norm_feed(const f32x4 (&h)[2][2], const float* g, bf16_t* xn, float* ss, int fq) {
    float q = 0.f;
    EPI_COLS(bj, n) { const f32x4 v = h[bj][n]; q += (v[0] * v[0] + v[1] * v[1]) + (v[2] * v[2] + v[3] * v[3]);
        *(u32x2*)(xn + bj * HALF + n * 16) = f32_to_bf4(v * *(const f32x4*)(g + bj * HALF + n * 16)); }
    q += __shfl_xor(q, 16); q += __shfl_xor(q, 32);
    if (fq == 0) *ss = q;
}
template <int MODE> struct EpiResid {
    static constexpr bool PERM = false, AFTER_DRAIN = false;
    float* H; bf16_t* HB; const float* G; float* SS;
    __device__ __forceinline__ void operator()(const f32x4 (&acc)[2][2][4][2], const Unit& u, int wr, int wc, int fr, int fq) const {
        const int row0 = u.pm * BM + wr * 64 + fr, col0 = u.pn * BM + wc * 32 + 4 * fq;
#pragma unroll
        for (int ai = 0; ai < 2; ++ai)
#pragma unroll
            for (int mp = 0; mp < 2; ++mp) { f32x4 hv[2][2][2];
#pragma unroll
                for (int e = 0; e < 2; ++e) { const size_t ro = (size_t)(row0 + ai * HALF + (2 * mp + e) * 16) * 2048 + col0; EPI_COLS(bj, n) hv[e][bj][n] = *(const f32x4*)(H + ro + bj * HALF + n * 16); }
#pragma unroll
                for (int e = 0; e < 2; ++e) { const int m = 2 * mp + e, row = row0 + ai * HALF + m * 16; const size_t ro = (size_t)row * 2048 + col0;
                    EPI_COLS(bj, n) { const int co = bj * HALF + n * 16; const f32x4 v = hv[e][bj][n] + acc[ai][bj][m][n]; *(f32x4*)(H + ro + co) = v; hv[e][bj][n] = v;
                        if (MODE == 1) *(u32x2*)(HB + ro + co) = f32_to_bf4(v); }
                    if (MODE == 2) norm_feed(hv[e], G + col0, HB + ro, SS + (size_t)row * 32 + u.pn * 4 + wc, fq); } }
    }
};
struct EpiPG {
    static constexpr bool PERM = false, AFTER_DRAIN = false;
    float* H; const bf16_t* PE; bf16_t* XN; const float* G; float* SS;
    __device__ __forceinline__ void operator()(const f32x4 (&acc)[2][2][4][2], const Unit& u, int wr, int wc, int fr, int fq) const {
        const int row0 = u.pm * BM + wr * 64 + fr, col0 = u.pn * BM + wc * 32 + 4 * fq;
#pragma unroll
        for (int ai = 0; ai < 2; ++ai)
#pragma unroll
            for (int mp = 0; mp < 2; ++mp) { f32x4 hv[2][2][2]; u32x2 pq_[2][2][2];
#pragma unroll
                for (int e = 0; e < 2; ++e) { const size_t ro = (size_t)(row0 + ai * HALF + (2 * mp + e) * 16) * 2048 + col0; EPI_COLS(bj, n) { const int co = bj * HALF + n * 16; pq_[e][bj][n] = *(const u32x2*)(PE + ro + co); hv[e][bj][n] = *(const f32x4*)(H + ro + co); } }
#pragma unroll
                for (int e = 0; e < 2; ++e) { const int m = 2 * mp + e, row = row0 + ai * HALF + m * 16; const size_t ro = (size_t)row * 2048 + col0;
                    EPI_COLS(bj, n) { const int co = bj * HALF + n * 16; const f32x4 v = hv[e][bj][n] + sigm4(acc[ai][bj][m][n]) * bf4_to_f32(pq_[e][bj][n]); *(f32x4*)(H + ro + co) = v; hv[e][bj][n] = v; }
                    norm_feed(hv[e], G + col0, XN + ro, SS + (size_t)row * 32 + u.pn * 4 + wc, fq); } }
    }
};

template <class Epi, class Sched, bool ALIGN_EPI = false, bool SP2 = false>
__device__ __forceinline__ void gemm_phase(PG8_LAS unsigned char* lds, const Gemm g, const Sched& S, const Epi& E) {
    const int tid = tid_opaque(), wid = __builtin_amdgcn_readfirstlane(tid >> 6), lane = tid & 63, wr = wid >> 2, wc = wid & 3, fr = lane & 15, fq = lane >> 4;
    int K_ = g.K; asm volatile("" : "+s"(K_)); const int K = K_, nt = K / BK;
    unsigned voffA[2], voffB[2];
#pragma unroll
    for (int i = 0; i < 2; ++i) { int R, C; stage_rc(tid * 16 + i * 8192, R, C); const int Rb = Epi::PERM ? ((R & ~31) + perm32(R & 31)) : R;
        voffA[i] = (unsigned)(R * K + C) * 2u; voffB[i] = (unsigned)(Rb * K + C) * 2u; }
    const size_t kstep = (size_t)(BK * 2);
    const size_t hstep = (size_t)HALF * K * 2;
    const size_t tstep = 2 * hstep;
    const unsigned ldsw = (unsigned)wid * 1024u;
    const int aoff = lds_byte(wr * 64 + fr, fq * 8), boff = lds_byte(wc * 32 + fr, fq * 8);
#define PG8_SA(b, h) (((b) * 2 + (h)) * HTB)
#define PG8_SB(b, h) ((4 + (b) * 2 + (h)) * HTB)
#define PG8_STAGE(bufoff, gbase, voff) do { _Pragma("unroll") for (int _i = 0; _i < 2; ++_i) \
        __builtin_amdgcn_global_load_lds((const unsigned*)((const char*)(gbase) + (voff)[_i]), (PG8_LAS unsigned*)(lds + (bufoff) + ldsw + _i * 8192), 16, 0, 0); } while (0)
#define PG8_LDA(dst, b, h) do { _Pragma("unroll") for (int m = 0; m < 4; ++m) _Pragma("unroll") for (int k = 0; k < 2; ++k) dst[m][k] = *(const PG8_LAS bf16x8*)(lds + PG8_SA(b, h) + aoff + m * 2048 + k * 1024); } while (0)
#define PG8_LDB(dst, b, h) do { _Pragma("unroll") for (int n = 0; n < 2; ++n) _Pragma("unroll") for (int k = 0; k < 2; ++k) dst[n][k] = *(const PG8_LAS bf16x8*)(lds + PG8_SB(b, h) + boff + n * 2048 + k * 1024); } while (0)
#define PG8_MMA(ai, bj, At, Bt) do { __builtin_amdgcn_s_setprio(1); _Pragma("unroll") for (int m = 0; m < 4; ++m) _Pragma("unroll") for (int n = 0; n < 2; ++n) _Pragma("unroll") for (int k = 0; k < 2; ++k) \
        acc[ai][bj][m][n] = __builtin_amdgcn_mfma_f32_16x16x32_bf16(Bt[n][k], At[m][k], acc[ai][bj][m][n], 0, 0, 0); __builtin_amdgcn_s_setprio(0); } while (0)
#define PG8_WAIT_V(n) asm volatile("s_waitcnt vmcnt(" #n ")" ::: "memory")
#define PG8_WAIT_L(n) asm volatile("s_waitcnt lgkmcnt(" #n ")" ::: "memory")
#define PG8_BAR __builtin_amdgcn_s_barrier()
#define PG8_SCHED __builtin_amdgcn_sched_barrier(0)
    Unit cur, nxt; int ui = 0;
    if (!S.next(0, cur)) return;
    f32x4 acc[2][2][4][2];
#pragma unroll
    for (int a = 0; a < 2; ++a)
#pragma unroll
        for (int b = 0; b < 2; ++b)
#pragma unroll
            for (int m = 0; m < 4; ++m)
#pragma unroll
                for (int n = 0; n < 2; ++n) acc[a][b][m][n] = (f32x4){0.f, 0.f, 0.f, 0.f};
    bf16x8 At[4][2], B0[2][2], B1[2][2];
    const char* cA = (const char*)g.A + (size_t)cur.pm * tstep; const char* cB = (const char*)g.Bt + (size_t)cur.pn * tstep;
    S.a_ready(cur);
    if constexpr (SP2) {
        PG8_STAGE(PG8_SB(0, 0), cB, voffB); PG8_STAGE(PG8_SB(0, 1), cB + hstep, voffB); PG8_STAGE(PG8_SA(0, 0), cA, voffA); PG8_STAGE(PG8_SA(0, 1), cA + hstep, voffA);
        if (wr == 1) PG8_BAR;
        PG8_WAIT_V(2); PG8_BAR;
        PG8_STAGE(PG8_SB(1, 0), cB + kstep, voffB); PG8_STAGE(PG8_SA(1, 0), cA + kstep, voffA); PG8_STAGE(PG8_SB(1, 1), cB + hstep + kstep, voffB);
        PG8_WAIT_V(6); PG8_BAR;
    } else {
        PG8_STAGE(PG8_SB(0, 0), cB, voffB); PG8_STAGE(PG8_SA(0, 0), cA, voffA); PG8_STAGE(PG8_SB(0, 1), cB + hstep, voffB); PG8_STAGE(PG8_SA(0, 1), cA + hstep, voffA);
        if (wr == 1) PG8_BAR;
        PG8_WAIT_V(4); PG8_BAR;
        PG8_STAGE(PG8_SB(1, 0), cB + kstep, voffB); PG8_STAGE(PG8_SA(1, 0), cA + kstep, voffA); PG8_STAGE(PG8_SB(1, 1), cB + hstep + kstep, voffB);
        PG8_WAIT_V(6); PG8_BAR;
    }
    for (;;) {
        const bool has_next = S.next(ui + 1, nxt);
        const char* nA = has_next ? (const char*)g.A + (size_t)nxt.pm * tstep : cA; const char* nB = has_next ? (const char*)g.Bt + (size_t)nxt.pn * tstep : cB;
        for (int t = 0; t < nt; t += 2) {
            const bool last = (t == nt - 2);
            const char* a1 = cA + (size_t)(t + 1) * kstep;
            const char* a2 = last ? nA : cA + (size_t)(t + 2) * kstep; const char* b2 = last ? nB : cB + (size_t)(t + 2) * kstep;
            const char* a3 = a2 + kstep; const char* b3 = b2 + kstep;
            if (last && has_next) S.a_ready(nxt);
            if constexpr (SP2) {
            PG8_LDB(B0, 0, 0); PG8_LDB(B1, 0, 1); PG8_SCHED; PG8_LDA(At, 0, 0); PG8_STAGE(PG8_SA(1, 1), a1 + hstep, voffA);
            PG8_WAIT_V(8); PG8_WAIT_L(0); PG8_BAR; PG8_MMA(0, 0, At, B0); PG8_MMA(0, 1, At, B1); PG8_BAR; PG8_SCHED;
            PG8_LDA(At, 0, 1); PG8_STAGE(PG8_SB(0, 0), b2, voffB); PG8_STAGE(PG8_SB(0, 1), b2 + hstep, voffB); PG8_STAGE(PG8_SA(0, 0), a2, voffA);
            PG8_WAIT_V(8); PG8_WAIT_L(0); PG8_BAR; PG8_MMA(1, 0, At, B0); PG8_MMA(1, 1, At, B1); PG8_BAR; PG8_SCHED;
            PG8_LDB(B0, 1, 0); PG8_LDB(B1, 1, 1); PG8_SCHED; PG8_LDA(At, 1, 0); PG8_STAGE(PG8_SA(0, 1), a2 + hstep, voffA);
            PG8_WAIT_V(8); PG8_WAIT_L(0); PG8_BAR; PG8_MMA(0, 0, At, B0); PG8_MMA(0, 1, At, B1); PG8_BAR; PG8_SCHED;
            PG8_LDA(At, 1, 1); PG8_STAGE(PG8_SB(1, 0), b3, voffB); PG8_STAGE(PG8_SB(1, 1), b3 + hstep, voffB); PG8_STAGE(PG8_SA(1, 0), a3, voffA);
            PG8_WAIT_V(8); PG8_WAIT_L(0); PG8_BAR; PG8_MMA(1, 0, At, B0); PG8_MMA(1, 1, At, B1); PG8_BAR; PG8_SCHED;
            } else {
            PG8_LDB(B0, 0, 0); PG8_SCHED; PG8_LDA(At, 0, 0); PG8_STAGE(PG8_SA(1, 1), a1 + hstep, voffA);
            PG8_WAIT_L(8); PG8_BAR; PG8_WAIT_L(0); PG8_MMA(0, 0, At, B0); PG8_BAR; PG8_SCHED;
            PG8_LDB(B1, 0, 1); PG8_STAGE(PG8_SB(0, 0), b2, voffB);
            PG8_BAR; PG8_WAIT_L(0); PG8_MMA(0, 1, At, B1); PG8_BAR;
            PG8_LDA(At, 0, 1); PG8_STAGE(PG8_SA(0, 0), a2, voffA);
            PG8_BAR; PG8_WAIT_L(0); PG8_MMA(1, 0, At, B0); PG8_BAR; PG8_SCHED;
            PG8_STAGE(PG8_SB(0, 1), b2 + hstep, voffB);
            PG8_WAIT_V(6); PG8_BAR; PG8_MMA(1, 1, At, B1); PG8_BAR;
            PG8_LDB(B0, 1, 0); PG8_SCHED; PG8_LDA(At, 1, 0); PG8_STAGE(PG8_SA(0, 1), a2 + hstep, voffA);
            PG8_WAIT_L(8); PG8_BAR; PG8_WAIT_L(0); PG8_MMA(0, 0, At, B0); PG8_BAR; PG8_SCHED;
            PG8_LDB(B1, 1, 1); PG8_STAGE(PG8_SB(1, 0), b3, voffB);
            PG8_BAR; PG8_WAIT_L(0); PG8_MMA(0, 1, At, B1); PG8_BAR;
            PG8_LDA(At, 1, 1); PG8_STAGE(PG8_SA(1, 0), a3, voffA);
            PG8_BAR; PG8_WAIT_L(0); PG8_MMA(1, 0, At, B0); PG8_BAR; PG8_SCHED;
            PG8_STAGE(PG8_SB(1, 1), b3 + hstep, voffB);
            PG8_WAIT_V(6); PG8_BAR; PG8_MMA(1, 1, At, B1); PG8_BAR;
            }
        }
        if constexpr (ALIGN_EPI) { if (wr == 0) PG8_BAR; }
        if constexpr (!Epi::AFTER_DRAIN) { E(acc, cur, wr, wc, fr, fq); S.done(cur); }
        if (!has_next) break;
#pragma unroll
        for (int a = 0; a < 2; ++a)
#pragma unroll
            for (int b = 0; b < 2; ++b)
#pragma unroll
                for (int m = 0; m < 4; ++m)
#pragma unroll
                    for (int n = 0; n < 2; ++n) acc[a][b][m][n] = (f32x4){0.f, 0.f, 0.f, 0.f};
        cur = nxt; cA = nA; cB = nB; ++ui;
        if constexpr (ALIGN_EPI) { if (wr == 1) PG8_BAR; }
    }
    PG8_WAIT_V(0);
    if constexpr (!ALIGN_EPI) { if (wr == 0) PG8_BAR; }
    PG8_BAR;
    if constexpr (Epi::AFTER_DRAIN) { E.fused(acc, cur, wr, wc, fr, fq, lds, wid, lane); S.done(cur); }
#undef PG8_SA
#undef PG8_SB
#undef PG8_STAGE
#undef PG8_LDA
#undef PG8_LDB
#undef PG8_MMA
#undef PG8_WAIT_V
#undef PG8_WAIT_L
#undef PG8_BAR
#undef PG8_SCHED
}
}
namespace att {
using bf16x8 = __attribute__((ext_vector_type(8))) short;
using s16x4  = __attribute__((ext_vector_type(4))) short;
using f32x16 = __attribute__((ext_vector_type(16))) float;
using u32x4  = __attribute__((ext_vector_type(4))) unsigned;
constexpr int NW = 8, QBLK = 32, KVBLK = 64;
constexpr float SCALE = 0.07216878364870322f;
constexpr float THR = 8.f;
constexpr int LDQ = 1536, LDK = 2048, LDR = 64, LDO = 1024;
constexpr size_t SHM_V = KVBLK * 128 * 2, SHM_K = KVBLK * 128 * 2, SHM_R = KVBLK * 64 * 2, SHM_QR = NW * 4096, SHM_ATTN = 2 * SHM_V + 2 * SHM_K + 2 * SHM_R + NW * 64 * 4 + SHM_QR;
#define KSWZ(row, colB) ((row) * 256 + ((colB) ^ (((row) & 7) << 4)))
#define RSWZ(row, colB) ((row) * 128 + ((colB) ^ (((row) & 7) << 4)))
#define SBAR() __builtin_amdgcn_sched_barrier(0)
__device__ __forceinline__ int crow(int r, int hi) { return (r & 3) + 8 * (r >> 2) + 4 * hi; }
__device__ __forceinline__ unsigned cvtpk(float lo, float hi) { return pg8::cvt_pk_bf16(lo, hi); }
__device__ __forceinline__ bf16x8 ld8(const unsigned short* p) { return *reinterpret_cast<const bf16x8*>(p); }
__device__ __forceinline__ unsigned bfr(float f) { return pg8::cvt_pk_bf16(f, 0.f) & 0xffffu; }
__device__ __forceinline__ unsigned bfpk(float lo, float hi) { return pg8::cvt_pk_bf16(lo, hi); }

__device__ __forceinline__ void partialSM(f32x16& p0, f32x16& p1, float& m_reg, float& mn, float& alpha) {
  constexpr float C = SCALE * 1.4426950408889634f;
  float pmax = p0[0];
#pragma unroll
  for (int r = 1; r < 16; ++r) pmax = fmaxf(pmax, p0[r]);
#pragma unroll
  for (int r = 0; r < 16; ++r) pmax = fmaxf(pmax, p1[r]);
  { auto rr = __builtin_amdgcn_permlane32_swap(__float_as_uint(pmax), __float_as_uint(pmax), false, false);
    pmax = fmaxf(__uint_as_float(rr[0]), __uint_as_float(rr[1])); }
  if (__builtin_expect(__all(pmax - m_reg <= THR / SCALE), 1)) { mn = m_reg; alpha = 1.f; }
  else { mn = fmaxf(m_reg, pmax); alpha = __builtin_amdgcn_exp2f((m_reg - mn) * C); m_reg = mn; }
  float mnC = -mn * C;
#pragma unroll
  for (int r = 0; r < 16; ++r) p0[r] = fmaf(p0[r], C, mnC);
#pragma unroll
  for (int r = 0; r < 16; ++r) p1[r] = fmaf(p1[r], C, mnC);
#pragma unroll
  for (int r = 0; r < 16; ++r) p0[r] = __builtin_amdgcn_exp2f(p0[r]);
}
__device__ __forceinline__ void finishSM(f32x16& p0, f32x16& p1, float alpha, float& l_reg, bf16x8& pa0, bf16x8& pa1, bf16x8& pa2, bf16x8& pa3) {
#pragma unroll
  for (int r = 0; r < 16; ++r) p1[r] = __builtin_amdgcn_exp2f(p1[r]);
  float ps = 0;
#pragma unroll
  for (int r = 0; r < 16; ++r) ps += p0[r];
#pragma unroll
  for (int r = 0; r < 16; ++r) ps += p1[r];
  { auto rr = __builtin_amdgcn_permlane32_swap(__float_as_uint(ps), __float_as_uint(ps), false, false);
    ps = __uint_as_float(rr[0]) + __uint_as_float(rr[1]); }
  l_reg = l_reg * alpha + ps;
#define PK4(P, BASE, OUT) do { unsigned a0 = cvtpk(P[BASE + 0], P[BASE + 1]), a1 = cvtpk(P[BASE + 2], P[BASE + 3]);   \
    unsigned b0 = cvtpk(P[BASE + 4], P[BASE + 5]), b1 = cvtpk(P[BASE + 6], P[BASE + 7]);                              \
    auto r0 = __builtin_amdgcn_permlane32_swap(a0, b0, false, false); auto r1 = __builtin_amdgcn_permlane32_swap(a1, b1, false, false); \
    u32x4 w = {r0[0], r1[0], r0[1], r1[1]}; OUT = *reinterpret_cast<bf16x8*>(&w); } while (0)
  PK4(p0, 0, pa0); PK4(p0, 8, pa1); PK4(p1, 0, pa2); PK4(p1, 8, pa3);
#undef PK4
}
__device__ __forceinline__ void qkt(f32x16& p0, f32x16& p1, const char* Ks, const char* Rs, const bf16x8* qr, const char* qrl, int r32, int hi) {
  p0 = f32x16{}; p1 = f32x16{};
#pragma unroll
  for (int d0 = 0; d0 < 8; ++d0) { int cb = (d0 * 16 + hi * 8) * 2;
    bf16x8 b0 = *reinterpret_cast<const bf16x8*>(Ks + KSWZ(r32, cb));
    bf16x8 b1 = *reinterpret_cast<const bf16x8*>(Ks + KSWZ(32 + r32, cb));
    p0 = __builtin_amdgcn_mfma_f32_32x32x16_bf16(b0, qr[d0], p0, 0, 0, 0);
    p1 = __builtin_amdgcn_mfma_f32_32x32x16_bf16(b1, qr[d0], p1, 0, 0, 0); }
#pragma unroll
  for (int d0 = 0; d0 < 4; ++d0) { int cb = (d0 * 16 + hi * 8) * 2;
    bf16x8 b0 = *reinterpret_cast<const bf16x8*>(Rs + RSWZ(r32, cb));
    bf16x8 b1 = *reinterpret_cast<const bf16x8*>(Rs + RSWZ(32 + r32, cb));
    const bf16x8 qv = *reinterpret_cast<const bf16x8*>(qrl + d0 * 1024);
    p0 = __builtin_amdgcn_mfma_f32_32x32x16_bf16(b0, qv, p0, 0, 0, 0);
    p1 = __builtin_amdgcn_mfma_f32_32x32x16_bf16(b1, qv, p1, 0, 0, 0); }
}
__device__ __forceinline__ int v_st(int k, int c) { const int kk = (k & ~0xC) | ((k & 4) << 1) | ((k & 8) >> 1); return ((kk >> 3) * 4 + (c >> 5)) * 512 + ((kk & 7) * 32 + (c & 31)) * 2; }
__device__ __forceinline__ int v_rd_base(int lane) { return ((lane & 3) << 3) | (((lane >> 2) & 3) << 6) | (((lane >> 4) & 1) << 5) | (((lane >> 5) & 1) << 8); }
constexpr int v_rd_off(int d0, int ks, int half) { return d0 * 512 + ks * 4096 + half * 2048; }
template <int OFF> __device__ __forceinline__ s16x4 tr_read(int vb) {
  s16x4 r; asm volatile("ds_read_b64_tr_b16 %0, %1 offset:%2" : "=&v"(r) : "v"(vb), "i"(OFF) : "memory"); return r;
}
template <int D0> __device__ __forceinline__ void pv_one(f32x16& od, int vb, bf16x8 pa0, bf16x8 pa1, bf16x8 pa2, bf16x8 pa3) {
  const s16x4 l0 = tr_read<v_rd_off(D0, 0, 0)>(vb), h0 = tr_read<v_rd_off(D0, 0, 1)>(vb), l1 = tr_read<v_rd_off(D0, 1, 0)>(vb), h1 = tr_read<v_rd_off(D0, 1, 1)>(vb);
  const s16x4 l2 = tr_read<v_rd_off(D0, 2, 0)>(vb), h2 = tr_read<v_rd_off(D0, 2, 1)>(vb), l3 = tr_read<v_rd_off(D0, 3, 0)>(vb), h3 = tr_read<v_rd_off(D0, 3, 1)>(vb);
  asm volatile("s_waitcnt lgkmcnt(0)" ::: "memory"); SBAR();
#define PK(L, H) (bf16x8){L[0], L[1], L[2], L[3], H[0], H[1], H[2], H[3]}
  od = __builtin_amdgcn_mfma_f32_32x32x16_bf16(pa0, PK(l0, h0), od, 0, 0, 0);
  od = __builtin_amdgcn_mfma_f32_32x32x16_bf16(pa1, PK(l1, h1), od, 0, 0, 0);
  od = __builtin_amdgcn_mfma_f32_32x32x16_bf16(pa2, PK(l2, h2), od, 0, 0, 0);
  od = __builtin_amdgcn_mfma_f32_32x32x16_bf16(pa3, PK(l3, h3), od, 0, 0, 0);
#undef PK
}
__device__ __forceinline__ void pv_d0(f32x16* o, int vb, bf16x8 pa0, bf16x8 pa1, bf16x8 pa2, bf16x8 pa3) {
  pv_one<0>(o[0], vb, pa0, pa1, pa2, pa3); pv_one<1>(o[1], vb, pa0, pa1, pa2, pa3); pv_one<2>(o[2], vb, pa0, pa1, pa2, pa3); pv_one<3>(o[3], vb, pa0, pa1, pa2, pa3);
}
__device__ __forceinline__ void attn_dense_body(const unsigned short* __restrict__ Qb, const unsigned short* __restrict__ Kh, const unsigned short* __restrict__ Vh,
                                                const unsigned short* __restrict__ Rh, unsigned short* __restrict__ Ob, int seq, char* lds) {
  const int tid = tid_opaque(), wid = tid >> 6, lane = tid & 63, r32 = lane & 31, hi = lane >> 5;
  char* V_lds = lds; char* K_lds = lds + 2 * SHM_V; char* R_lds = lds + 2 * SHM_V + 2 * SHM_K;
  float* ws = (float*)(lds + 2 * SHM_V + 2 * SHM_K + 2 * SHM_R) + wid * 64; float* li_l = ws; float* al_l = ws + 32;
  float m_reg = -1e30f, l_reg = 0; f32x16 o[4] = {}; bf16x8 qr[8]; char* qrl = lds + 2 * SHM_V + 2 * SHM_K + 2 * SHM_R + NW * 64 * 4 + wid * 4096 + lane * 16;
  const unsigned short* Qw = Qb + (long)(wid * QBLK + r32) * LDQ + hi * 8;
#pragma unroll
  for (int d0 = 0; d0 < 8; ++d0) qr[d0] = ld8(Qw + d0 * 16);
#pragma unroll
  for (int d0 = 0; d0 < 4; ++d0) *(bf16x8*)(qrl + d0 * 1024) = ld8(Qw + (8 + d0) * 16);
  const int sr = tid >> 4, sc = (tid & 15) * 8, vst0 = v_st(sr, sc), vst1 = v_st(32 + sr, sc);
  const int rr_ = tid >> 3, rc = (tid & 7) * 8;
  const int vb0 = (int)(uintptr_t)V_lds + v_rd_base(lane);
  struct { bf16x8 vs0, vs1, ks0, ks1, rs; } sr_[1];
#define SLOAD(i, k0) do { sr_[i].vs0 = ld8(&Vh[(long)((k0) + sr) * LDK + sc]); sr_[i].vs1 = ld8(&Vh[(long)((k0) + 32 + sr) * LDK + sc]); \
    sr_[i].ks0 = ld8(&Kh[(long)((k0) + sr) * LDK + sc]); sr_[i].ks1 = ld8(&Kh[(long)((k0) + 32 + sr) * LDK + sc]); sr_[i].rs = ld8(&Rh[(long)((k0) + rr_) * LDR + rc]); } while (0)
#define SWRITE(b, i) do { *(bf16x8*)(V_lds + (b) * SHM_V + vst0) = sr_[i].vs0;          \
    *(bf16x8*)(V_lds + (b) * SHM_V + vst1) = sr_[i].vs1; int kc = sc * 2;               \
    *(bf16x8*)(K_lds + (b) * SHM_K + KSWZ(sr, kc)) = sr_[i].ks0;                       \
    *(bf16x8*)(K_lds + (b) * SHM_K + KSWZ(32 + sr, kc)) = sr_[i].ks1;                  \
    *(bf16x8*)(R_lds + (b) * SHM_R + RSWZ(rr_, rc * 2)) = sr_[i].rs; } while (0)
#define SWAIT() asm volatile("s_waitcnt vmcnt(0)" ::: "memory")
#define RESC(a) do { if (__any((a) < 1.f)) { if (hi == 0) al_l[r32] = (a); asm volatile("s_waitcnt lgkmcnt(0)" ::: "memory"); \
    _Pragma("unroll") for (int d = 0; d < 4; ++d) _Pragma("unroll") for (int r = 0; r < 16; ++r) o[d][r] *= al_l[crow(r, hi)]; } } while (0)
  f32x16 pA0, pA1, pB0, pB1; float mnA, mnB, alA, alB; bf16x8 pa0, pa1, pa2, pa3; const int NT = seq / KVBLK;
  constexpr int SE = 0, SO = 0;
  SLOAD(SE, 0); asm volatile("s_waitcnt vmcnt(0)" ::: "memory"); SWRITE(0, SE); __syncthreads();
  qkt(pA0, pA1, K_lds, R_lds, qr, qrl, r32, hi); partialSM(pA0, pA1, m_reg, mnA, alA);
  SLOAD(SO, KVBLK);
  SWAIT(); SWRITE(1, SO); __syncthreads();
  for (int j = 1; j + 1 < NT; j += 2) {
    SBAR(); qkt(pB0, pB1, K_lds + SHM_K, R_lds + SHM_R, qr, qrl, r32, hi);
    finishSM(pA0, pA1, alA, l_reg, pa0, pa1, pa2, pa3); SBAR();
    SLOAD(SO, (j + 1) * KVBLK); SBAR();
    pv_d0(o, vb0, pa0, pa1, pa2, pa3); partialSM(pB0, pB1, m_reg, mnB, alB);
    __syncthreads(); SWAIT(); SWRITE(0, SE);
    RESC(alB); __syncthreads();
    SBAR(); qkt(pA0, pA1, K_lds, R_lds, qr, qrl, r32, hi);
    finishSM(pB0, pB1, alB, l_reg, pa0, pa1, pa2, pa3); SBAR();
    SLOAD(SE, (j + 2) * KVBLK); SBAR();
    pv_d0(o, vb0 + (int)SHM_V, pa0, pa1, pa2, pa3); partialSM(pA0, pA1, m_reg, mnA, alA);
    __syncthreads(); SWAIT(); SWRITE(1, SO);
    RESC(alA); __syncthreads();
  }
  SBAR(); qkt(pB0, pB1, K_lds + SHM_K, R_lds + SHM_R, qr, qrl, r32, hi);
  finishSM(pA0, pA1, alA, l_reg, pa0, pa1, pa2, pa3); SBAR();
  pv_d0(o, vb0, pa0, pa1, pa2, pa3); partialSM(pB0, pB1, m_reg, mnB, alB);
  __syncthreads(); RESC(alB);
  finishSM(pB0, pB1, alB, l_reg, pa0, pa1, pa2, pa3); SBAR();
  pv_d0(o, vb0 + (int)SHM_V, pa0, pa1, pa2, pa3);
  if (hi == 0) li_l[r32] = l_reg; asm volatile("s_waitcnt lgkmcnt(0)" ::: "memory");
  float rli[16];
#pragma unroll
  for (int r = 0; r < 16; ++r) rli[r] = __builtin_amdgcn_rcpf(li_l[crow(r, hi)]);
  unsigned short* Ow = Ob + (long)(wid * QBLK) * LDO;
#pragma unroll
  for (int r = 0; r < 16; ++r) { int orow = crow(r, hi);
#pragma unroll
    for (int d0 = 0; d0 < 4; ++d0) Ow[(long)orow * LDO + d0 * 32 + r32] = (unsigned short)(cvtpk(o[d0][r] * rli[r], 0.f) & 0xffffu); }
  __syncthreads();
#undef SLOAD
#undef SWRITE
#undef SWAIT
#undef RESC
}
__device__ __forceinline__ void hgrn_chunk_seq(const unsigned short* __restrict__ QH, const unsigned short* __restrict__ KH, const unsigned short* __restrict__ Zi, int ldz,
                                               const float* __restrict__ GM, const float* __restrict__ GL, unsigned short* __restrict__ OS, int dir, char* lds) {
  const int tid = tid_opaque(), wid = __builtin_amdgcn_readfirstlane(tid >> 6), lane = tid & 63, r32 = lane & 31, hi = lane >> 5, rb = wid & 1, vq = wid >> 1;
  char* Kimg = lds; char* KTimg = lds + 16384; char* Vimg = lds + 32768; char* Simg = lds + 49152; float* gtab = (float*)(lds + 81920);
  const int sr = tid >> 4, sc = (tid & 15) * 8;
  const int vbV = (int)(uintptr_t)Vimg + v_rd_base(lane) + vq * 512, vbS = (int)(uintptr_t)Simg + v_rd_base(lane) + vq * 512, vbK = (int)(uintptr_t)KTimg + v_rd_base(lane) + 2 * rb * 512;
  f32x16 St0 = {}, St1 = {};
#pragma unroll 1
  for (int c = 0; c < 64; ++c) {
    const int cn = dir ? 63 - c : c; const long n0 = (long)cn * 64;
    if (tid < 128) gtab[tid] = GM[cn * 1024 + tid]; else if (tid < 256) gtab[tid] = GL[cn * 1024 + tid - 128];
#pragma unroll
    for (int e = 0; e < 2; ++e) { const int t = sr + 32 * e; const long n = n0 + (dir ? 63 - t : t);
      const bf16x8 k8 = ld8(KH + n * 1024 + sc), v8 = ld8(Zi + n * ldz + sc);
      *(bf16x8*)(Kimg + KSWZ(t, sc * 2)) = k8; *(bf16x8*)(KTimg + v_st(t, sc)) = k8; *(bf16x8*)(Vimg + v_st(t, sc)) = v8; }
    bf16x8 qr[8];
    { const int t = 32 * rb + r32; const long n = n0 + (dir ? 63 - t : t);
#pragma unroll
      for (int d0 = 0; d0 < 8; ++d0) qr[d0] = ld8(QH + n * 1024 + d0 * 16 + hi * 8); }
    __syncthreads();
#pragma unroll
    for (int r = 0; r < 16; ++r) { const int k0 = 64 * rb + crow(r, hi), k1 = k0 + 32;
      St0[r] *= gtab[k0]; St1[r] *= gtab[k1];
      *(unsigned short*)(Simg + rb * 16384 + v_st(k0 & 63, 32 * vq + r32)) = (unsigned short)bfr(St0[r]);
      *(unsigned short*)(Simg + rb * 16384 + v_st(k1 & 63, 32 * vq + r32)) = (unsigned short)bfr(St1[r]); }
    __syncthreads();
    f32x16 p0 = {}, p1 = {};
#pragma unroll
    for (int d0 = 0; d0 < 8; ++d0) { const int cb = (d0 * 16 + hi * 8) * 2;
      const bf16x8 b0 = *reinterpret_cast<const bf16x8*>(Kimg + KSWZ(r32, cb));
      p0 = __builtin_amdgcn_mfma_f32_32x32x16_bf16(b0, qr[d0], p0, 0, 0, 0);
      if (rb) { const bf16x8 b1 = *reinterpret_cast<const bf16x8*>(Kimg + KSWZ(32 + r32, cb)); p1 = __builtin_amdgcn_mfma_f32_32x32x16_bf16(b1, qr[d0], p1, 0, 0, 0); } }
#pragma unroll
    for (int r = 0; r < 16; ++r) { const bool keep = crow(r, hi) <= r32; if (rb) p1[r] = keep ? p1[r] : 0.f; else p0[r] = keep ? p0[r] : 0.f; }
    bf16x8 pa0, pa1, pa2, pa3;
#define PK4(P, BASE, OUT) do { unsigned a0 = bfpk(P[BASE + 0], P[BASE + 1]), a1 = bfpk(P[BASE + 2], P[BASE + 3]);   \
    unsigned b0 = bfpk(P[BASE + 4], P[BASE + 5]), b1 = bfpk(P[BASE + 6], P[BASE + 7]);                              \
    auto r0 = __builtin_amdgcn_permlane32_swap(a0, b0, false, false); auto r1 = __builtin_amdgcn_permlane32_swap(a1, b1, false, false); \
    u32x4 w = {r0[0], r1[0], r0[1], r1[1]}; OUT = *reinterpret_cast<bf16x8*>(&w); } while (0)
    PK4(p0, 0, pa0); PK4(p0, 8, pa1); PK4(p1, 0, pa2); PK4(p1, 8, pa3);
#undef PK4
    f32x16 o = {};
    pv_one<0>(o, vbV, pa0, pa1, pa2, pa3);
    pv_one<0>(o, vbS, qr[0], qr[1], qr[2], qr[3]);
    pv_one<0>(o, vbS + 16384, qr[4], qr[5], qr[6], qr[7]);
#pragma unroll
    for (int r = 0; r < 16; ++r) { const int t = 32 * rb + crow(r, hi); const long n = n0 + (dir ? 63 - t : t);
      OS[n * 1024 + 32 * vq + r32] = (unsigned short)bfr(o[r]); }
#define PKF(L, H) (bf16x8){L[0], L[1], L[2], L[3], H[0], H[1], H[2], H[3]}
    { const s16x4 vl0 = tr_read<v_rd_off(0, 0, 0)>(vbV), vh0 = tr_read<v_rd_off(0, 0, 1)>(vbV), vl1 = tr_read<v_rd_off(0, 1, 0)>(vbV), vh1 = tr_read<v_rd_off(0, 1, 1)>(vbV);
      const s16x4 vl2 = tr_read<v_rd_off(0, 2, 0)>(vbV), vh2 = tr_read<v_rd_off(0, 2, 1)>(vbV), vl3 = tr_read<v_rd_off(0, 3, 0)>(vbV), vh3 = tr_read<v_rd_off(0, 3, 1)>(vbV);
      const s16x4 al0 = tr_read<v_rd_off(0, 0, 0)>(vbK), ah0 = tr_read<v_rd_off(0, 0, 1)>(vbK), al1 = tr_read<v_rd_off(0, 1, 0)>(vbK), ah1 = tr_read<v_rd_off(0, 1, 1)>(vbK);
      const s16x4 al2 = tr_read<v_rd_off(0, 2, 0)>(vbK), ah2 = tr_read<v_rd_off(0, 2, 1)>(vbK), al3 = tr_read<v_rd_off(0, 3, 0)>(vbK), ah3 = tr_read<v_rd_off(0, 3, 1)>(vbK);
      const s16x4 bl0 = tr_read<v_rd_off(1, 0, 0)>(vbK), bh0 = tr_read<v_rd_off(1, 0, 1)>(vbK), bl1 = tr_read<v_rd_off(1, 1, 0)>(vbK), bh1 = tr_read<v_rd_off(1, 1, 1)>(vbK);
      const s16x4 bl2 = tr_read<v_rd_off(1, 2, 0)>(vbK), bh2 = tr_read<v_rd_off(1, 2, 1)>(vbK), bl3 = tr_read<v_rd_off(1, 3, 0)>(vbK), bh3 = tr_read<v_rd_off(1, 3, 1)>(vbK);
      asm volatile("s_waitcnt lgkmcnt(0)" ::: "memory"); SBAR();
      St0 = __builtin_amdgcn_mfma_f32_32x32x16_bf16(PKF(al0, ah0), PKF(vl0, vh0), St0, 0, 0, 0); St0 = __builtin_amdgcn_mfma_f32_32x32x16_bf16(PKF(al1, ah1), PKF(vl1, vh1), St0, 0, 0, 0);
      St0 = __builtin_amdgcn_mfma_f32_32x32x16_bf16(PKF(al2, ah2), PKF(vl2, vh2), St0, 0, 0, 0); St0 = __builtin_amdgcn_mfma_f32_32x32x16_bf16(PKF(al3, ah3), PKF(vl3, vh3), St0, 0, 0, 0);
      St1 = __builtin_amdgcn_mfma_f32_32x32x16_bf16(PKF(bl0, bh0), PKF(vl0, vh0), St1, 0, 0, 0); St1 = __builtin_amdgcn_mfma_f32_32x32x16_bf16(PKF(bl1, bh1), PKF(vl1, vh1), St1, 0, 0, 0);
      St1 = __builtin_amdgcn_mfma_f32_32x32x16_bf16(PKF(bl2, bh2), PKF(vl2, vh2), St1, 0, 0, 0); St1 = __builtin_amdgcn_mfma_f32_32x32x16_bf16(PKF(bl3, bh3), PKF(vl3, vh3), St1, 0, 0, 0); }
#undef PKF
#pragma unroll
    for (int r = 0; r < 16; ++r) { const int k0 = 64 * rb + crow(r, hi); St0[r] *= gtab[128 + k0]; St1[r] *= gtab[128 + k0 + 32]; }
    __syncthreads();
  }
}
}

constexpr int NWAVES = 8;
#define GAS __attribute__((address_space(1)))
#define LAS __attribute__((address_space(3)))
#define CAS __attribute__((address_space(4)))
typedef unsigned short bf16;
typedef unsigned v4u __attribute__((ext_vector_type(4)));
typedef unsigned v2u __attribute__((ext_vector_type(2)));
typedef float f32x4 __attribute__((ext_vector_type(4)));
typedef float f32x2 __attribute__((ext_vector_type(2)));
typedef float f32x16 __attribute__((ext_vector_type(16)));
typedef GAS unsigned gu32;
#define RLX_AGENT __ATOMIC_RELAXED, __HIP_MEMORY_SCOPE_AGENT
#define LDS_WAIT() asm volatile("s_waitcnt lgkmcnt(0)" ::: "memory")
#define VM_WAIT() asm volatile("s_waitcnt vmcnt(0)" ::: "memory")
constexpr int RING_BYTES = 131072, MISC_OFF = RING_BYTES + 320, LDS_BYTES = 147456;

__device__ __forceinline__ float bf2f(unsigned short b) { return __uint_as_float(((unsigned)b) << 16); }
__device__ __forceinline__ unsigned f2bf(float f) { unsigned u = __float_as_uint(f); return (u + 0x7fffu + ((u >> 16) & 1u)) >> 16; }
__device__ __forceinline__ unsigned pk2(float lo, float hi) { return pg8::cvt_pk_bf16(lo, hi); }
__device__ __forceinline__ float sigmf(float x) { return __builtin_amdgcn_rcpf(1.0f + __expf(-x)); }
__device__ __forceinline__ float wave_sum(float v) {
#pragma unroll
    for (int o = 1; o < 64; o <<= 1) v += __shfl_xor(v, o);
    return v;
}
__device__ __forceinline__ void ld16bf(const bf16* p, float (&f)[16]) {
    const v4u a = *(const v4u*)p, b = *(const v4u*)(p + 8);
    const unsigned w[8] = {a.x, a.y, a.z, a.w, b.x, b.y, b.z, b.w};
#pragma unroll
    for (int i = 0; i < 8; ++i) { f[2 * i] = __uint_as_float(w[i] << 16); f[2 * i + 1] = __uint_as_float(w[i] & 0xffff0000u); }
}
__device__ __forceinline__ void ld8bf(const bf16* p, float (&f)[8]) {
    const v4u a = *(const v4u*)p; const unsigned w[4] = {a.x, a.y, a.z, a.w};
#pragma unroll
    for (int i = 0; i < 4; ++i) { f[2 * i] = __uint_as_float(w[i] << 16); f[2 * i + 1] = __uint_as_float(w[i] & 0xffff0000u); }
}
__device__ __forceinline__ void ld16f(const float* p, float (&f)[16]) {
#pragma unroll
    for (int i = 0; i < 4; ++i) { const f32x4 v = *(const f32x4*)(p + 4 * i); f[4 * i] = v[0]; f[4 * i + 1] = v[1]; f[4 * i + 2] = v[2]; f[4 * i + 3] = v[3]; }
}
__device__ __forceinline__ void st16f(float* p, const float (&f)[16]) {
#pragma unroll
    for (int i = 0; i < 4; ++i) *(f32x4*)(p + 4 * i) = (f32x4){f[4 * i], f[4 * i + 1], f[4 * i + 2], f[4 * i + 3]};
}
__device__ __forceinline__ void st16bf(bf16* p, const float (&f)[16]) {
    v4u a, b; a.x = pk2(f[0], f[1]); a.y = pk2(f[2], f[3]); a.z = pk2(f[4], f[5]); a.w = pk2(f[6], f[7]);
    b.x = pk2(f[8], f[9]); b.y = pk2(f[10], f[11]); b.z = pk2(f[12], f[13]); b.w = pk2(f[14], f[15]);
    *(v4u*)p = a; *(v4u*)(p + 8) = b;
}
__device__ __forceinline__ void st8bf(bf16* p, const float (&f)[8]) {
    v4u a; a.x = pk2(f[0], f[1]); a.y = pk2(f[2], f[3]); a.z = pk2(f[4], f[5]); a.w = pk2(f[6], f[7]); *(v4u*)p = a;
}

#define XB_TMO      128
#define XB_XCNT(j)  (256  + 64 * (j))
#define XB_XSUB(j)  (1280 + 64 * (j))
#define XB_XGEN(j)  (2304 + 64 * (j))
#define XB_TOP      3328
#define XB_TOPGEN   3392
#define XCD_BAR_WORDS 3456
#define XB_SPIN_CAP (1u << 18)

__device__ __forceinline__ unsigned xb_ld(unsigned* p)              { return __hip_atomic_load(p, __ATOMIC_RELAXED, __HIP_MEMORY_SCOPE_AGENT); }
__device__ __forceinline__ unsigned xb_add(unsigned* p, unsigned v) { return __hip_atomic_fetch_add(p, v, __ATOMIC_RELAXED, __HIP_MEMORY_SCOPE_AGENT); }
__device__ __forceinline__ unsigned xb_xcc_id() { return (unsigned)__builtin_amdgcn_s_getreg((3 << 11) | 20) & 0xFu; }
#define XB_SPIN(cond, bar) do { unsigned _sp = 0; while (cond) { __builtin_amdgcn_s_sleep(1); \
    if ((++_sp & 255u) == 0u) { if (xb_ld(&(bar)[XB_TMO])) break; if (_sp > XB_SPIN_CAP) { atomicAdd(&(bar)[XB_TMO], 1u); break; } } } } while (0)

struct XcdBarrier {
    unsigned* bar; unsigned x;
    volatile LAS unsigned* st;
};

__device__ __forceinline__ XcdBarrier xcd_barrier_post(unsigned* bar, volatile LAS unsigned* st) {
    XcdBarrier b; b.bar = bar; b.x = xb_xcc_id(); b.st = st;
    if (threadIdx.x == 0) (void)xb_add(&bar[XB_XCNT(b.x)], 1u);
    return b;
}
__device__ __forceinline__ void xcd_barrier_complete(unsigned* bar, unsigned x, unsigned& nloc, unsigned& nx) {
    const unsigned G = gridDim.x * gridDim.y * gridDim.z;
    unsigned sum, cnt, mine, sp = 0u;
    for (;;) {
        sum = 0u; cnt = 0u; mine = 0u;
#pragma unroll
        for (unsigned j = 0; j < 16; ++j) { const unsigned c = xb_ld(&bar[XB_XCNT(j)]); sum += c; cnt += (c > 0u) ? 1u : 0u; mine = (j == x) ? c : mine; }
        if (sum == G) break;
        __builtin_amdgcn_s_sleep(1);
        if ((++sp & 255u) == 0u) { if (xb_ld(&bar[XB_TMO])) break; if (sp > XB_SPIN_CAP) { atomicAdd(&bar[XB_TMO], 1u); break; } }
    }
    nloc = mine > 0u ? mine : 1u; nx = cnt > 0u ? cnt : 1u;
}

__device__ __forceinline__ void xcd_barrier(const XcdBarrier& b) {
    asm volatile("s_waitcnt vmcnt(0)" ::: "memory");
    __syncthreads();
    if (threadIdx.x == 0) {
        unsigned* bar = b.bar;
        __builtin_amdgcn_s_waitcnt(0);
        unsigned nloc = b.st[0], nx = b.st[1];
        if (nloc == 0u) { xcd_barrier_complete(bar, b.x, nloc, nx); b.st[0] = nloc; b.st[1] = nx; }
        const unsigned old = xb_add(&bar[XB_XSUB(b.x)], 1u);
        const unsigned gen = old / nloc;
        if (old + 1u == (gen + 1u) * nloc) {
            __builtin_amdgcn_fence(__ATOMIC_RELEASE, "agent");
            asm volatile("s_waitcnt vmcnt(0)" ::: "memory");
            const unsigned og = xb_add(&bar[XB_TOP], 1u);
            const unsigned tg = og / nx;
            if (og + 1u == (tg + 1u) * nx) xb_add(&bar[XB_TOPGEN], 1u);
            else XB_SPIN(xb_ld(&bar[XB_TOPGEN]) == tg, bar);
            __builtin_amdgcn_fence(__ATOMIC_ACQUIRE, "agent");
            xb_add(&bar[XB_XGEN(b.x)], 1u);
            asm volatile("s_waitcnt vmcnt(0)" ::: "memory");
        } else {
            XB_SPIN(xb_ld(&bar[XB_XGEN(b.x)]) == gen, bar);
            __builtin_amdgcn_fence(__ATOMIC_ACQUIRE, "agent");
            asm volatile("s_waitcnt vmcnt(0)" ::: "memory");
        }
    }
    __syncthreads();
}

__device__ __forceinline__ int uq_perm(int n) { const int h = n / 192, j = n % 192; if (j < 128) return n; const int jj = j - 128; return h * 192 + 128 + 2 * (jj & 31) + (jj >> 5); }
struct TrItem { const float* W; bf16* WT; int ldn, k0, kvalid, n0, ldk, kd0, drow0, perm; };
__device__ __forceinline__ void tr_load(const TrItem& T, float (&v)[32], int lane) {
#pragma unroll
    for (int i = 0; i < 32; ++i) { const int kk = 2 * i + (lane >> 5); v[i] = kk < T.kvalid ? __builtin_nontemporal_load(&T.W[(size_t)(T.k0 + kk) * T.ldn + T.n0 + (lane & 31)]) : 0.f; }
}
__device__ __forceinline__ void tr_store(const TrItem& T, const float (&v)[32], LAS float* scr, int lane) {
#pragma unroll
    for (int i = 0; i < 32; ++i) scr[(2 * i + (lane >> 5)) * 33 + (lane & 31)] = v[i];
    LDS_WAIT(); asm volatile("" ::: "memory");
    const int c = lane & 7;
#pragma unroll
    for (int j = 0; j < 4; ++j) { const int n = (lane >> 3) + 8 * j; const LAS float* s = scr + (8 * c) * 33 + n;
        v4u o; o.x = pk2(s[0 * 33], s[1 * 33]); o.y = pk2(s[2 * 33], s[3 * 33]); o.z = pk2(s[4 * 33], s[5 * 33]); o.w = pk2(s[6 * 33], s[7 * 33]);
        const int drow = T.perm ? uq_perm(T.n0 + n) : T.drow0 + n;
        *(GAS v4u*)(T.WT + (size_t)drow * T.ldk + T.kd0 + 8 * c) = o; }
    LDS_WAIT(); asm volatile("" ::: "memory");
}
struct LayerW { const float *w_in, *w2, *a2, *g2, *uq, *ukv, *br, *wo, *w1, *w2m, *wpe, *wpg; };
__device__ __forceinline__ TrItem tr_which(const LayerW& L, unsigned char* ws, int it) {
    bf16* WIN = (bf16*)(ws + WS_WIN); bf16* LORA = (bf16*)(ws + WS_LORA); bf16* UQ = (bf16*)(ws + WS_UQ); bf16* UKV = (bf16*)(ws + WS_UKV); bf16* BR = (bf16*)(ws + WS_BR);
    bf16* WO = (bf16*)(ws + WS_WO); bf16* W1 = (bf16*)(ws + WS_W1); bf16* W2 = (bf16*)(ws + WS_W2); bf16* WPE = (bf16*)(ws + WS_WPE); bf16* WPG = (bf16*)(ws + WS_WPG);
    constexpr int I_IN = 32 * 503, I_LW = 64, I_LA = 64, I_LG = 96, I_UQ = 12 * 48, I_UKV = 8 * 64, I_BR = 3 * 16 * 64, I_WO = 32 * 64, I_W1 = 32 * 256, I_W2 = 128 * 64, I_PE = 4 * 64;
    int r = it;
    if (r < I_IN) { const int kb = r / 503, n0 = (r % 503) * 32; const int drow = n0 < 3488 ? n0 : (n0 < 9952 ? n0 + 96 : n0 + 288); return TrItem{L.w_in, WIN, IN_W, kb * 64, 64, n0, 2048, kb * 64, drow, 0}; } r -= I_IN;
    if (r < I_LW) { const int d = r >> 5, n0 = (r & 31) * 32; return TrItem{L.w2 + d * 65536, LORA, 1024, 0, 64, n0, 256, 64 * d, d * 1024 + n0, 0}; } r -= I_LW;
    if (r < I_LA) { const int d = r >> 5, n0 = (r & 31) * 32; return TrItem{L.a2 + d * 65536, LORA, 1024, 0, 64, n0, 256, 128 + 64 * d, 2048 + d * 1024 + n0, 0}; } r -= I_LA;
    if (r < I_LG) { const int kb = r >> 5, n0 = (r & 31) * 32; return TrItem{L.g2, LORA + (size_t)4096 * 256, 1024, kb * 64, 160 - kb * 64, n0, 256, 64 * kb, n0, 0}; } r -= I_LG;
    if (r < I_UQ) { const int kb = r / 48, n0 = (r % 48) * 32; return TrItem{L.uq, UQ, 1536, kb * 64, 64, n0, 768, kb * 64, 0, 1}; } r -= I_UQ;
    if (r < I_UKV) { const int kb = r >> 6, n0 = (r & 63) * 32; return TrItem{L.ukv, UKV, 2048, kb * 64, 64, n0, 512, kb * 64, n0, 0}; } r -= I_UKV;
    if (r < I_BR) { const int nb3 = r >> 10, q = r & 1023, kb = q >> 6, n0 = (q & 63) * 32; return TrItem{L.br + (size_t)nb3 * 1024 * 2048, BR + (size_t)nb3 * 2048 * 1024, 2048, kb * 64, 64, n0, 1024, kb * 64, n0, 0}; } r -= I_BR;
    if (r < I_WO) { const int kb = r >> 6, n0 = (r & 63) * 32; return TrItem{L.wo, WO, 2048, kb * 64, 64, n0, 2048, kb * 64, n0, 0}; } r -= I_WO;
    if (r < I_W1) { const int kb = r >> 8, n0 = (r & 255) * 32; return TrItem{L.w1, W1, 8192, kb * 64, 64, n0, 2048, kb * 64, n0, 0}; } r -= I_W1;
    if (r < I_W2) { const int kb = r >> 6, n0 = (r & 63) * 32; return TrItem{L.w2m, W2, 2048, kb * 64, 64, n0, 8192, kb * 64, n0, 0}; } r -= I_W2;
    if (r < I_PE) { const int kb = r >> 6, n0 = (r & 63) * 32; return TrItem{L.wpe, WPE, 2048, kb * 64, 64, n0, 256, kb * 64, n0, 0}; } r -= I_PE;
    { const int kb = r >> 6, n0 = (r & 63) * 32; return TrItem{L.wpg, WPG, 2048, kb * 64, 64, n0, 2048, kb * 64, n0, 0}; }
}
constexpr int TR_EARLY = 32 * 503 + 64 + 64 + 96 + 12 * 48 + 8 * 64;
static_assert(TR_EARLY % 8 == 0, "the phase-4 filler hands out chunks of 8 items");
__device__ __forceinline__ void convert_weights(const LayerW& L, unsigned char* ws, LAS float* scr, int gw, int NGW, int lane, int first) {
    constexpr int NITEMS = 32 * 503 + 64 + 64 + 96 + 12 * 48 + 8 * 64 + 3 * 16 * 64 + 32 * 64 + 32 * 256 + 128 * 64 + 4 * 64 + 32 * 64;
    if (first + gw >= NITEMS) return;
    TrItem cur = tr_which(L, ws, first + gw); float v[32]; tr_load(cur, v, lane);
#pragma unroll 1
    for (int it = first + gw; it < NITEMS; it += NGW) {
        const int nx = it + NGW; TrItem nxt = cur; float w[32];
        if (nx < NITEMS) { nxt = tr_which(L, ws, nx); tr_load(nxt, w, lane); }
        tr_store(cur, v, scr, lane);
        if (nx < NITEMS) {
#pragma unroll
            for (int i = 0; i < 32; ++i) v[i] = w[i]; }
        cur = nxt;
    }
}
template <bool OUT32> __device__ __forceinline__ void rms_row(const float* xrow, const float* g, void* orow, int lane) {
    const f32x4* xr = (const f32x4*)xrow + lane; f32x4 v[8]; float s = 0.f;
#pragma unroll
    for (int j = 0; j < 8; ++j) { v[j] = xr[64 * j]; s += (v[j][0] * v[j][0] + v[j][1] * v[j][1]) + (v[j][2] * v[j][2] + v[j][3] * v[j][3]); }
    const float rstd = __builtin_amdgcn_rsqf(wave_sum(s) * (1.0f / 2048.0f) + 1e-6f);
#pragma unroll
    for (int j = 0; j < 8; ++j) { const f32x4 gv = ((const f32x4*)g)[64 * j + lane]; const f32x4 o = v[j] * rstd * gv;
        if (OUT32) ((f32x4*)orow)[64 * j + lane] = o; else { v2u w; w.x = pk2(o[0], o[1]); w.y = pk2(o[2], o[3]); ((v2u*)orow)[64 * j + lane] = w; } }
}
template <int NCH> __device__ __forceinline__ void shiftN(const bf16* Z, size_t m, bool hp, bool hn, int c, const float* mu, float (&u)[NCH]) {
    float z[NCH], zp[NCH], zn[NCH];
    if constexpr (NCH == 16) { ld16bf(Z + m * ZW + c, z); if (hp) ld16bf(Z + (m - 1) * ZW + c, zp); if (hn) ld16bf(Z + (m + 1) * ZW + c, zn); }
    else { ld8bf(Z + m * ZW + c, z); if (hp) ld8bf(Z + (m - 1) * ZW + c, zp); if (hn) ld8bf(Z + (m + 1) * ZW + c, zn); }
#pragma unroll
    for (int i = 0; i < NCH; i += 4) { const f32x4 m0 = *(const f32x4*)(mu + c + i), m1 = *(const f32x4*)(mu + RWKV_W + c + i);
#pragma unroll
        for (int j = 0; j < 4; ++j) { const float zz = z[i + j], p = hp ? zp[i + j] : 0.f, n = hn ? zn[i + j] : 0.f; u[i + j] = zz + m0[j] * (p - zz) + m1[j] * (n - zz); } }
}
struct PreP { const float *mu, *kk, *lb, *qg, *kvg, *COS, *SIN; };
__device__ __forceinline__ void unpk8(const v4u a, float (&f)[8]) { const unsigned w[4] = {a.x, a.y, a.z, a.w};
#pragma unroll
    for (int i = 0; i < 4; ++i) { f[2 * i] = __uint_as_float(w[i] << 16); f[2 * i + 1] = __uint_as_float(w[i] & 0xffff0000u); } }
__device__ __forceinline__ void pre_run_rwkv(size_t m0, const PreP& P, unsigned char* ws, int lane) {
    const bf16* Z = (const bf16*)(ws + WS_Z);
    const int s0 = (int)(m0 & (SEQ - 1)); const bool hp = s0 > 0, hn = s0 + 4 < SEQ;
    unsigned z_ = 0u; asm volatile("" : "+v"(z_)); const v4u zero4 = {z_, z_, z_, z_};
    v4u ra[6], rb[6];
#pragma unroll
    for (int i = 0; i < 6; ++i) { const bool ok = i == 0 ? hp : (i == 5 ? hn : true); const bf16* p = Z + (m0 + i - 1) * ZW + 16 * lane; ra[i] = ok ? *(const v4u*)p : zero4; rb[i] = ok ? *(const v4u*)(p + 8) : zero4; }
#pragma unroll
    for (int sec = 0; sec < 3; ++sec) {
        const int c = sec * 1024 + 16 * lane;
        v4u na[6], nb[6];
#pragma unroll
        for (int i = 0; i < 6; ++i) { const bool ok = i == 0 ? hp : (i == 5 ? hn : true);
            if (sec < 2) { const bf16* p = Z + (m0 + i - 1) * ZW + c + 1024; na[i] = ok ? *(const v4u*)p : zero4; nb[i] = ok ? *(const v4u*)(p + 8) : zero4; }
            else { na[i] = (ok && lane < 52) ? *(const v4u*)(Z + (m0 + i - 1) * ZW + 3072 + 8 * lane) : zero4; nb[i] = zero4; } }
        float m0v[16], m1v[16]; ld16f(P.mu + c, m0v); ld16f(P.mu + RWKV_W + c, m1v);
        float kkv[16]; if (sec == 1) ld16f(P.kk + 16 * lane, kkv);
#pragma unroll
        for (int t = 0; t < 4; ++t) { float zp[16], zz[16], zn[16], u[16];
            { float h0[8], h1[8]; unpk8(ra[t], h0); unpk8(rb[t], h1);
#pragma unroll
              for (int i = 0; i < 8; ++i) { zp[i] = h0[i]; zp[8 + i] = h1[i]; } }
            { float h0[8], h1[8]; unpk8(ra[t + 1], h0); unpk8(rb[t + 1], h1);
#pragma unroll
              for (int i = 0; i < 8; ++i) { zz[i] = h0[i]; zz[8 + i] = h1[i]; } }
            { float h0[8], h1[8]; unpk8(ra[t + 2], h0); unpk8(rb[t + 2], h1);
#pragma unroll
              for (int i = 0; i < 8; ++i) { zn[i] = h0[i]; zn[8 + i] = h1[i]; } }
#pragma unroll
            for (int i = 0; i < 16; ++i) u[i] = zz[i] + m0v[i] * (zp[i] - zz[i]) + m1v[i] * (zn[i] - zz[i]);
            const size_t o = (m0 + t) * 1024 + 16 * lane;
            if (sec == 0) st16bf((bf16*)(ws + WS_R) + o, u);
            else if (sec == 2) st16bf((bf16*)(ws + WS_V) + o, u);
            else { st16bf((bf16*)(ws + WS_KS) + o, u); float ss = 0.f;
#pragma unroll
                for (int i = 0; i < 16; ++i) { u[i] *= kkv[i]; ss += u[i] * u[i]; }
                ss += __shfl_xor(ss, 1); ss += __shfl_xor(ss, 2);
                const float inv = __builtin_amdgcn_rsqf(fmaxf(ss, 1e-24f));
                if ((lane & 3) == 0) ((float*)(ws + WS_KAP))[(m0 + t) * 16 + (lane >> 2)] = inv; } }
#pragma unroll
        for (int i = 0; i < 6; ++i) { ra[i] = na[i]; rb[i] = nb[i]; }
    }
    {
        const int c = 3072 + 8 * lane;
        if (lane < 52) {
            float m0v[8], m1v[8];
#pragma unroll
            for (int i = 0; i < 8; i += 4) { const f32x4 a = *(const f32x4*)(P.mu + c + i), b = *(const f32x4*)(P.mu + RWKV_W + c + i);
#pragma unroll
                for (int j = 0; j < 4; ++j) { m0v[i + j] = a[j]; m1v[i + j] = b[j]; } }
#pragma unroll
            for (int t = 0; t < 4; ++t) { float zp[8], zz[8], zn[8], u[8]; unpk8(ra[t], zp); unpk8(ra[t + 1], zz); unpk8(ra[t + 2], zn);
#pragma unroll
                for (int i = 0; i < 8; ++i) { u[i] = zz[i] + m0v[i] * (zp[i] - zz[i]) + m1v[i] * (zn[i] - zz[i]); if (lane < 16) { const float e_ = __builtin_amdgcn_exp2f(-2.8853900817779268f * __builtin_fabsf(u[i])), th_ = (1.0f - e_) * __builtin_amdgcn_rcpf(1.0f + e_); u[i] = u[i] < 0.f ? -th_ : th_; }     else if (lane >= 32) u[i] = sigmf(u[i]); }
                st8bf((bf16*)(ws + WS_ALORA) + (lane < 32 ? (size_t)0 : (size_t)M * 256) + (m0 + t) * 256 + 8 * (lane & 31), u); }
        } else {
#pragma unroll
            for (int t = 0; t < 4; ++t) *(v4u*)((bf16*)(ws + WS_ALORA) + (size_t)M * 256 + (m0 + t) * 256 + 8 * (lane & 31)) = zero4;
        }
    }
}
__device__ __forceinline__ void pre_token(size_t m, const PreP& P, unsigned char* ws, int lane) {
    const bf16* Z = (const bf16*)(ws + WS_Z);
    float a[8], b[8], kvv[8]; ld8bf(Z + m * ZW + ZO_C + 8 * lane, a); if (lane < 32) ld8bf(Z + m * ZW + ZO_C + 512 + 8 * lane, b); ld8bf(Z + m * ZW + ZO_C + 768 + 8 * lane, kvv);
    const float tr = bf2f(Z[m * ZW + ZO_C + 1280 + lane]); const float cc_ = P.COS[m * 32 + (lane & 31)], sn_ = P.SIN[m * 32 + (lane & 31)];
    { float ss = 0.f;
#pragma unroll
      for (int i = 0; i < 8; ++i) { ss += a[i] * a[i]; if (lane < 32) ss += b[i] * b[i]; }
      const float rstd = __builtin_amdgcn_rsqf(wave_sum(ss) * (1.0f / 768.0f) + 1e-6f);
      bf16* O = (bf16*)(ws + WS_CQN) + m * 768;
#pragma unroll
      for (int i = 0; i < 8; ++i) a[i] = a[i] * rstd * P.qg[8 * lane + i];
      st8bf(O + 8 * lane, a);
      if (lane < 32) {
#pragma unroll
          for (int i = 0; i < 8; ++i) b[i] = b[i] * rstd * P.qg[512 + 8 * lane + i];
          st8bf(O + 512 + 8 * lane, b); } }
    { float ss = 0.f;
#pragma unroll
      for (int i = 0; i < 8; ++i) ss += kvv[i] * kvv[i];
      const float rstd = __builtin_amdgcn_rsqf(wave_sum(ss) * (1.0f / 512.0f) + 1e-6f);
#pragma unroll
      for (int i = 0; i < 8; ++i) kvv[i] = kvv[i] * rstd * P.kvg[8 * lane + i];
      st8bf((bf16*)(ws + WS_CKVN) + m * 512 + 8 * lane, kvv); }
    { const float o = __shfl_xor(tr, 32); const int i = lane & 31;
      const float r = lane < 32 ? tr * cc_ - o * sn_ : tr * cc_ + o * sn_;
      ((bf16*)(ws + WS_KR))[m * 64 + 2 * i + (lane >> 5)] = (bf16)f2bf(r); }
}
__device__ __forceinline__ void hgrn_gate(float z, float lb, float ol, float& key, float& lf2) {
    const float e = __builtin_amdgcn_exp2f(-1.4426950408889634f * __builtin_fabsf(z)), s = __builtin_amdgcn_rcpf(1.0f + e), es = e * s;
    const float sp = z >= 0.f ? s : es, sn = z >= 0.f ? es : s;
    key = ol * sn; lf2 = __builtin_amdgcn_logf(fmaxf(lb + ol * sp, 1e-30f));
}
__device__ __forceinline__ void hgrn_prep(int u, const float* lbl, unsigned char* ws, int lane) {
    const bf16* Z = (const bf16*)(ws + WS_Z); const int cg = u >> 3, h = u & 7, c0 = 128 * h + 2 * lane; const size_t n0 = (size_t)cg * 64;
    const float lb0 = lbl[c0], lb1 = lbl[c0 + 1], ol0 = 1.0f - lb0, ol1 = 1.0f - lb1;
    const bf16* zq = Z + ZO_H + c0; const bf16* zf = zq + 1024; const bf16* zb = zq + 2048;
    bf16* QH = (bf16*)(ws + WS_QH) + c0; bf16* KH = (bf16*)(ws + WS_KH) + c0; constexpr size_t DS = (size_t)M * 1024; constexpr float CL = 115.41560327111707f;
    float* GM = (float*)(ws + WS_GM); float* GL = (float*)(ws + WS_GL); const size_t go = (size_t)cg * 1024 + c0, gd = (size_t)256 * 1024;
    float x00 = 0.f, x01 = 0.f, x10 = 0.f, x11 = 0.f;
#pragma unroll 1
    for (int bt = 0; bt < 4; ++bt) {
        const bool up = bt < 2; const int tb = up ? 32 + 16 * bt : 31 - 16 * (bt - 2), ts = up ? 1 : -1;
        if (bt == 2) { *(f32x2*)(GL + go) = (f32x2){__builtin_amdgcn_exp2f(x00), __builtin_amdgcn_exp2f(x01)}; *(f32x2*)(GM + gd + go) = (f32x2){__builtin_amdgcn_exp2f(x10), __builtin_amdgcn_exp2f(x11)};
                       x00 = 0.f; x01 = 0.f; x10 = 0.f; x11 = 0.f; }
        unsigned wf[16], wb[16], wq[16];
#pragma unroll
        for (int i = 0; i < 16; ++i) { const size_t n = n0 + (size_t)(tb + ts * i); wf[i] = *(const unsigned*)(zf + n * ZW); wb[i] = *(const unsigned*)(zb + n * ZW); wq[i] = *(const unsigned*)(zq + n * ZW); }
#pragma unroll
        for (int i = 0; i < 16; ++i) { const size_t n = n0 + (size_t)(tb + ts * i);
            const float q0 = __uint_as_float(wq[i] << 16), q1 = __uint_as_float(wq[i] & 0xffff0000u);
            const float s0 = q0 * __builtin_amdgcn_rcpf(1.0f + __builtin_amdgcn_exp2f(-1.4426950408889634f * q0)), s1 = q1 * __builtin_amdgcn_rcpf(1.0f + __builtin_amdgcn_exp2f(-1.4426950408889634f * q1));
            float k00, k01, k10, k11, l00, l01, l10, l11;
            hgrn_gate(__uint_as_float(wf[i] << 16), lb0, ol0, k00, l00); hgrn_gate(__uint_as_float(wf[i] & 0xffff0000u), lb1, ol1, k01, l01);
            hgrn_gate(__uint_as_float(wb[i] << 16), lb0, ol0, k10, l10); hgrn_gate(__uint_as_float(wb[i] & 0xffff0000u), lb1, ol1, k11, l11);
            const float y00 = x00 + l00, y01 = x01 + l01, y10 = x10 + l10, y11 = x11 + l11;
            const float e00 = up ? y00 : -x00, e01 = up ? y01 : -x01, e10 = up ? -x10 : y10, e11 = up ? -x11 : y11;
            x00 = y00; x01 = y01; x10 = y10; x11 = y11;
            *(unsigned*)(QH + n * 1024) = pk2(s0 * __builtin_amdgcn_exp2f(fminf(e00, CL)), s1 * __builtin_amdgcn_exp2f(fminf(e01, CL)));
            *(unsigned*)(KH + n * 1024) = pk2(k00 * __builtin_amdgcn_exp2f(fminf(-e00, CL)), k01 * __builtin_amdgcn_exp2f(fminf(-e01, CL)));
            *(unsigned*)(QH + DS + n * 1024) = pk2(s0 * __builtin_amdgcn_exp2f(fminf(e10, CL)), s1 * __builtin_amdgcn_exp2f(fminf(e11, CL)));
            *(unsigned*)(KH + DS + n * 1024) = pk2(k10 * __builtin_amdgcn_exp2f(fminf(-e10, CL)), k11 * __builtin_amdgcn_exp2f(fminf(-e11, CL))); }
    }
    *(f32x2*)(GM + go) = (f32x2){__builtin_amdgcn_exp2f(x00), __builtin_amdgcn_exp2f(x01)}; *(f32x2*)(GL + gd + go) = (f32x2){__builtin_amdgcn_exp2f(x10), __builtin_amdgcn_exp2f(x11)};
}
struct PostP { const float *gnw, *gnb, *rk, *hng, *ka; };
__device__ __forceinline__ void post_token(size_t m, const PostP& P, unsigned char* ws, int lane) {
    const int c16 = 16 * lane; const size_t o = m * 1024 + c16;
    float of[16], ob[16], gz[16];
    ld16bf((const bf16*)(ws + WS_OS) + o, of); ld16bf((const bf16*)(ws + WS_OS) + (size_t)M * 1024 + o, ob); ld16bf((const bf16*)(ws + WS_Z) + m * ZW + ZO_H + 4096 + c16, gz);
    { float yf[16], yb[16]; ld16bf((const bf16*)(ws + WS_YS) + o, yf); ld16bf((const bf16*)(ws + WS_YS) + (size_t)M * 1024 + o, yb);
      float s1 = 0.f;
#pragma unroll
      for (int i = 0; i < 16; ++i) { yf[i] += yb[i]; s1 += yf[i]; }
      s1 += __shfl_xor(s1, 1); s1 += __shfl_xor(s1, 2); const float mean = s1 * (1.0f / 64.0f); float s2 = 0.f;
#pragma unroll
      for (int i = 0; i < 16; ++i) { yf[i] -= mean; s2 += yf[i] * yf[i]; }
      s2 += __shfl_xor(s2, 1); s2 += __shfl_xor(s2, 2); const float rstd = __builtin_amdgcn_rsqf(s2 * (1.0f / 64.0f) + 64e-5f);
      float r[16], k0[16], k1[16], t[16]; ld16bf((const bf16*)(ws + WS_R) + o, r); ld16bf((const bf16*)(ws + WS_A) + o, k0); ld16bf((const bf16*)(ws + WS_A) + (size_t)M * 1024 + o, k1); ld16f(P.rk + c16, t);
      float bs = 0.f;
      { float ks[16], ka[16]; ld16bf((const bf16*)(ws + WS_KS) + o, ks); ld16f(P.ka + c16, ka);
#pragma unroll
        for (int i = 0; i < 16; ++i) bs += r[i] * ks[i] * (2.0f + (k0[i] + k1[i] - 2.0f) * ka[i]) * t[i]; }
      bs += __shfl_xor(bs, 1); bs += __shfl_xor(bs, 2);
      float gw_[16], gb_[16], v[16], g[16]; ld16f(P.gnw + c16, gw_); ld16f(P.gnb + c16, gb_); ld16bf((const bf16*)(ws + WS_V) + o, v); ld16bf((const bf16*)(ws + WS_G) + o, g);
#pragma unroll
      for (int i = 0; i < 16; ++i) yf[i] = (yf[i] * rstd * gw_[i] + gb_[i] + bs * v[i]) * g[i];
      st16bf((bf16*)(ws + WS_YA) + o, yf); }
    { float ss = 0.f;
#pragma unroll
      for (int i = 0; i < 16; ++i) { of[i] += ob[i]; ss += of[i] * of[i]; }
      ss += __shfl_xor(ss, 1); ss += __shfl_xor(ss, 2); ss += __shfl_xor(ss, 4);
      const float rstd = __builtin_amdgcn_rsqf(ss * (1.0f / 128.0f) + 1e-6f);
      float ng[16]; ld16f(P.hng + (c16 & 127), ng);
#pragma unroll
      for (int i = 0; i < 16; ++i) of[i] = of[i] * rstd * ng[i] * (gz[i] * sigmf(gz[i]));
      st16bf((bf16*)(ws + WS_YB) + o, of); }
}
#define SCAN_BAR() do { asm volatile("s_waitcnt lgkmcnt(0)" ::: "memory"); __builtin_amdgcn_s_barrier(); asm volatile("" ::: "memory"); } while (0)
__device__ __forceinline__ float quad_sum(float x) {
    x += __builtin_bit_cast(float, __builtin_amdgcn_update_dpp(0, __builtin_bit_cast(int, x), 0xB1, 0xF, 0xF, true));
    x += __builtin_bit_cast(float, __builtin_amdgcn_update_dpp(0, __builtin_bit_cast(int, x), 0x4E, 0xF, 0xF, true));
    return x;
}
__device__ __forceinline__ float oct_sum(float x) {
    x += __builtin_bit_cast(float, __builtin_amdgcn_update_dpp(0, __builtin_bit_cast(int, x), 0xB1, 0xF, 0xF, true));
    x += __builtin_bit_cast(float, __builtin_amdgcn_update_dpp(0, __builtin_bit_cast(int, x), 0x4E, 0xF, 0xF, true));
    x += __builtin_bit_cast(float, __builtin_amdgcn_update_dpp(0, __builtin_bit_cast(int, x), 0x141, 0xF, 0xF, true));
    return x;
}
__device__ __forceinline__ void rwkv_scan(int sid, const float* kal, const float* kkl, unsigned char* ws, LAS unsigned char* lds) {
    const int tid = tid_opaque(), wave = __builtin_amdgcn_readfirstlane(tid >> 6), lane = tid & 63;
    const int dir = sid & 1, bh = sid >> 1, h = bh & 15, b = bh >> 4;
    constexpr int NB = SEQ / 16;
    constexpr int O_XI = 0, O_B2T = 16384, O_VT = 32768, O_YI = 49152, O_MN = 61440, O_GS = 73728, O_SB = 81920, O_OUT = 90112, O_WRAW = 98304, O_LAM = 106496;
    LAS float* outb = (LAS float*)(lds + O_OUT); LAS float* lamb = (LAS float*)(lds + O_LAM);
#define SW128(row, k) ((row) * 128 + (((((k) >> 3) << 4)) ^ (((row) & 7) << 4)) + ((k) & 7) * 2)
#define SW64(row, kk) ((row) * 64 + (((((kk) >> 3) << 4)) ^ ((((row) >> 2) & 3) << 4)) + ((kk) & 7) * 2)
#define NK(t_) (((t_) & 3) + 8 * ((t_) >> 2))
    if (wave >= 4) {
        const int j = tid - 256, st = j & 15, q4 = j >> 4;
        const size_t dofs = (size_t)dir * M * 1024;
        const int co = h * 64 + q4 * 4;
        const float* b0 = (const float*)(ws + WS_KAP) + h;     const unsigned short* b1 = (const unsigned short*)(ws + WS_W) + dofs + co; const bf16* b2 = (const bf16*)(ws + WS_A) + dofs + co;
        const bf16* b3 = (const bf16*)(ws + WS_KS) + co; const bf16* b4 = (const bf16*)(ws + WS_R) + co; const bf16* b5 = (const bf16*)(ws + WS_V) + co;
        const f32x4 ka4 = *(const f32x4*)(kal + co), kk4 = *(const f32x4*)(kkl + co);
        bf16* YS = (bf16*)(ws + WS_YS) + dofs + co;
        const int nk = NK(st), nr = nk + 4;
        const int q4p = (q4 & 12) | ((q4 & 1) << 1) | ((q4 & 2) >> 1);
        struct Raw { v2u a, ks, r, v, w; float ki; };
        typedef _Float16 h16x4_ __attribute__((ext_vector_type(4)));
        Raw A, B, C;
#define RW_TOK(nb_) ((size_t)(b * SEQ + (dir ? SEQ - 1 - ((nb_) * 16 + st) : (nb_) * 16 + st)) * 1024)
#define RW_LOAD(X, nb_) do { const size_t o_ = RW_TOK(nb_); X.ki = b0[(o_ >> 10) * 16]; X.w = *(const v2u*)(b1 + o_); X.a = *(const v2u*)(b2 + o_); X.ks = *(const v2u*)(b3 + o_); X.r = *(const v2u*)(b4 + o_); X.v = *(const v2u*)(b5 + o_); } while (0)
#define BF4(w_) ((f32x4){__uint_as_float((w_).x << 16), __uint_as_float((w_).x & 0xffff0000u), __uint_as_float((w_).y << 16), __uint_as_float((w_).y & 0xffff0000u)})
#define PK4B(v_) ((v2u){pg8::cvt_pk_bf16((v_)[0], (v_)[1]), pg8::cvt_pk_bf16((v_)[2], (v_)[3])})
#define RW_SHR(x_, n_) __builtin_bit_cast(float, __builtin_amdgcn_update_dpp(0x3f800000, __builtin_bit_cast(int, x_), 0x110 + (n_), 0xF, 0xF, false))
#define RW_SCALE(X, nb_) do { f32x4 lt_ = __builtin_convertvector(__builtin_bit_cast(h16x4_, X.w), f32x4), lp_; \
        _Pragma("unroll") for (int e_ = 0; e_ < 4; ++e_) { float x_ = lt_[e_]; x_ *= RW_SHR(x_, 1); x_ *= RW_SHR(x_, 2); x_ *= RW_SHR(x_, 4); x_ *= RW_SHR(x_, 8); lt_[e_] = x_; lp_[e_] = RW_SHR(x_, 1); } \
        f32x4 il_; il_[0] = __builtin_amdgcn_rcpf(lt_[0]); il_[1] = __builtin_amdgcn_rcpf(lt_[1]); il_[2] = __builtin_amdgcn_rcpf(lt_[2]); il_[3] = __builtin_amdgcn_rcpf(lt_[3]); \
        const f32x4 af_ = BF4(X.a), sf_ = BF4(X.ks), kf_ = sf_ * kk4 * X.ki; const int p3_ = ((nb_) & 3) * 4096, p2_ = ((nb_) % 3) * 4096; \
        const f32x4 kh_ = kf_ * lp_, bh_ = (kf_ * af_) * il_, th_ = (sf_ * (1.0f + (af_ - 1.0f) * ka4)) * il_, rh_ = BF4(X.r) * lt_; \
        *(LAS v2u*)(lds + O_XI + p3_ + SW128(nk, 4 * q4p)) = PK4B(kh_); *(LAS v2u*)(lds + O_XI + p3_ + SW128(nr, 4 * q4p)) = PK4B(rh_); \
        *(LAS v2u*)(lds + O_YI + p2_ + SW128(st, 4 * q4p)) = PK4B(bh_); *(LAS v2u*)(lds + O_YI + p2_ + SW128(16 + st, 4 * q4p)) = PK4B(th_); \
        _Pragma("unroll") for (int e_ = 0; e_ < 4; ++e_) { const unsigned w2_ = pg8::cvt_pk_bf16(bh_[e_], th_[e_]); *(LAS unsigned short*)(lds + O_B2T + p3_ + SW64(4 * q4 + e_, st)) = (unsigned short)(w2_ & 0xffffu); *(LAS unsigned short*)(lds + O_B2T + p3_ + SW64(4 * q4 + e_, 16 + st)) = (unsigned short)(w2_ >> 16); } \
        { const unsigned vw_[4] = {X.v.x & 0xffffu, X.v.x >> 16, X.v.y & 0xffffu, X.v.y >> 16}; \
          _Pragma("unroll") for (int e_ = 0; e_ < 4; ++e_) *(LAS unsigned short*)(lds + O_VT + p3_ + SW64(4 * q4 + e_, 16 + st)) = (unsigned short)vw_[e_]; } \
        if (st == 15) *(LAS f32x4*)(lamb + ((nb_) & 3) * 64 + q4 * 4) = lt_; } while (0)
#define RW_FLUSH(nb_) do { const f32x4 y_ = *(const LAS f32x4*)(outb + (((nb_) & 1) * 16 + st) * 64 + ((q4 ^ st) << 2)); v2u w_; w_.x = pk2(y_[0], y_[1]); w_.y = pk2(y_[2], y_[3]); *(v2u*)(YS + RW_TOK(nb_)) = w_; } while (0)
#define RW_ITER(nb_, X1, X2) do { if ((nb_) + 3 < NB) RW_SCALE(X1, (nb_) + 3); if ((nb_) + 6 < NB) RW_LOAD(X1, (nb_) + 6); if ((nb_) > 0) RW_FLUSH((nb_) - 1); SCAN_BAR(); } while (0)
        RW_LOAD(A, 0); RW_LOAD(B, 1); RW_LOAD(C, 2);
        SCAN_BAR();
        RW_SCALE(A, 0); RW_LOAD(A, 3);
        SCAN_BAR();
        RW_SCALE(B, 1); RW_LOAD(B, 4);
        SCAN_BAR();
        RW_SCALE(C, 2); RW_LOAD(C, 5);
        SCAN_BAR();
        for (int nb = 0; nb + 2 < NB; nb += 3) { RW_ITER(nb, A, B); RW_ITER(nb + 1, B, C); RW_ITER(nb + 2, C, A); }
        RW_ITER(NB - 1, A, B);
        static_assert(NB % 3 == 1, "stager loop tail assumes NB = 1 (mod 3)");
        RW_FLUSH(NB - 1);
#undef RW_TOK
#undef RW_LOAD
#undef RW_SHR
#undef RW_SCALE
#undef RW_FLUSH
#undef RW_ITER
#undef BF4
#undef PK4B
    } else if (wave < 2) {
        typedef short bfx8 __attribute__((ext_vector_type(8))); typedef float f16v __attribute__((ext_vector_type(16))); typedef unsigned u4v __attribute__((ext_vector_type(4)));
        const int vl = lane & 31, hi = lane >> 5, vrow = 32 * wave + vl;
        f16v St0 = {}, St1 = {};
        bfx8 so0 = {}, so1 = {}, so2 = {}, so3 = {};
        SCAN_BAR(); SCAN_BAR(); SCAN_BAR(); SCAN_BAR();
#pragma unroll 1
        for (int nb = 0; nb < NB; ++nb) {
            const int p3 = (nb & 3) * 4096, p2 = (nb % 3) * 4096;
            const LAS unsigned char* xi = lds + O_XI + p3; const LAS unsigned char* b2t = lds + O_B2T + p3; LAS unsigned char* vt = lds + O_VT + p3; const LAS unsigned char* mn = lds + O_MN + p2;
            f16v pq = {};
#pragma unroll
            for (int q = 0; q < 4; ++q) { const bfx8 ax = *(const LAS bfx8*)(xi + SW128(vl, 16 * q + 8 * hi)); pq = __builtin_amdgcn_mfma_f32_32x32x16_bf16(ax, q == 0 ? so0 : (q == 1 ? so1 : (q == 2 ? so2 : so3)), pq, 0, 0, 0); }
            f32x4 lm0[4], lm1[4];
#pragma unroll
            for (int g4 = 0; g4 < 4; ++g4) { lm0[g4] = *(const LAS f32x4*)(lamb + (nb & 3) * 64 + 8 * g4 + 4 * hi); lm1[g4] = *(const LAS f32x4*)(lamb + (nb & 3) * 64 + 32 + 8 * g4 + 4 * hi); }
            bfx8 pa0, pa1;
#define PK4(P, BASE, OUT) do { const unsigned a0 = pg8::cvt_pk_bf16(P[BASE + 0], P[BASE + 1]), a1 = pg8::cvt_pk_bf16(P[BASE + 2], P[BASE + 3]), b0_ = pg8::cvt_pk_bf16(P[BASE + 4], P[BASE + 5]), b1_ = pg8::cvt_pk_bf16(P[BASE + 6], P[BASE + 7]); \
        const auto r0 = __builtin_amdgcn_permlane32_swap(a0, b0_, false, false); const auto r1 = __builtin_amdgcn_permlane32_swap(a1, b1_, false, false); \
        const u4v w_ = {r0[0], r1[0], r0[1], r1[1]}; OUT = __builtin_bit_cast(bfx8, w_); } while (0)
            PK4(pq, 0, pa0); PK4(pq, 8, pa1);
#undef PK4
            f16v d = {};
            const bfx8 pv = *(const LAS bfx8*)(vt + SW64(vrow, 16 + 8 * hi));
            const bfx8 bk00 = *(const LAS bfx8*)(b2t + SW64(vl, 8 * hi)), bk10 = *(const LAS bfx8*)(b2t + SW64(32 + vl, 8 * hi)), bk01 = *(const LAS bfx8*)(b2t + SW64(vl, 16 + 8 * hi)), bk11 = *(const LAS bfx8*)(b2t + SW64(32 + vl, 16 + 8 * hi));
            { const bfx8 m0 = *(const LAS bfx8*)(mn + SW128(vl, 8 * hi)), m1 = *(const LAS bfx8*)(mn + SW128(vl, 16 + 8 * hi)), m2 = *(const LAS bfx8*)(mn + SW128(vl, 32 + 8 * hi));
              d = __builtin_amdgcn_mfma_f32_32x32x16_bf16(m0, pa0, d, 0, 0, 0); d = __builtin_amdgcn_mfma_f32_32x32x16_bf16(m1, pa1, d, 0, 0, 0); d = __builtin_amdgcn_mfma_f32_32x32x16_bf16(m2, pv, d, 0, 0, 0); }
            bfx8 av0;
            { const unsigned w0x = pg8::cvt_pk_bf16(d[0], d[1]), w0y = pg8::cvt_pk_bf16(d[2], d[3]), w0z = pg8::cvt_pk_bf16(d[4], d[5]), w0w = pg8::cvt_pk_bf16(d[6], d[7]);
              const unsigned w1x = pg8::cvt_pk_bf16(d[8], d[9]), w1y = pg8::cvt_pk_bf16(d[10], d[11]), w1z = pg8::cvt_pk_bf16(d[12], d[13]), w1w = pg8::cvt_pk_bf16(d[14], d[15]);
              const auto e0 = __builtin_amdgcn_permlane32_swap(w0x, w1x, false, false); const auto e1 = __builtin_amdgcn_permlane32_swap(w0y, w1y, false, false);
              const auto e2 = __builtin_amdgcn_permlane32_swap(w0z, w1z, false, false); const auto e3 = __builtin_amdgcn_permlane32_swap(w0w, w1w, false, false);
              const u4v w_ = {e0[0], e1[0], e2[0], e3[0]}; av0 = __builtin_bit_cast(bfx8, w_); }
            if (hi == 1) { LAS float* po = outb + (nb & 1) * 16 * 64 + (vrow & 3);
#pragma unroll
                for (int t = 0; t < 16; ++t) po[t * 64 + (((vrow >> 2) ^ t) << 2)] = d[t]; }
            St0 = __builtin_amdgcn_mfma_f32_32x32x16_bf16(bk00, av0, St0, 0, 0, 0); St1 = __builtin_amdgcn_mfma_f32_32x32x16_bf16(bk10, av0, St1, 0, 0, 0);
            St0 = __builtin_amdgcn_mfma_f32_32x32x16_bf16(bk01, pv, St0, 0, 0, 0); St1 = __builtin_amdgcn_mfma_f32_32x32x16_bf16(bk11, pv, St1, 0, 0, 0);
            {
#pragma unroll
              for (int r = 0; r < 16; ++r) { St0[r] *= lm0[r >> 2][r & 3]; St1[r] *= lm1[r >> 2][r & 3]; }
              u4v w_;
              w_ = (u4v){pg8::cvt_pk_bf16(St0[0], St0[1]), pg8::cvt_pk_bf16(St0[2], St0[3]), pg8::cvt_pk_bf16(St0[4], St0[5]), pg8::cvt_pk_bf16(St0[6], St0[7])}; so0 = __builtin_bit_cast(bfx8, w_);
              w_ = (u4v){pg8::cvt_pk_bf16(St0[8], St0[9]), pg8::cvt_pk_bf16(St0[10], St0[11]), pg8::cvt_pk_bf16(St0[12], St0[13]), pg8::cvt_pk_bf16(St0[14], St0[15])}; so1 = __builtin_bit_cast(bfx8, w_);
              w_ = (u4v){pg8::cvt_pk_bf16(St1[0], St1[1]), pg8::cvt_pk_bf16(St1[2], St1[3]), pg8::cvt_pk_bf16(St1[4], St1[5]), pg8::cvt_pk_bf16(St1[6], St1[7])}; so2 = __builtin_bit_cast(bfx8, w_);
              w_ = (u4v){pg8::cvt_pk_bf16(St1[8], St1[9]), pg8::cvt_pk_bf16(St1[10], St1[11]), pg8::cvt_pk_bf16(St1[12], St1[13]), pg8::cvt_pk_bf16(St1[14], St1[15])}; so3 = __builtin_bit_cast(bfx8, w_); }
            SCAN_BAR();
        }
    } else {
        typedef short bfx8 __attribute__((ext_vector_type(8))); typedef float f16v __attribute__((ext_vector_type(16))); typedef unsigned u4v __attribute__((ext_vector_type(4)));
        const int vl = lane & 31, hi = lane >> 5, j = lane & 15, grp = lane >> 4;
        LAS float* gk = (LAS float*)(lds + O_GS + (wave - 2) * 4096); LAS float* gr = gk + 512;
        const int col = grp == 0 ? NK(j) : (grp == 1 ? 32 + j : (grp == 2 ? NK(j) + 4 : 48 + j));
#define MK_SPLIT 9
#define MK_BATCH(kb_) do { const LAS unsigned char* xi = lds + O_XI + ((kb_) & 3) * 4096; const LAS unsigned char* yi = lds + O_YI + ((kb_) % 3) * 4096; LAS unsigned char* mo = lds + O_MN + ((kb_) % 3) * 4096; \
        f16v g = {}; \
        _Pragma("unroll") for (int q = 0; q < 4; ++q) { const bfx8 ay = *(const LAS bfx8*)(yi + SW128(vl, 16 * q + 8 * hi)), bx = *(const LAS bfx8*)(xi + SW128(vl, 16 * q + 8 * hi)); g = __builtin_amdgcn_mfma_f32_32x32x16_bf16(ay, bx, g, 0, 0, 0); } \
        { const int tb_ = (vl >> 2) & 1, t_ = (vl & 3) + 4 * (vl >> 3); LAS float* gp_ = gk + tb_ * 512 + t_ * 32; \
          _Pragma("unroll") for (int r = 0; r < 16; ++r) gp_[(r & 3) + 8 * (r >> 2) + 4 * hi] = g[r]; } \
        asm volatile("s_waitcnt lgkmcnt(0)" ::: "memory"); \
        float x[16]; const float m0_ = grp == 0 ? -1.0f : 0.f, m1_ = grp == 1 ? -1.0f : 0.f; \
        f32x4 Lr[2][4]; float gq[2]; \
        _Pragma("unroll") for (int s4 = 0; s4 < 4; ++s4) Lr[0][s4] = *(const LAS f32x4*)(gk + 4 * s4); gq[0] = gk[16 + j]; \
        _Pragma("unroll") for (int t = 0; t < 16; ++t) {             \
            if (t == MK_SPLIT) SCAN_BAR();            \
            if (t + 1 < 16) { _Pragma("unroll") for (int s4 = 0; s4 < 4; ++s4) { if (4 * s4 < t + 1) Lr[(t + 1) & 1][s4] = *(const LAS f32x4*)(gk + (t + 1) * 32 + 4 * s4); } gq[(t + 1) & 1] = gk[(t + 1) * 32 + 16 + j]; } \
            float rhs = (t == j ? m0_ : 0.f) + (j < t ? m1_ * gq[t & 1] : 0.f); \
            _Pragma("unroll") for (int s = 0; s < 16; ++s) if (s < t) rhs = __builtin_fmaf(-Lr[t & 1][s >> 2][s & 3], x[s], rhs); \
            x[t] = rhs; asm volatile("" : "+v"(x[t]) :: "memory"); } \
          \
        f16v cm = {}; unsigned xp_s_[8]; \
        { const f32x4 b0_ = *(const LAS f32x4*)(gr + (vl & 15) * 32 + 8 * hi), b1_ = *(const LAS f32x4*)(gr + (vl & 15) * 32 + 8 * hi + 4); float bb_[8]; \
          _Pragma("unroll") for (int e = 0; e < 4; ++e) { bb_[e] = (vl < 16 && 8 * hi + e <= vl) ? b0_[e] : 0.f; bb_[4 + e] = (vl < 16 && 8 * hi + 4 + e <= vl) ? b1_[e] : 0.f; } \
          const u4v aw_ = {pg8::cvt_pk_bf16(bb_[0], bb_[1]), pg8::cvt_pk_bf16(bb_[2], bb_[3]), pg8::cvt_pk_bf16(bb_[4], bb_[5]), pg8::cvt_pk_bf16(bb_[6], bb_[7])}; \
          _Pragma("unroll") for (int q = 0; q < 8; ++q) xp_s_[q] = pg8::cvt_pk_bf16(x[2 * q], x[2 * q + 1]); \
          u4v bw_; _Pragma("unroll") for (int q = 0; q < 4; ++q) { const auto r_ = __builtin_amdgcn_permlane32_swap(xp_s_[q], xp_s_[4 + q], false, false); bw_[q] = r_[0]; }     \
          cm = __builtin_amdgcn_mfma_f32_32x32x16_bf16(__builtin_bit_cast(bfx8, aw_), __builtin_bit_cast(bfx8, bw_), cm, 0, 0, 0); } \
          \
        { const int cj_ = vl & 15; const bool c2_ = vl >= 16; float b2_[8]; \
          _Pragma("unroll") for (int r = 0; r < 8; ++r) { const int t = (r & 3) + 8 * (r >> 2) + 4 * hi; b2_[r] = gr[t * 32 + 16 + cj_]; } \
          const int colc_ = c2_ ? 32 + cj_ : NK(cj_); \
          if (hi == 0) { _Pragma("unroll") for (int q = 0; q < 8; ++q) { *(LAS unsigned short*)(mo + SW128(NK(2 * q), colc_)) = (unsigned short)(xp_s_[q] & 0xffffu); *(LAS unsigned short*)(mo + SW128(NK(2 * q + 1), colc_)) = (unsigned short)(xp_s_[q] >> 16); } } \
          _Pragma("unroll") for (int r = 0; r < 8; r += 2) { const int t0 = (r & 3) + 8 * (r >> 2) + 4 * hi; \
              const float c0_ = cm[r] + ((c2_ && cj_ <= t0) ? b2_[r] : 0.f), c1_ = cm[r + 1] + ((c2_ && cj_ <= t0 + 1) ? b2_[r + 1] : 0.f); const unsigned w2_ = pg8::cvt_pk_bf16(c0_, c1_); \
              *(LAS unsigned short*)(mo + SW128(NK(t0) + 4, colc_)) = (unsigned short)(w2_ & 0xffffu); *(LAS unsigned short*)(mo + SW128(NK(t0 + 1) + 4, colc_)) = (unsigned short)(w2_ >> 16); } } } while (0)
        if (wave == 2) {
            unsigned z_ = 0u; asm volatile("" : "+v"(z_));
#pragma unroll
            for (int i = 0; i < 12; ++i) *(LAS v4u*)(lds + O_MN + (i * 64 + lane) * 16) = (v4u){z_, z_, z_, z_};
            asm volatile("s_waitcnt lgkmcnt(0)" ::: "memory");
            if (lane < 48) { const int bi_ = lane >> 4, t = lane & 15; *(LAS unsigned short*)(lds + O_MN + bi_ * 4096 + SW128(NK(t) + 4, NK(t) + 4)) = (unsigned short)0x3f80u; } }
        if (wave == 2) { SCAN_BAR(); SCAN_BAR(); MK_BATCH(0); SCAN_BAR();
#pragma unroll 1
            for (int k = 2; k < NB; k += 2) { MK_BATCH(k); SCAN_BAR(); }
            SCAN_BAR(); SCAN_BAR(); }
        else { SCAN_BAR(); SCAN_BAR(); SCAN_BAR(); MK_BATCH(1); SCAN_BAR();
#pragma unroll 1
            for (int k = 3; k < NB; k += 2) { MK_BATCH(k); SCAN_BAR(); }
            SCAN_BAR(); }
#undef MK_BATCH
#undef MK_SPLIT
    }
#undef SW128
#undef SW64
#undef NK
}

constexpr int N_LAUNCHES = MK_N_LAUNCHES;
struct Args { const void* in[30]; float* out; unsigned char* ws; int ph_lo, ph_hi; };
enum { I_X = 0, I_P, I_POS, I_LN1, I_WIN, I_MU, I_W0, I_W2, I_A0, I_A2, I_G2, I_KK, I_KA, I_RK, I_GNW, I_GNB, I_HLB, I_HNG, I_QG, I_KVG, I_UQ, I_UKV, I_BR, I_WO, I_LN2, I_W1, I_W2M, I_WPE, I_WPG, I_FG };
#define INF(i) ((const float*)args.in[i])

__global__ void __launch_bounds__(NWAVES * 64, 2) fwd(Args args) {
    extern __shared__ __attribute__((aligned(16))) unsigned char lds_[];
    LAS unsigned char* lds = (LAS unsigned char*)lds_;
    volatile LAS unsigned* MISC = (volatile LAS unsigned*)(lds + MISC_OFF);
    const int tid = threadIdx.x, lane = tid & 63, wave = __builtin_amdgcn_readfirstlane(tid >> 6), G = gridDim.x, bx = blockIdx.x;
    const int gw = bx * NWAVES + wave, NGW = G * NWAVES;
    unsigned char* ws = args.ws; gu32* ctl = (gu32*)(ws + WS_CTL);
    float* H = args.out;
    for (int u = tid; u < (LDS_BYTES - RING_BYTES) / 4; u += NWAVES * 64) ((LAS unsigned*)(lds + RING_BYTES))[u] = 0u;
    __syncthreads();
    XcdBarrier bar; bar.bar = (unsigned*)(ctl + CW_BAR); bar.x = 0; bar.st = nullptr;
    if (N_LAUNCHES == 1) bar = xcd_barrier_post((unsigned*)(ctl + CW_BAR), MISC + 8);
    const int lo = args.ph_lo, hi = args.ph_hi;
#ifndef PHMASK
#define PHMASK 0xFFFFFF
#endif
#define IN(k) (lo <= (k) && (k) < hi)
#define ON(k) ((PHMASK >> (k)) & 1)
#ifndef CVFILL
#define CVFILL 1
#endif
#ifndef WGM_Z
#define WGM_Z 4
#define WGM_M1 4
#define WGM_M2 4
#define WGM_O 2
#endif
#ifndef DUP_MASK
#define DUP_MASK 0
#endif
#define DUPK(k) ((DUP_MASK >> (k)) & 1)
#ifndef PROBE_X2
#define PROBE_X2 0
#endif
#ifndef DUP_SUB
#define DUP_SUB 7
#endif
#define SEAM(k) do { if (N_LAUNCHES == 1) { if (IN(k) && IN((k) + 1)) xcd_barrier(bar); } } while (0)
    bf16* XN = (bf16*)(ws + WS_XN); bf16* Z = (bf16*)(ws + WS_Z); float* COS = (float*)(ws + WS_COS); float* SIN = (float*)(ws + WS_SIN); float* LB = (float*)(ws + WS_LB);
    bf16* PB = (bf16*)(ws + WS_PB);

    if (IN(0)) {
        const int tid = tid_opaque(); const size_t gt = (size_t)bx * 512 + tid, NGT = (size_t)G * 512;
        const int* pos = (const int*)args.in[I_POS];
        for (size_t i = gt; i < (size_t)M * 32; i += NGT) { const int m = (int)(i >> 5), j = (int)(i & 31);
            const float inv = __builtin_amdgcn_exp2f(-13.287712379549449f * (float)j * (1.0f / 32.0f)); const float ang = (float)pos[m] * inv;
            const float k = rintf(ang * 0.15915494309189535f); float r = fmaf(-k, 6.28125f, ang); r = fmaf(-k, 0.0019353071795864769f, r);
            COS[i] = __cosf(r); SIN[i] = __sinf(r); }
        { unsigned z_ = 0u; asm volatile("" : "+v"(z_)); const v4u z4_ = {z_, z_, z_, z_};
          v4u* p1_ = (v4u*)(ws + WS_WIN + (size_t)3488 * 4096); v4u* p2_ = (v4u*)(ws + WS_WIN + (size_t)10048 * 4096); v4u* p3_ = (v4u*)(ws + WS_LORA);
          for (size_t i = gt; i < (size_t)96 * 4096 / 16; i += NGT) p1_[i] = z4_;
          for (size_t i = gt; i < (size_t)192 * 4096 / 16; i += NGT) p2_[i] = z4_;
          for (size_t i = gt; i < (size_t)5120 * 512 * 2 / 16; i += NGT) p3_[i] = z4_; }
        if (gt < 1024) { const float* hl = INF(I_HLB); float e[4], mx = -1e30f, sum = 0.f;
#pragma unroll
            for (int l = 0; l < 4; ++l) { e[l] = hl[l * 1024 + gt]; mx = fmaxf(mx, e[l]); }
#pragma unroll
            for (int l = 0; l < 4; ++l) { e[l] = expf(e[l] - mx); sum += e[l]; }
            float cum = 0.f; const float w0 = e[0] / sum;
#pragma unroll
            for (int l = 0; l < 4; ++l) { cum += e[l] / sum; LB[l * 1024 + gt] = cum - w0; } }
        { const int lane = tid & 63; float* RS0 = (float*)(ws + WS_RSTD); const float* g0 = INF(I_LN1);
          for (int m = gw; m < M; m += NGW) { const f32x4* xr = (const f32x4*)(INF(I_X) + (size_t)m * 2048) + lane; f32x4* hr = (f32x4*)(H + (size_t)m * 2048) + lane; v2u* xo = (v2u*)(XN + (size_t)m * 2048) + lane; float q = 0.f;
#pragma unroll
              for (int j = 0; j < 8; ++j) { const f32x4 v = xr[64 * j]; hr[64 * j] = v; q += (v[0] * v[0] + v[1] * v[1]) + (v[2] * v[2] + v[3] * v[3]); const f32x4 o = v * ((const f32x4*)g0)[64 * j + lane]; v2u w; w.x = pk2(o[0], o[1]); w.y = pk2(o[2], o[3]); xo[64 * j] = w; }
              q = wave_sum(q); if (lane == 0) RS0[m] = __builtin_amdgcn_rsqf(q * (1.0f / 2048.0f) + 1e-6f); } }
        SEAM(0);
    }

    for (int l = 0; l < DEPTH; ++l) {
        const int pb = 1 + NPH_LAYER * l;
        if (hi <= pb || lo >= pb + NPH_LAYER) continue;
        if (ON(0) && IN(pb + 0)) for (int rep_ = 0; rep_ < 1 + DUPK(0); ++rep_) {
            const int tid = tid_opaque(), lane = tid & 63; const size_t gt = (size_t)bx * 512 + tid, NGT = (size_t)G * 512; (void)lane; (void)gt; (void)NGT;
            LayerW L; L.w_in = INF(I_WIN) + (size_t)l * 2048 * IN_W; L.w2 = INF(I_W2) + (size_t)l * 2 * 64 * 1024; L.a2 = INF(I_A2) + (size_t)l * 2 * 64 * 1024; L.g2 = INF(I_G2) + (size_t)l * 160 * 1024;
            L.uq = INF(I_UQ) + (size_t)l * 768 * 1536; L.ukv = INF(I_UKV) + (size_t)l * 512 * 2048; L.br = INF(I_BR) + (size_t)l * 3 * 1024 * 2048; L.wo = INF(I_WO) + (size_t)l * 2048 * 2048;
            L.w1 = INF(I_W1) + (size_t)l * 2048 * 8192; L.w2m = INF(I_W2M) + (size_t)l * 8192 * 2048; L.wpe = INF(I_WPE) + (size_t)l * 256 * 2048; L.wpg = INF(I_WPG) + (size_t)l * 2048 * 2048;
            convert_weights(L, ws, (LAS float*)(lds + wave * 16384), gw, NGW, lane, (l > 0 && CVFILL) ? TR_EARLY : 0);
            const float* pl = INF(I_P) + (size_t)l * M * 256;
            for (size_t i = gt; i < (size_t)M * 256 / 8; i += NGT) { const f32x4 a = *(const f32x4*)(pl + 8 * i), b = *(const f32x4*)(pl + 8 * i + 4);
                v4u o; o.x = pk2(a[0], a[1]); o.y = pk2(a[2], a[3]); o.z = pk2(b[0], b[1]); o.w = pk2(b[2], b[3]); *(v4u*)(PB + 8 * i) = o; }
            if (l > 0) { const float* SSP = (const float*)(ws + WS_SS); float* RSO = (float*)(ws + WS_RSTD); for (int m0 = gw * 2 + (lane >> 5); m0 < M; m0 += NGW * 8) { float q4_[4];
#pragma unroll
              for (int i = 0; i < 4; ++i) { const int m = m0 + i * NGW * 2; q4_[i] = m < M ? SSP[(size_t)m * 32 + (lane & 31)] : 0.f; }
#pragma unroll
              for (int i = 0; i < 4; ++i) { const int m = m0 + i * NGW * 2; float q = q4_[i]; q += __shfl_xor(q, 1); q += __shfl_xor(q, 2); q += __shfl_xor(q, 4); q += __shfl_xor(q, 8); q += __shfl_xor(q, 16); if ((lane & 31) == 0 && m < M) RSO[m] = __builtin_amdgcn_rsqf(q * (1.0f / 2048.0f) + 1e-6f); } } }
            if (PROBE_X2 == 5) { convert_weights(L, ws, (LAS float*)(lds + wave * 16384), gw, NGW, lane, 0); for (int m = gw; m < M; m += NGW) rms_row<false>(H + (size_t)m * 2048, INF(I_LN1) + l * 2048, XN + (size_t)m * 2048, lane); }
            if (rep_ < DUPK(0)) xcd_barrier(bar); else SEAM(pb + 0);
        }
        if (ON(1) && IN(pb + 1)) for (int rep_ = 0; rep_ < 1 + DUPK(1); ++rep_) {
            const int tid = tid_opaque(), lane = tid & 63; const size_t gt = (size_t)bx * 512 + tid, NGT = (size_t)G * 512; (void)lane; (void)gt; (void)NGT;
            pg8::Gemm g{XN, (const bf16*)(ws + WS_WIN), M, ZW, 2048}; pg8::StaticOrder S; S.init(M, ZW, G, bx, WGM_Z);
            pg8::EpiB16<1> E{Z, ZW, (const float*)(ws + WS_RSTD), nullptr};
            pg8::gemm_phase<pg8::EpiB16<1>, pg8::StaticOrder, true, true>(lds, g, S, E);
            if (PROBE_X2 == 3) { __syncthreads(); pg8::gemm_phase<pg8::EpiB16<1>, pg8::StaticOrder, true, true>(lds, g, S, E); }
            if (rep_ < DUPK(1)) xcd_barrier(bar); else SEAM(pb + 1);
        }
        if (ON(2) && IN(pb + 2)) for (int rep_ = 0; rep_ < 1 + DUPK(2); ++rep_) {
            const int tid = tid_opaque(), lane = tid & 63; const size_t gt = (size_t)bx * 512 + tid, NGT = (size_t)G * 512; (void)lane; (void)gt; (void)NGT;
            PreP P; P.mu = INF(I_MU) + (size_t)l * 2 * RWKV_W; P.kk = INF(I_KK) + l * 1024; P.lb = LB + l * 1024; P.qg = INF(I_QG) + l * 768; P.kvg = INF(I_KVG) + l * 512; P.COS = COS; P.SIN = SIN;
            for (int r = gw; r < M / 4; r += NGW) pre_run_rwkv((size_t)r * 4, P, ws, lane);
            for (int m = gw; m < M; m += NGW) pre_token((size_t)m, P, ws, lane);
            for (int u = gw; u < 2048; u += NGW) hgrn_prep(u, LB + l * 1024, ws, lane);
            if (rep_ < DUPK(2)) xcd_barrier(bar); else SEAM(pb + 2);
        }
        if (ON(3) && IN(pb + 3)) for (int rep_ = 0; rep_ < 1 + DUPK(3); ++rep_) {
            const int tid = tid_opaque(), lane = tid & 63; const size_t gt = (size_t)bx * 512 + tid, NGT = (size_t)G * 512; (void)lane; (void)gt; (void)NGT;
            if (ON(16)) { pg8::Gemm g{(const bf16*)(ws + WS_ALORA), (const bf16*)(ws + WS_LORA), M, 4096, 256}; pg8::StaticOrder S; S.init(M, 4096, G, bx, WGM_O);
              pg8::EpiLora E{INF(I_W0) + l * 2048, INF(I_A0) + l * 2048, (unsigned short*)(ws + WS_W), (bf16*)(ws + WS_A), (bf16*)(ws + WS_G), 0};
              pg8::gemm_phase<pg8::EpiLora, pg8::StaticOrder, true, true>(lds, g, S, E); }
            if (ON(16) && (G != 256 || bx >= 128)) { pg8::Gemm g{(const bf16*)(ws + WS_ALORA) + (size_t)M * 256, (const bf16*)(ws + WS_LORA) + (size_t)4096 * 256, M, 1024, 256}; pg8::StaticOrder S; if (G == 256) S.init(M, 1024, 128, bx - 128, WGM_O); else S.init(M, 1024, G, bx, WGM_O);
              pg8::EpiLora E{INF(I_W0) + l * 2048, INF(I_A0) + l * 2048, (unsigned short*)(ws + WS_W), (bf16*)(ws + WS_A), (bf16*)(ws + WS_G), 16};
              pg8::gemm_phase<pg8::EpiLora, pg8::StaticOrder, true, true>(lds, g, S, E); }
            if (ON(17)) { pg8::Gemm g{(const bf16*)(ws + WS_CQN), (const bf16*)(ws + WS_UQ), M, 1536, 768}; pg8::StaticOrder S; S.init(M, 1536, G, bx, WGM_O);
              pg8::EpiB16<3> E{(bf16*)(ws + WS_Q), 1536, COS, SIN};
              pg8::gemm_phase<pg8::EpiB16<3>, pg8::StaticOrder, true, true>(lds, g, S, E); }
            if (ON(18)) { pg8::Gemm g{(const bf16*)(ws + WS_CKVN), (const bf16*)(ws + WS_UKV), M, 2048, 512}; pg8::StaticOrder S; S.init(M, 2048, G, bx, WGM_O);
              pg8::EpiB16<0> E{(bf16*)(ws + WS_KV), 2048, nullptr, nullptr};
              pg8::gemm_phase<pg8::EpiB16<0>, pg8::StaticOrder, true, true>(lds, g, S, E); }
            if (rep_ < DUPK(3)) xcd_barrier(bar); else SEAM(pb + 3);
        }
        if (ON(4) && IN(pb + 4)) for (int rep_ = 0; rep_ < 1 + DUPK(4); ++rep_) {
            const int tid = tid_opaque(), lane = tid & 63; const size_t gt = (size_t)bx * 512 + tid, NGT = (size_t)G * 512; (void)lane; (void)gt; (void)NGT;
            if (bx < 128) { if (ON(19) && (rep_ == 0 || (DUP_SUB & 1))) rwkv_scan(bx, INF(I_KA) + l * 1024, INF(I_KK) + l * 1024, ws, lds);
                if (PROBE_X2 == 1) { __syncthreads(); rwkv_scan(bx, INF(I_KA) + l * 1024, INF(I_KK) + l * 1024, ws, lds); } }
            else if (bx < 192) { if (ON(20) && (rep_ == 0 || (DUP_SUB & 4))) { const int qid = bx - 128, dir = qid & 1, bh = qid >> 1, h = bh & 7, b = bh >> 3;
                att::hgrn_chunk_seq((const bf16*)(ws + WS_QH) + ((size_t)dir * M + (size_t)b * SEQ) * 1024 + 128 * h, (const bf16*)(ws + WS_KH) + ((size_t)dir * M + (size_t)b * SEQ) * 1024 + 128 * h,
                                    (const bf16*)(ws + WS_Z) + (size_t)b * SEQ * ZW + ZO_H + 3072 + 128 * h, ZW, (const float*)(ws + WS_GM) + ((size_t)dir * 256 + b * 64) * 1024 + 128 * h,
                                    (const float*)(ws + WS_GL) + ((size_t)dir * 256 + b * 64) * 1024 + 128 * h, (bf16*)(ws + WS_OS) + ((size_t)dir * M + (size_t)b * SEQ) * 1024 + 128 * h, dir, (char*)lds_);
                if (PROBE_X2 == 2) att::hgrn_chunk_seq((const bf16*)(ws + WS_QH) + ((size_t)dir * M + (size_t)b * SEQ) * 1024 + 128 * h, (const bf16*)(ws + WS_KH) + ((size_t)dir * M + (size_t)b * SEQ) * 1024 + 128 * h,
                                    (const bf16*)(ws + WS_Z) + (size_t)b * SEQ * ZW + ZO_H + 3072 + 128 * h, ZW, (const float*)(ws + WS_GM) + ((size_t)dir * 256 + b * 64) * 1024 + 128 * h,
                                    (const float*)(ws + WS_GL) + ((size_t)dir * 256 + b * 64) * 1024 + 128 * h, (bf16*)(ws + WS_OS) + ((size_t)dir * M + (size_t)b * SEQ) * 1024 + 128 * h, dir, (char*)lds_); } }
            __syncthreads();
            {
                gu32* qh = ctl + CW_ATTQ + 64 * (l + 4 * rep_);
                const bf16* Q = (const bf16*)(ws + WS_Q); const bf16* KV = (const bf16*)(ws + WS_KV); const bf16* KR = (const bf16*)(ws + WS_KR); bf16* YC = (bf16*)(ws + WS_YC);
                for (;ON(21) && (rep_ == 0 || (DUP_SUB & 2));) {
                    if (tid == 0) MISC[16] = __hip_atomic_fetch_add(qh, 1u, RLX_AGENT);
                    __syncthreads(); const unsigned u = MISC[16]; __syncthreads();
                    if (u >= 512u) break;
                    const int bh = (int)(u >> 4), qb = (int)(u & 15), b = bh >> 3, h = bh & 7; const size_t row0 = (size_t)b * SEQ + (size_t)qb * 256, kr0 = (size_t)b * SEQ;
                    att::attn_dense_body(Q + row0 * 1536 + h * 192, KV + kr0 * 2048 + h * 256, KV + kr0 * 2048 + h * 256 + 128, KR + kr0 * 64, YC + row0 * 1024 + h * 128, SEQ, (char*)lds_);
                }
            }
            if (CVFILL && l + 1 < DEPTH && rep_ == 0) {
                const int l1 = l + 1; LayerW L; L.w_in = INF(I_WIN) + (size_t)l1 * 2048 * IN_W; L.w2 = INF(I_W2) + (size_t)l1 * 2 * 64 * 1024; L.a2 = INF(I_A2) + (size_t)l1 * 2 * 64 * 1024; L.g2 = INF(I_G2) + (size_t)l1 * 160 * 1024;
                L.uq = INF(I_UQ) + (size_t)l1 * 768 * 1536; L.ukv = INF(I_UKV) + (size_t)l1 * 512 * 2048; L.br = INF(I_BR) + (size_t)l1 * 3 * 1024 * 2048; L.wo = INF(I_WO) + (size_t)l1 * 2048 * 2048; L.w1 = INF(I_W1) + (size_t)l1 * 2048 * 8192; L.w2m = INF(I_W2M) + (size_t)l1 * 8192 * 2048; L.wpe = INF(I_WPE) + (size_t)l1 * 256 * 2048; L.wpg = INF(I_WPG) + (size_t)l1 * 2048 * 2048;
                gu32* qc = ctl + CW_CVQ + 64 * l;
                for (;;) {
                    if (tid == 0) MISC[16] = __hip_atomic_fetch_add(qc, 1u, RLX_AGENT);
                    __syncthreads(); const unsigned ch = MISC[16]; __syncthreads();
                    if (ch * 8u >= (unsigned)TR_EARLY) break;
                    { const TrItem T = tr_which(L, ws, (int)ch * 8 + wave); float v[32]; tr_load(T, v, lane); tr_store(T, v, (LAS float*)(lds + wave * 16384), lane); }
                }
            }
            if (rep_ < DUPK(4)) xcd_barrier(bar); else SEAM(pb + 4);
        }
        if (ON(5) && IN(pb + 5)) for (int rep_ = 0; rep_ < 1 + DUPK(5); ++rep_) {
            const int tid = tid_opaque(), lane = tid & 63; const size_t gt = (size_t)bx * 512 + tid, NGT = (size_t)G * 512; (void)lane; (void)gt; (void)NGT;
            PostP P; P.gnw = INF(I_GNW) + l * 1024; P.gnb = INF(I_GNB) + l * 1024; P.rk = INF(I_RK) + l * 1024; P.hng = INF(I_HNG) + l * 128; P.ka = INF(I_KA) + l * 1024;
            for (int m = gw; m < M; m += NGW) post_token((size_t)m, P, ws, lane);
            if (PROBE_X2 == 7) { for (int m = gw; m < M; m += NGW) post_token((size_t)m, P, ws, lane); }
            if (rep_ < DUPK(5)) xcd_barrier(bar); else SEAM(pb + 5);
        }
        if (ON(6) && IN(pb + 6)) for (int rep_ = 0; rep_ < 1 + DUPK(6); ++rep_) {
            const int tid = tid_opaque(), lane = tid & 63; const size_t gt = (size_t)bx * 512 + tid, NGT = (size_t)G * 512; (void)lane; (void)gt; (void)NGT;
            pg8::StaticOrder S; S.init(M, 2048, G, bx, WGM_O); pg8::StaticOrder Sr; Sr.init(M, 2048, G, bx, WGM_O, 1); const bf16* BR = (const bf16*)(ws + WS_BR);
            { pg8::Gemm g{(const bf16*)(ws + WS_YA), BR, M, 2048, 1024}; pg8::EpiBranch<0> E{Z, (float*)(ws + WS_MIX), (bf16*)(ws + WS_MIXED)}; pg8::gemm_phase<pg8::EpiBranch<0>, pg8::StaticOrder, true, true>(lds, g, S, E); }
            VM_WAIT(); __syncthreads();
            { pg8::Gemm g{(const bf16*)(ws + WS_YB), BR + (size_t)2048 * 1024, M, 2048, 1024}; pg8::EpiBranch<1> E{Z, (float*)(ws + WS_MIX), (bf16*)(ws + WS_MIXED)}; pg8::gemm_phase<pg8::EpiBranch<1>, pg8::StaticOrder, true, true>(lds, g, Sr, E); }
            VM_WAIT(); __syncthreads();
            { pg8::Gemm g{(const bf16*)(ws + WS_YC), BR + (size_t)2 * 2048 * 1024, M, 2048, 1024}; pg8::EpiBranch<2> E{Z, (float*)(ws + WS_MIX), (bf16*)(ws + WS_MIXED)}; pg8::gemm_phase<pg8::EpiBranch<2>, pg8::StaticOrder, true, true>(lds, g, S, E); }
            if (rep_ < DUPK(6)) xcd_barrier(bar); else SEAM(pb + 6);
        }
        if (ON(7) && IN(pb + 7)) for (int rep_ = 0; rep_ < 1 + DUPK(7); ++rep_) {
            const int tid = tid_opaque(), lane = tid & 63; const size_t gt = (size_t)bx * 512 + tid, NGT = (size_t)G * 512; (void)lane; (void)gt; (void)NGT;
            pg8::Gemm g{(const bf16*)(ws + WS_MIXED), (const bf16*)(ws + WS_WO), M, 2048, 2048}; pg8::StaticOrder S; S.init(M, 2048, G, bx, WGM_O, 1);
            pg8::EpiResid<2> E{H, XN, INF(I_LN2) + l * 2048, (float*)(ws + WS_SS) + (size_t)M * 32};
            pg8::gemm_phase<pg8::EpiResid<2>, pg8::StaticOrder, true, true>(lds, g, S, E);
            if (rep_ < DUPK(7)) xcd_barrier(bar); else SEAM(pb + 7);
        }
        if (ON(8) && IN(pb + 8)) for (int rep_ = 0; rep_ < 1 + DUPK(8); ++rep_) {
            const int tid = tid_opaque(), lane = tid & 63; const size_t gt = (size_t)bx * 512 + tid, NGT = (size_t)G * 512; (void)lane; (void)gt; (void)NGT;
            { const float* SSP = (const float*)(ws + WS_SS) + (size_t)M * 32; float* RSO = (float*)(ws + WS_RSTD) + M; for (int m0 = gw * 2 + (lane >> 5); m0 < M; m0 += NGW * 8) { float q4_[4];
#pragma unroll
              for (int i = 0; i < 4; ++i) { const int m = m0 + i * NGW * 2; q4_[i] = m < M ? SSP[(size_t)m * 32 + (lane & 31)] : 0.f; }
#pragma unroll
              for (int i = 0; i < 4; ++i) { const int m = m0 + i * NGW * 2; float q = q4_[i]; q += __shfl_xor(q, 1); q += __shfl_xor(q, 2); q += __shfl_xor(q, 4); q += __shfl_xor(q, 8); q += __shfl_xor(q, 16); if ((lane & 31) == 0 && m < M) RSO[m] = __builtin_amdgcn_rsqf(q * (1.0f / 2048.0f) + 1e-6f); } } }
            pg8::Gemm g{PB, (const bf16*)(ws + WS_WPE), M, 2048, 256}; pg8::StaticOrder S; S.init(M, 2048, G, bx, WGM_O);
            pg8::EpiB16<0> E{(bf16*)(ws + WS_PE), 2048, nullptr, nullptr};
            pg8::gemm_phase<pg8::EpiB16<0>, pg8::StaticOrder, true, true>(lds, g, S, E);
            if (rep_ < DUPK(8)) xcd_barrier(bar); else SEAM(pb + 8);
        }
        if (ON(9) && IN(pb + 9)) for (int rep_ = 0; rep_ < 1 + DUPK(9); ++rep_) {
            const int tid = tid_opaque(), lane = tid & 63; const size_t gt = (size_t)bx * 512 + tid, NGT = (size_t)G * 512; (void)lane; (void)gt; (void)NGT;
            pg8::Gemm g{XN, (const bf16*)(ws + WS_W1), M, DFF, 2048}; pg8::StaticOrder S; S.init(M, DFF, G, bx, WGM_M1);
            pg8::EpiB16<2> E{(bf16*)(ws + WS_HID), DFF, (const float*)(ws + WS_RSTD) + M, nullptr};
            pg8::gemm_phase<pg8::EpiB16<2>, pg8::StaticOrder, true, true>(lds, g, S, E);
            if (PROBE_X2 == 4) { __syncthreads(); pg8::gemm_phase<pg8::EpiB16<2>, pg8::StaticOrder, true, true>(lds, g, S, E); }
            if (rep_ < DUPK(9)) xcd_barrier(bar); else SEAM(pb + 9);
        }
        if (ON(10) && IN(pb + 10)) for (int rep_ = 0; rep_ < 1 + DUPK(10); ++rep_) {
            const int tid = tid_opaque(), lane = tid & 63; const size_t gt = (size_t)bx * 512 + tid, NGT = (size_t)G * 512; (void)lane; (void)gt; (void)NGT;
            pg8::Gemm g{(const bf16*)(ws + WS_HID), (const bf16*)(ws + WS_W2), M, 2048, DFF}; pg8::StaticOrder S; S.init(M, 2048, G, bx, WGM_M2, 1);
            pg8::EpiResid<1> E{H, (bf16*)(ws + WS_HB), nullptr, nullptr};
            pg8::gemm_phase<pg8::EpiResid<1>, pg8::StaticOrder, true, true>(lds, g, S, E);
            if (rep_ < DUPK(10)) xcd_barrier(bar); else SEAM(pb + 10);
        }
        if (ON(11) && IN(pb + 11)) for (int rep_ = 0; rep_ < 1 + DUPK(11); ++rep_) {
            const int tid = tid_opaque(), lane = tid & 63; const size_t gt = (size_t)bx * 512 + tid, NGT = (size_t)G * 512; (void)lane; (void)gt; (void)NGT;
            pg8::Gemm g{(const bf16*)(ws + WS_HB), (const bf16*)(ws + WS_WPG), M, 2048, 2048}; pg8::StaticOrder S; S.init(M, 2048, G, bx, WGM_O);
            pg8::EpiPG E{H, (const bf16*)(ws + WS_PE), XN, l + 1 < DEPTH ? INF(I_LN1) + (l + 1) * 2048 : INF(I_FG), (float*)(ws + WS_SS)};
            pg8::gemm_phase<pg8::EpiPG, pg8::StaticOrder, true, true>(lds, g, S, E);
            if (rep_ < DUPK(11)) xcd_barrier(bar); else SEAM(pb + 11);
        }
    }
    if (IN(NPHASES - 1)) {
        const int lane = tid_opaque() & 63;
        const float* SSf = (const float*)(ws + WS_SS);
        for (int m = gw; m < M; m += NGW) { float q = lane < 32 ? SSf[(size_t)m * 32 + lane] : 0.f; q = wave_sum(q); const float rstd = __builtin_amdgcn_rsqf(q * (1.0f / 2048.0f) + 1e-6f); f32x4* hr = (f32x4*)(H + (size_t)m * 2048) + lane;
#pragma unroll
            for (int j = 0; j < 8; ++j) hr[64 * j] = hr[64 * j] * rstd * ((const f32x4*)INF(I_FG))[64 * j + lane]; }
    }
#undef IN
#undef SEAM
}

extern "C" void kernel_launch(void* const* d_in, const int* in_sizes, int n_in, void* d_out, int out_size, void* d_ws, size_t ws_size, hipStream_t stream) {
    static int grid = 0;
    if (grid == 0) {
        if (n_in != 30 || out_size != M * DM || ws_size < WS_END) { fprintf(stderr, "kernel_launch: unexpected shapes: n_in %d out %d ws %zu (need %zu)\n", n_in, out_size, ws_size, (size_t)WS_END); grid = -1; return; }
        int dev = 0, cus = 0, per_cu = 0;
        if (hipGetDevice(&dev) != hipSuccess || hipDeviceGetAttribute(&cus, hipDeviceAttributeMultiprocessorCount, dev) != hipSuccess) { grid = -1; return; }
        if (hipFuncSetAttribute((const void*)fwd, hipFuncAttributeMaxDynamicSharedMemorySize, LDS_BYTES) != hipSuccess) { fprintf(stderr, "kernel_launch: hipFuncSetAttribute failed\n"); grid = -1; return; }
        if (hipOccupancyMaxActiveBlocksPerMultiprocessor(&per_cu, (const void*)fwd, NWAVES * 64, LDS_BYTES) != hipSuccess || per_cu < 1) fprintf(stderr, "kernel_launch: occupancy query reports %d blocks per CU\n", per_cu);
        (void)hipGetLastError();
        grid = cus;
        if (grid != 256) fprintf(stderr, "kernel_launch: %d CUs; the phase-4 role split assumes 256 workgroups\n", grid);
    }
    if (grid < 0) return;
    unsigned char* ws = (unsigned char*)d_ws;
    (void)hipMemsetAsync(ws + WS_CTL, 0, CTL_ZERO_BYTES, stream);
    Args a{};
    for (int i = 0; i < 30; ++i) a.in[i] = d_in[i];
    a.out = (float*)d_out; a.ws = ws;
    for (int li = 0; li < N_LAUNCHES; ++li) {
        if (N_LAUNCHES == 1) { a.ph_lo = 0; a.ph_hi = NPHASES; } else { a.ph_lo = li; a.ph_hi = li + 1; }
        hipLaunchKernelGGL(fwd, dim3(grid), dim3(NWAVES * 64), LDS_BYTES, stream, a);
        const hipError_t le = hipPeekAtLastError();
        if (le != hipSuccess) { fprintf(stderr, "kernel_launch: launch %d failed: %s\n", li, hipGetErrorName(le)); break; }
    }
}
```
